# Optimizing an MI355X kernel written in HIP

```python
import math
import jax, jax.numpy as jnp
from jax import lax
import numpy as np

D_MODEL = 1024
BATCH = 4
SEQ = 4096
DEPTH = 2

GRID_W = 64
D_FF = 2816
NORM_EPS = 1e-6
N_BRANCHES = 3
S5_GROUPS = 32
S5_GROUP_CH = 16
S5_STATE = 64
S5_WIDTH = S5_GROUPS * S5_GROUP_CH
S5_DT_MIN = 1e-3
S5_DT_MAX = 1e-1
GLA_HEADS = 4
GLA_HEAD_DIM = 128
GLA_WIDTH = GLA_HEADS * GLA_HEAD_DIM
GLA_LOWRANK = 16
GLA_TAU = 16.0
GLA_CHUNK = 64
ATTN_Q_HEADS = 8
ATTN_KV_HEADS = 2
ATTN_HEAD_DIM = 64
ATTN_WIDTH = ATTN_Q_HEADS * ATTN_HEAD_DIM
ATTN_KV_WIDTH = ATTN_KV_HEADS * ATTN_HEAD_DIM
ATTN_BLOCK = 128
ROPE_BASE = 10000.0
IN_SPLITS = (S5_WIDTH, GLA_WIDTH, GLA_WIDTH, GLA_WIDTH, GLA_WIDTH, GLA_LOWRANK, GLA_LOWRANK, ATTN_WIDTH, ATTN_KV_WIDTH, ATTN_KV_WIDTH)
IN_WIDTH = sum(IN_SPLITS)

kernel_name = 'hybrid_s5_gla_gqa_macaron_encoder'

F32 = jnp.float32


def rms_norm(x, gain):
    x32 = x.astype(F32)
    y = x32 * lax.rsqrt(jnp.mean(x32 * x32, axis=-1, keepdims=True) + NORM_EPS)
    return (y * gain.astype(F32)).astype(x.dtype)


def swiglu_ffn(h, w_gate, w_up, w_down):
    return (jax.nn.silu(h @ w_gate) * (h @ w_up)) @ w_down


def _linear_recurrence(left, right):
    a_l, b_l = left
    a_r, b_r = right
    return a_r * a_l, a_r * b_l + b_r


def s5_scan_dir(u32, lam_re, lam_im, log_dt, b_re, b_im, c_re, c_im, reverse):
    lam = lax.complex(lam_re.astype(F32), lam_im.astype(F32))
    dt = jnp.exp(log_dt.astype(F32))[:, None]
    lam_bar = jnp.exp(lam * dt)
    b = lax.complex(b_re.astype(F32), b_im.astype(F32))
    b_bar = ((lam_bar - 1.0) / lam)[..., None] * b
    bu = jnp.einsum('blgh,gph->blgp', u32.astype(jnp.complex64), b_bar)
    a = jnp.broadcast_to(lam_bar, bu.shape)
    _, states = lax.associative_scan(_linear_recurrence, (a, bu), axis=1, reverse=reverse)
    c = lax.complex(c_re.astype(F32), c_im.astype(F32))
    return jnp.real(jnp.einsum('blgp,ghp->blgh', states, c))


def s5_branch(u, lam_re, lam_im, log_dt, b_re, b_im, c_re, c_im, d_skip, w_glu):
    bsz, seq_len, _ = u.shape
    u32 = u.astype(F32)
    ug = u32.reshape(bsz, seq_len, S5_GROUPS, S5_GROUP_CH)
    y = (s5_scan_dir(ug, lam_re[0], lam_im[0], log_dt[0], b_re[0], b_im[0], c_re[0], c_im[0], False)
         + s5_scan_dir(ug, lam_re[1], lam_im[1], log_dt[1], b_re[1], b_im[1], c_re[1], c_im[1], True))
    y = y.reshape(bsz, seq_len, S5_WIDTH) + d_skip.astype(F32) * u32
    y = jax.nn.gelu(y).astype(u.dtype)
    return y * jax.nn.sigmoid(y @ w_glu)


def gla_chunked(q, k, v, log_a):
    bsz, seq_len, nh, dk = q.shape
    dv = v.shape[-1]
    n_chunks = seq_len // GLA_CHUNK

    def chunks(t):
        return t.reshape(bsz, n_chunks, GLA_CHUNK, nh, t.shape[-1])

    q, k, v, log_a = chunks(q), chunks(k), chunks(v), chunks(log_a)
    b = jnp.cumsum(log_a, axis=2)
    b_last = b[:, :, -1]
    q_dec = q * jnp.exp(b)
    k_dec = k * jnp.exp(-b)
    mask = jnp.tril(jnp.ones((GLA_CHUNK, GLA_CHUNK), dtype=bool))
    scores = jnp.where(mask, jnp.einsum('bnihd,bnjhd->bnhij', q_dec, k_dec), 0.0)
    o_intra = jnp.einsum('bnhij,bnjhe->bnihe', scores, v)
    k_to_end = k * jnp.exp(b_last[:, :, None] - b)
    chunk_kv = jnp.einsum('bnjhd,bnjhe->nbhde', k_to_end, v)
    chunk_decay = jnp.exp(jnp.moveaxis(b_last, 1, 0))

    def step(state, inp):
        decay, kv = inp
        return decay[..., None] * state + kv, state

    init = jnp.zeros((bsz, nh, dk, dv), F32)
    _, prev_states = lax.scan(step, init, (chunk_decay, chunk_kv))
    o_inter = jnp.einsum('bnihd,nbhde->bnihe', q_dec, prev_states)
    return (o_intra + o_inter).reshape(bsz, seq_len, nh, dv)


def gla_branch(q, k, v, gate, z_f, z_b, w_alpha, b_alpha, norm_gain):
    bsz, seq_len, _ = q.shape

    def heads(t):
        return t.astype(F32).reshape(bsz, seq_len, GLA_HEADS, GLA_HEAD_DIM)

    qh = heads(q) * GLA_HEAD_DIM ** -0.5
    kh = heads(k)
    vh = heads(v)

    def log_gate(z, w, bias):
        logits = (z @ w + bias).astype(F32)
        return heads(jax.nn.log_sigmoid(logits) / GLA_TAU)

    la_f = log_gate(z_f, w_alpha[0], b_alpha[0])
    la_b = log_gate(z_b, w_alpha[1], b_alpha[1])

    def flip(t):
        return jnp.flip(t, axis=1)

    o_f = gla_chunked(qh, kh, vh, la_f)
    o_b = flip(gla_chunked(flip(qh), flip(kh), flip(vh), flip(la_b)))
    o = rms_norm(o_f + o_b, norm_gain).reshape(bsz, seq_len, GLA_WIDTH).astype(q.dtype)
    return o * jax.nn.silu(gate)


def rope_1d(x, pos):
    d = x.shape[-1]
    half = d // 2
    inv_freq = ROPE_BASE ** (-jnp.arange(half, dtype=F32) * 2.0 / d)
    ang = pos.astype(F32)[:, None] * inv_freq[None, :]
    cos = jnp.cos(ang)[:, None, :]
    sin = jnp.sin(ang)[:, None, :]
    x1, x2 = x[..., :half], x[..., half:]
    return jnp.concatenate([x1 * cos - x2 * sin, x2 * cos + x1 * sin], axis=-1)


def axial_rope(x, rows, cols):
    half = x.shape[-1] // 2
    return jnp.concatenate([rope_1d(x[..., :half], rows), rope_1d(x[..., half:], cols)], axis=-1)


def attn_branch(q, k, v, q_gain, k_gain):
    bsz, seq_len, _ = q.shape
    n_rows = seq_len // GRID_W
    rows = jnp.repeat(jnp.arange(n_rows, dtype=jnp.int32), GRID_W)
    cols = jnp.tile(jnp.arange(GRID_W, dtype=jnp.int32), n_rows)
    qh = q.astype(F32).reshape(bsz, seq_len, ATTN_Q_HEADS, ATTN_HEAD_DIM)
    kh = k.astype(F32).reshape(bsz, seq_len, ATTN_KV_HEADS, ATTN_HEAD_DIM)
    vh = v.astype(F32).reshape(bsz, seq_len, ATTN_KV_HEADS, ATTN_HEAD_DIM)
    qh = axial_rope(rms_norm(qh, q_gain), rows, cols) * ATTN_HEAD_DIM ** -0.5
    kh = axial_rope(rms_norm(kh, k_gain), rows, cols)
    group = ATTN_Q_HEADS // ATTN_KV_HEADS
    n_blocks = seq_len // ATTN_BLOCK
    q_blocks = qh.reshape(bsz, n_blocks, ATTN_BLOCK, ATTN_KV_HEADS, group, ATTN_HEAD_DIM)
    q_blocks = jnp.moveaxis(q_blocks, 1, 0)

    def attend(qb):
        s = jnp.einsum('bqkgd,bskd->bkgqs', qb, kh)
        p = jax.nn.softmax(s, axis=-1)
        return jnp.einsum('bkgqs,bskd->bqkgd', p, vh)

    out = lax.map(attend, q_blocks)
    out = jnp.moveaxis(out, 0, 1).reshape(bsz, seq_len, ATTN_WIDTH)
    return out.astype(q.dtype)


def setup_inputs(seed: int = 0) -> dict:
    key = jax.random.key(seed)
    keys = iter(jax.random.split(key, 40))

    def normal(shape, scale):
        return scale * jax.random.normal(next(keys), shape, F32)

    def gain(shape):
        return 1.0 + normal(shape, 0.02)

    G, H, P = S5_GROUPS, S5_GROUP_CH, S5_STATE
    x = normal((BATCH, SEQ, D_MODEL), 1.0)
    ffn1_norm = gain((DEPTH, D_MODEL))
    ffn1_w_gate = normal((DEPTH, D_MODEL, D_FF), D_MODEL ** -0.5)
    ffn1_w_up = normal((DEPTH, D_MODEL, D_FF), D_MODEL ** -0.5)
    ffn1_w_down = normal((DEPTH, D_FF, D_MODEL), D_FF ** -0.5)
    mix_norm = gain((DEPTH, D_MODEL))
    w_in = normal((DEPTH, D_MODEL, IN_WIDTH), D_MODEL ** -0.5)
    s5_lambda_re = -0.5 + normal((DEPTH, 2, G, P), 0.01)
    s5_lambda_im = math.pi * jnp.arange(P, dtype=F32) + normal((DEPTH, 2, G, P), 0.01)
    s5_log_dt = jax.random.uniform(next(keys), (DEPTH, 2, G), F32, math.log(S5_DT_MIN), math.log(S5_DT_MAX))
    s5_b_re = normal((DEPTH, 2, G, P, H), (0.5 / H) ** 0.5)
    s5_b_im = normal((DEPTH, 2, G, P, H), (0.5 / H) ** 0.5)
    s5_c_re = normal((DEPTH, 2, G, H, P), (0.5 / P) ** 0.5)
    s5_c_im = normal((DEPTH, 2, G, H, P), (0.5 / P) ** 0.5)
    s5_d = normal((DEPTH, S5_WIDTH), 1.0)
    s5_w_glu = normal((DEPTH, S5_WIDTH, S5_WIDTH), S5_WIDTH ** -0.5)
    gla_w_alpha = normal((DEPTH, 2, GLA_LOWRANK, GLA_WIDTH), GLA_LOWRANK ** -0.5)
    gla_b_alpha = normal((DEPTH, 2, GLA_WIDTH), 0.1)
    gla_norm = gain((DEPTH, GLA_HEAD_DIM))
    attn_q_norm = gain((DEPTH, ATTN_HEAD_DIM))
    attn_k_norm = gain((DEPTH, ATTN_HEAD_DIM))
    w_branch_s5 = normal((DEPTH, S5_WIDTH, D_MODEL), S5_WIDTH ** -0.5)
    w_branch_gla = normal((DEPTH, GLA_WIDTH, D_MODEL), GLA_WIDTH ** -0.5)
    w_branch_attn = normal((DEPTH, ATTN_WIDTH, D_MODEL), ATTN_WIDTH ** -0.5)
    w_merge_gate = normal((DEPTH, D_MODEL, N_BRANCHES * D_MODEL), D_MODEL ** -0.5)
    b_merge_gate = normal((DEPTH, N_BRANCHES * D_MODEL), 0.01)
    w_out = normal((DEPTH, D_MODEL, D_MODEL), D_MODEL ** -0.5)
    ffn2_norm = gain((DEPTH, D_MODEL))
    ffn2_w_gate = normal((DEPTH, D_MODEL, D_FF), D_MODEL ** -0.5)
    ffn2_w_up = normal((DEPTH, D_MODEL, D_FF), D_MODEL ** -0.5)
    ffn2_w_down = normal((DEPTH, D_FF, D_MODEL), D_FF ** -0.5)
    final_norm = gain((D_MODEL,))
    return {'x': x, 'ffn1_norm': ffn1_norm, 'ffn1_w_gate': ffn1_w_gate, 'ffn1_w_up': ffn1_w_up,
            'ffn1_w_down': ffn1_w_down, 'mix_norm': mix_norm, 'w_in': w_in,
            's5_lambda_re': s5_lambda_re, 's5_lambda_im': s5_lambda_im, 's5_log_dt': s5_log_dt,
            's5_b_re': s5_b_re, 's5_b_im': s5_b_im, 's5_c_re': s5_c_re, 's5_c_im': s5_c_im,
            's5_d': s5_d, 's5_w_glu': s5_w_glu, 'gla_w_alpha': gla_w_alpha, 'gla_b_alpha': gla_b_alpha,
            'gla_norm': gla_norm, 'attn_q_norm': attn_q_norm, 'attn_k_norm': attn_k_norm,
            'w_branch_s5': w_branch_s5, 'w_branch_gla': w_branch_gla, 'w_branch_attn': w_branch_attn,
            'w_merge_gate': w_merge_gate, 'b_merge_gate': b_merge_gate, 'w_out': w_out,
            'ffn2_norm': ffn2_norm, 'ffn2_w_gate': ffn2_w_gate, 'ffn2_w_up': ffn2_w_up,
            'ffn2_w_down': ffn2_w_down, 'final_norm': final_norm}


def reference(x, ffn1_norm, ffn1_w_gate, ffn1_w_up, ffn1_w_down, mix_norm, w_in,
              s5_lambda_re, s5_lambda_im, s5_log_dt, s5_b_re, s5_b_im, s5_c_re, s5_c_im,
              s5_d, s5_w_glu, gla_w_alpha, gla_b_alpha, gla_norm, attn_q_norm, attn_k_norm,
              w_branch_s5, w_branch_gla, w_branch_attn, w_merge_gate, b_merge_gate, w_out,
              ffn2_norm, ffn2_w_gate, ffn2_w_up, ffn2_w_down, final_norm):
    bsz, seq_len, _ = x.shape
    split_at = [int(c) for c in np.cumsum(IN_SPLITS)[:-1]]
    for i in range(DEPTH):
        h = rms_norm(x, ffn1_norm[i])
        x = x + 0.5 * swiglu_ffn(h, ffn1_w_gate[i], ffn1_w_up[i], ffn1_w_down[i])

        h = rms_norm(x, mix_norm[i])
        (s5_u, gla_q, gla_k, gla_v, gla_g, gla_zf, gla_zb,
         at_q, at_k, at_v) = jnp.split(h @ w_in[i], split_at, axis=-1)
        y_s5 = s5_branch(s5_u, s5_lambda_re[i], s5_lambda_im[i], s5_log_dt[i], s5_b_re[i], s5_b_im[i],
                         s5_c_re[i], s5_c_im[i], s5_d[i], s5_w_glu[i])
        y_gla = gla_branch(gla_q, gla_k, gla_v, gla_g, gla_zf, gla_zb,
                           gla_w_alpha[i], gla_b_alpha[i], gla_norm[i])
        y_attn = attn_branch(at_q, at_k, at_v, attn_q_norm[i], attn_k_norm[i])
        gates = jax.nn.sigmoid(h @ w_merge_gate[i] + b_merge_gate[i])
        gates = gates.reshape(bsz, seq_len, N_BRANCHES, D_MODEL)
        merged = (gates[:, :, 0] * (y_s5 @ w_branch_s5[i])
                  + gates[:, :, 1] * (y_gla @ w_branch_gla[i])
                  + gates[:, :, 2] * (y_attn @ w_branch_attn[i]))
        x = x + merged @ w_out[i]

        h = rms_norm(x, ffn2_norm[i])
        x = x + 0.5 * swiglu_ffn(h, ffn2_w_gate[i], ffn2_w_up[i], ffn2_w_down[i])
    return rms_norm(x, final_norm)
```

```cpp
#include <hip/hip_runtime.h>
#include <hip/hip_cooperative_groups.h>
#include <hip/hip_bf16.h>
#include <cstdio>
#include <cstdint>
#include <cmath>
namespace cg = cooperative_groups;

namespace pg8 {
#define PG8_LAS __attribute__((address_space(3)))
typedef unsigned short bf16_t;
typedef short bf16x8 __attribute__((ext_vector_type(8)));
typedef float f32x4 __attribute__((ext_vector_type(4)));
typedef unsigned u32x4 __attribute__((ext_vector_type(4)));
constexpr int BM = 256, BK = 64, HALF = 128, HTB = HALF * BK * 2  , STAGE_BYTES = 8 * HTB, NXCD = 8, WGM = 8;

__host__ __device__ __forceinline__ int lds_byte(int r, int c) { const int st = (r >> 4) * 2 + (c >> 5), rr = r & 15, cc = c & 31, ob = rr * 64 + cc * 2; return st * 1024 + (ob ^ (((ob >> 9) & 1) << 5)); }
__host__ __device__ __forceinline__ void stage_rc(int b, int& R, int& C) { const int st = b / 1024, sb = b % 1024, swz = sb ^ (((sb >> 9) & 1) << 5); R = (st >> 1) * 16 + swz / 64; C = (st & 1) * 32 + (swz % 64) / 2; }
__host__ __device__ __forceinline__ int perm32(int rho) { const int n = rho >> 4, i = rho & 15; return 8 * (i >> 2) + 4 * n + (i & 3); }

struct Unit { int pm, pn, g; };

struct StaticOrder {
    int nM, nN, nwg, G, c;
    __host__ __device__ void init(int M, int N, int G_, int c_) { nM = M / BM; nN = N / BM; nwg = nM * nN; G = G_; c = c_; }
    __host__ __device__ bool next(int i, Unit& u) const {
        const long L = (long)i * G + c; if (L >= nwg) return false;
        int wgid = (int)L; { const int q = nwg / NXCD, r = nwg % NXCD, xcd = wgid % NXCD, off = wgid / NXCD; wgid = (xcd < r ? xcd * (q + 1) : r * (q + 1) + (xcd - r) * q) + off; }
        const int nig = WGM * nN, gid = wgid / nig, fm = gid * WGM, gsz = (nM - fm) < WGM ? (nM - fm) : WGM;
        u.pm = fm + ((wgid % nig) % gsz); u.pn = (wgid % nig) / gsz; u.g = 0; return true;
    }
    __device__ __forceinline__ void a_ready(const Unit&) const {}
    __device__ __forceinline__ void done(const Unit&) const {}
};

struct Gemm { const bf16_t* A; const bf16_t* Bt; int M, N, K, lda, ldb; size_t sA, sB; size_t aoff[3]; int useoff; };
#define PG8_ABASE(G_, U_) ((const char*)(G_).A + ((G_).useoff ? ((U_).g == 0 ? (G_).aoff[0] : ((U_).g == 1 ? (G_).aoff[1] : (G_).aoff[2])) : (size_t)(U_).g * (G_).sA))
__device__ __forceinline__ unsigned cvt_pk_bf16(float lo, float hi) { unsigned r; asm volatile("v_cvt_pk_bf16_f32 %0, %1, %2" : "=v"(r) : "v"(lo), "v"(hi)); return r; }
__device__ __forceinline__ float bflo(unsigned w) { return __builtin_bit_cast(float, w << 16); }
__device__ __forceinline__ float bfhi(unsigned w) { return __builtin_bit_cast(float, w & 0xffff0000u); }
__device__ __forceinline__ float rstd1024(const float* ss, int row) { const f32x4* p = (const f32x4*)(ss + (size_t)row * 16); const f32x4 a = p[0], b = p[1], c = p[2], d = p[3];
    const float t = ((a[0] + a[1]) + (a[2] + a[3])) + ((b[0] + b[1]) + (b[2] + b[3])) + ((c[0] + c[1]) + (c[2] + c[3])) + ((d[0] + d[1]) + (d[2] + d[3])); return rsqrtf(t * (1.0f / 1024.0f) + 1e-6f); }
__device__ __forceinline__ float sigmoidf_(float x) { return __builtin_amdgcn_rcpf(1.0f + __expf(-x)); }
__device__ __forceinline__ u32x4 pack8(f32x4 a, f32x4 b) { u32x4 w; w.x = cvt_pk_bf16(a[0], a[1]); w.y = cvt_pk_bf16(a[2], a[3]); w.z = cvt_pk_bf16(b[0], b[1]); w.w = cvt_pk_bf16(b[2], b[3]); return w; }
__device__ __forceinline__ void unpack8(u32x4 w, f32x4& a, f32x4& b) { a = (f32x4){bflo(w.x), bfhi(w.x), bflo(w.y), bfhi(w.y)}; b = (f32x4){bflo(w.z), bfhi(w.z), bflo(w.w), bfhi(w.w)}; }

struct EpiSwiGLU {
    static constexpr bool PERM = true, AFTER_DRAIN = false;
    bf16_t* H; const float* ss; int ldh;
    __device__ __forceinline__ void operator()(const f32x4 (&acc)[2][2][4][2], const Unit& u, int wr, int wc, int fr, int fq) const {
        const int row0 = u.pm * BM + wr * 64 + fr, col0 = u.pn * 128 + wc * 32 + 8 * fq;
#pragma unroll
        for (int ai = 0; ai < 2; ++ai)
#pragma unroll
            for (int m = 0; m < 4; ++m) { const int row = row0 + ai * HALF + m * 16; const float r = rstd1024(ss, row);
                f32x4 o[2];
#pragma unroll
                for (int n = 0; n < 2; ++n)
#pragma unroll
                    for (int j = 0; j < 4; ++j) { const float g = acc[ai][0][m][n][j] * r, up = acc[ai][1][m][n][j] * r; o[n][j] = g * sigmoidf_(g) * up; }
                *(u32x4*)(H + (size_t)row * ldh + col0) = pack8(o[0], o[1]); }
    }
};
struct EpiResid {
    static constexpr bool PERM = true, AFTER_DRAIN = false;
    const float* Xin; float* X; bf16_t* XB; float* ssn; float scale;
    __device__ __forceinline__ void operator()(const f32x4 (&acc)[2][2][4][2], const Unit& u, int wr, int wc, int fr, int fq) const {
        const int row0 = u.pm * BM + wr * 64 + fr, col0 = u.pn * BM + wc * 32 + 8 * fq;
#pragma unroll
        for (int ai = 0; ai < 2; ++ai)
#pragma unroll
            for (int m = 0; m < 4; ++m) { const int row = row0 + ai * HALF + m * 16; float part = 0.f;
#pragma unroll
                for (int bj = 0; bj < 2; ++bj) { float* xp = X + (size_t)row * 1024 + col0 + bj * HALF; const float* xi = Xin + (size_t)row * 1024 + col0 + bj * HALF;
                    f32x4 x0 = *(const f32x4*)xi, x1 = *(const f32x4*)(xi + 4);
                    x0 = x0 + acc[ai][bj][m][0] * scale; x1 = x1 + acc[ai][bj][m][1] * scale;
                    *(f32x4*)xp = x0; *(f32x4*)(xp + 4) = x1;
                    *(u32x4*)(XB + (size_t)row * 1024 + col0 + bj * HALF) = pack8(x0, x1);
                    part += (x0[0] * x0[0] + x0[1] * x0[1]) + (x0[2] * x0[2] + x0[3] * x0[3]) + (x1[0] * x1[0] + x1[1] * x1[1]) + (x1[2] * x1[2] + x1[3] * x1[3]); }
                part += __shfl_xor(part, 16); part += __shfl_xor(part, 32);
                if (fq == 0) ssn[(size_t)row * 16 + u.pn * 4 + wc] = part; }
    }
};
struct EpiScaleBf16 {
    static constexpr bool PERM = true, AFTER_DRAIN = false;
    bf16_t* O; int ldo; const float* ss;
    __device__ __forceinline__ void operator()(const f32x4 (&acc)[2][2][4][2], const Unit& u, int wr, int wc, int fr, int fq) const {
        const int row0 = u.pm * BM + wr * 64 + fr, col0 = u.pn * BM + wc * 32 + 8 * fq;
#pragma unroll
        for (int ai = 0; ai < 2; ++ai)
#pragma unroll
            for (int m = 0; m < 4; ++m) { const int row = row0 + ai * HALF + m * 16; const float r = rstd1024(ss, row);
#pragma unroll
                for (int bj = 0; bj < 2; ++bj) *(u32x4*)(O + (size_t)row * ldo + col0 + bj * HALF) = pack8(acc[ai][bj][m][0] * r, acc[ai][bj][m][1] * r); }
    }
};
struct EpiGlu {
    static constexpr bool PERM = true, AFTER_DRAIN = false;
    const bf16_t* YG; int ldg; bf16_t* Y; int ldy;
    __device__ __forceinline__ void operator()(const f32x4 (&acc)[2][2][4][2], const Unit& u, int wr, int wc, int fr, int fq) const {
        const int row0 = u.pm * BM + wr * 64 + fr, col0 = u.pn * BM + wc * 32 + 8 * fq;
#pragma unroll
        for (int ai = 0; ai < 2; ++ai)
#pragma unroll
            for (int m = 0; m < 4; ++m) { const int row = row0 + ai * HALF + m * 16;
#pragma unroll
                for (int bj = 0; bj < 2; ++bj) { const int col = col0 + bj * HALF; f32x4 y0, y1; unpack8(*(const u32x4*)(YG + (size_t)row * ldg + col), y0, y1);
#pragma unroll
                    for (int j = 0; j < 4; ++j) { y0[j] *= sigmoidf_(acc[ai][bj][m][0][j]); y1[j] *= sigmoidf_(acc[ai][bj][m][1][j]); }
                    *(u32x4*)(Y + (size_t)row * ldy + col) = pack8(y0, y1); } }
    }
};
struct EpiGate {
    static constexpr bool PERM = true, AFTER_DRAIN = false;
    bf16_t* G; const float* bias; const float* ss;
    __device__ __forceinline__ void operator()(const f32x4 (&acc)[2][2][4][2], const Unit& u, int wr, int wc, int fr, int fq) const {
        const int row0 = u.pm * BM + wr * 64 + fr, col0 = u.pn * BM + wc * 32 + 8 * fq;
#pragma unroll
        for (int ai = 0; ai < 2; ++ai)
#pragma unroll
            for (int m = 0; m < 4; ++m) { const int row = row0 + ai * HALF + m * 16; const float r = rstd1024(ss, row);
#pragma unroll
                for (int bj = 0; bj < 2; ++bj) { const int col = col0 + bj * HALF; const f32x4 b0 = *(const f32x4*)(bias + col), b1 = *(const f32x4*)(bias + col + 4); f32x4 g0, g1;
#pragma unroll
                    for (int j = 0; j < 4; ++j) { g0[j] = sigmoidf_(acc[ai][bj][m][0][j] * r + b0[j]); g1[j] = sigmoidf_(acc[ai][bj][m][1][j] * r + b1[j]); }
                    *(u32x4*)(G + (size_t)row * 1024 + col) = pack8(g0, g1); } }
    }
};
template <int MODE> struct EpiMerge {
    static constexpr bool PERM = true, AFTER_DRAIN = false;
    bf16_t* G; float* MG;
    __device__ __forceinline__ void operator()(const f32x4 (&acc)[2][2][4][2], const Unit& u, int wr, int wc, int fr, int fq) const {
        const int row0 = u.pm * BM + wr * 64 + fr, col0 = u.pn * BM + wc * 32 + 8 * fq;
#pragma unroll
        for (int ai = 0; ai < 2; ++ai)
#pragma unroll
            for (int m = 0; m < 4; ++m) { const int row = row0 + ai * HALF + m * 16;
#pragma unroll
                for (int bj = 0; bj < 2; ++bj) { const size_t off = (size_t)row * 1024 + col0 + bj * HALF; f32x4 g0, g1; unpack8(*(const u32x4*)(G + off), g0, g1);
                    f32x4 v0 = g0 * acc[ai][bj][m][0], v1 = g1 * acc[ai][bj][m][1];
                    if (MODE != 0) { v0 = v0 + *(const f32x4*)(MG + off); v1 = v1 + *(const f32x4*)(MG + off + 4); }
                    if (MODE != 2) { *(f32x4*)(MG + off) = v0; *(f32x4*)(MG + off + 4) = v1; }
                    else *(u32x4*)(G + off) = pack8(v0, v1); } }
    }
};

struct BatchOrder {
    int nM, nN, per, total, G, c;
    __device__ void init(int nM_, int nN_, int nb, int G_, int c_) { nM = nM_; nN = nN_; per = nM_ * nN_; total = per * nb; G = G_; c = c_; }
    __device__ bool next(int i, Unit& u) const { const int L = i * G + c; if (L >= total) return false; u.g = L / per; const int r = L % per; u.pm = r / nN; u.pn = r % nN; return true; }
    __device__ __forceinline__ void a_ready(const Unit&) const {}
    __device__ __forceinline__ void done(const Unit&) const {}
};
struct TileBatchOrder {
    StaticOrder so; int nb;
    __device__ void init(int M, int N, int nb_, int G_, int c_) { so.init(M, N, G_, c_); nb = nb_; }
    __device__ bool next(int i, Unit& u) const { if (!so.next(i / nb, u)) return false; u.g = i % nb; return true; }
    __device__ __forceinline__ void a_ready(const Unit&) const {}
    __device__ __forceinline__ void done(const Unit&) const {}
};
struct EpiGate3 {
    static constexpr bool PERM = true, AFTER_DRAIN = false;
    bf16_t* G3; const float* bias; const float* ss;
    __device__ __forceinline__ void operator()(const f32x4 (&acc)[2][2][4][2], const Unit& u, int wr, int wc, int fr, int fq) const {
        const int row0 = u.pm * BM + wr * 64 + fr, col0 = u.pn * BM + wc * 32 + 8 * fq;
        bf16_t* Gb = G3 + (size_t)u.g * 16384 * 1024; const float* bb = bias + u.g * 1024;
#pragma unroll
        for (int ai = 0; ai < 2; ++ai)
#pragma unroll
            for (int m = 0; m < 4; ++m) { const int row = row0 + ai * HALF + m * 16; const float r = rstd1024(ss, row);
#pragma unroll
                for (int bj = 0; bj < 2; ++bj) { const int col = col0 + bj * HALF; const f32x4 b0 = *(const f32x4*)(bb + col), b1 = *(const f32x4*)(bb + col + 4); f32x4 g0, g1;
#pragma unroll
                    for (int j = 0; j < 4; ++j) { g0[j] = sigmoidf_(acc[ai][bj][m][0][j] * r + b0[j]); g1[j] = sigmoidf_(acc[ai][bj][m][1][j] * r + b1[j]); }
                    *(u32x4*)(Gb + (size_t)row * 1024 + col) = pack8(g0, g1); } }
    }
};
struct EpiMerge3 {
    static constexpr bool PERM = true, AFTER_DRAIN = false;
    bf16_t* G3; bf16_t* MG;
    __device__ __forceinline__ void operator()(const f32x4 (&acc)[2][2][4][2], const Unit& u, int wr, int wc, int fr, int fq) const {
        const int row0 = u.pm * BM + wr * 64 + fr, col0 = u.pn * BM + wc * 32 + 8 * fq;
        const bf16_t* Gb = G3 + (size_t)u.g * 16384 * 1024;
#pragma unroll
        for (int ai = 0; ai < 2; ++ai)
#pragma unroll
            for (int m = 0; m < 4; ++m) { const int row = row0 + ai * HALF + m * 16;
#pragma unroll
                for (int bj = 0; bj < 2; ++bj) { const size_t off = (size_t)row * 1024 + col0 + bj * HALF; f32x4 g0, g1; unpack8(*(const u32x4*)(Gb + off), g0, g1);
                    f32x4 v0 = g0 * acc[ai][bj][m][0], v1 = g1 * acc[ai][bj][m][1];
                    if (u.g != 0) { f32x4 m0, m1; unpack8(*(const u32x4*)(MG + off), m0, m1); v0 = v0 + m0; v1 = v1 + m1; }
                    if (u.g != 2) *(u32x4*)(MG + off) = pack8(v0, v1); else *(u32x4*)(G3 + off) = pack8(v0, v1); } }
    }
};
struct EpiInSplit {
    static constexpr bool PERM = true, AFTER_DRAIN = false;
    bf16_t* O; int ldo; bf16_t* UG; const float* ss;
    __device__ __forceinline__ void operator()(const f32x4 (&acc)[2][2][4][2], const Unit& u, int wr, int wc, int fr, int fq) const {
        const int row0 = u.pm * BM + wr * 64 + fr;
#pragma unroll
        for (int ai = 0; ai < 2; ++ai)
#pragma unroll
            for (int m = 0; m < 4; ++m) { const int row = row0 + ai * HALF + m * 16; const float r = rstd1024(ss, row);
#pragma unroll
                for (int bj = 0; bj < 2; ++bj) { const u32x4 w = pack8(acc[ai][bj][m][0] * r, acc[ai][bj][m][1] * r);
                    if (u.pn < 2) { const int cidx = u.pn * BM + bj * HALF + wc * 32 + 8 * fq, gg = cidx >> 4, h0 = cidx & 15, b = row >> 12, tt = row & 4095;
                        *(u32x4*)(UG + ((size_t)(gg * 512 + b * 128 + (tt >> 5)) * 768 + 256 + (tt & 31) * 16 + h0)) = w; }
                    else *(u32x4*)(O + (size_t)row * ldo + (u.pn - 2) * BM + bj * HALF + wc * 32 + 8 * fq) = w; } }
    }
};
struct EpiF32B {
    static constexpr bool PERM = true, AFTER_DRAIN = false;
    float* C; int ldc; size_t sC;
    __device__ __forceinline__ void operator()(const f32x4 (&acc)[2][2][4][2], const Unit& u, int wr, int wc, int fr, int fq) const {
        const int row0 = u.pm * BM + wr * 64 + fr, col0 = u.pn * BM + wc * 32 + 8 * fq;
#pragma unroll
        for (int ai = 0; ai < 2; ++ai)
#pragma unroll
            for (int m = 0; m < 4; ++m) { const int row = row0 + ai * HALF + m * 16;
#pragma unroll
                for (int bj = 0; bj < 2; ++bj) { float* p = C + (size_t)u.g * sC + (size_t)row * ldc + col0 + bj * HALF; *(f32x4*)p = acc[ai][bj][m][0]; *(f32x4*)(p + 4) = acc[ai][bj][m][1]; } }
    }
};
__device__ __forceinline__ float gelu_tanh_(float x) { const float z = 0.7978845608028654f * (x + 0.044715f * x * x * x); const float tt = 1.0f - 2.0f * __builtin_amdgcn_rcpf(__expf(2.0f * z) + 1.0f); return 0.5f * x * (1.0f + tt); }
struct EpiS5Y {
    static constexpr bool PERM = true, AFTER_DRAIN = false;
    bf16_t* YG;
    __device__ __forceinline__ void operator()(const f32x4 (&acc)[2][2][4][2], const Unit& u, int wr, int wc, int fr, int fq) const {
        const int row0 = u.pm * BM + wr * 64 + fr, col0 = u.pn * BM + wc * 32 + 8 * fq;
#pragma unroll
        for (int ai = 0; ai < 2; ++ai)
#pragma unroll
            for (int m = 0; m < 4; ++m) { const int r = row0 + ai * HALF + m * 16, b = r >> 7, c = r & 127;
#pragma unroll
                for (int bj = 0; bj < 2; ++bj) { const int n = col0 + bj * HALF, i = n >> 4, h0 = n & 15; f32x4 y0, y1;
#pragma unroll
                    for (int j = 0; j < 4; ++j) { y0[j] = gelu_tanh_(acc[ai][bj][m][0][j]); y1[j] = gelu_tanh_(acc[ai][bj][m][1][j]); }
                    *(u32x4*)(YG + (size_t)(b * 4096 + 32 * c + i) * 512 + 16 * u.g + h0) = pack8(y0, y1); } }
    }
};
template <class Epi, class Sched, bool ALIGN_EPI = false, bool SP2 = false>
__device__ __forceinline__ void gemm_phase(PG8_LAS unsigned char* lds, const Gemm g, const Sched& S, const Epi& E) {
    int tid_o = threadIdx.x; asm volatile("" : "+v"(tid_o));
    const int tid = tid_o, wid = __builtin_amdgcn_readfirstlane(tid >> 6), lane = tid & 63, wr = wid >> 2, wc = wid & 3, fr = lane & 15, fq = lane >> 4;
    const int K = g.K, nt = K / BK;
    unsigned voffA[2], voffB[2];
#pragma unroll
    for (int i = 0; i < 2; ++i) { int R, C; stage_rc(tid * 16 + i * 8192, R, C); const int Rb = Epi::PERM ? ((R & ~31) + perm32(R & 31)) : R;
        voffA[i] = (unsigned)(R * g.lda + C) * 2u; voffB[i] = (unsigned)(Rb * g.ldb + C) * 2u; }
    const size_t kstep = (size_t)(BK * 2);
    const size_t hstepA = (size_t)HALF * g.lda * 2, hstepB = (size_t)HALF * g.ldb * 2;
    const size_t tstepA = 2 * hstepA, tstepB = 2 * hstepB;
    const unsigned ldsw = (unsigned)wid * 1024u;
    const int aoff = lds_byte(wr * 64 + fr, fq * 8), boff = lds_byte(wc * 32 + fr, fq * 8);
#define PG8_SA(b, h) (((b) * 2 + (h)) * HTB)
#define PG8_SB(b, h) ((4 + (b) * 2 + (h)) * HTB)
#define PG8_STAGE(bufoff, gbase, voff) do { _Pragma("unroll") for (int _i = 0; _i < 2; ++_i) \
        __builtin_amdgcn_global_load_lds((const unsigned*)((const char*)(gbase) + (voff)[_i]), (PG8_LAS unsigned*)(lds + (bufoff) + ldsw + _i * 8192), 16, 0, 0); } while (0)
#define PG8_LDA(dst, b, h) do { _Pragma("unroll") for (int m = 0; m < 4; ++m) _Pragma("unroll") for (int k = 0; k < 2; ++k) dst[m][k] = *(const PG8_LAS bf16x8*)(lds + PG8_SA(b, h) + aoff + m * 2048 + k * 1024); } while (0)
#define PG8_LDB(dst, b, h) do { _Pragma("unroll") for (int n = 0; n < 2; ++n) _Pragma("unroll") for (int k = 0; k < 2; ++k) dst[n][k] = *(const PG8_LAS bf16x8*)(lds + PG8_SB(b, h) + boff + n * 2048 + k * 1024); } while (0)
#define PG8_MMA(ai, bj, At, Bt) do { __builtin_amdgcn_s_setprio(1); _Pragma("unroll") for (int m = 0; m < 4; ++m) _Pragma("unroll") for (int n = 0; n < 2; ++n) _Pragma("unroll") for (int k = 0; k < 2; ++k) \
        acc[ai][bj][m][n] = __builtin_amdgcn_mfma_f32_16x16x32_bf16(Bt[n][k], At[m][k], acc[ai][bj][m][n], 0, 0, 0); __builtin_amdgcn_s_setprio(0); } while (0)
#define PG8_WAIT_V(n) asm volatile("s_waitcnt vmcnt(" #n ")" ::: "memory")
#define PG8_WAIT_L(n) asm volatile("s_waitcnt lgkmcnt(" #n ")" ::: "memory")
#define PG8_BAR __builtin_amdgcn_s_barrier()
#define PG8_SCHED __builtin_amdgcn_sched_barrier(0)
    Unit cur, nxt; int ui = 0;
    if (!S.next(0, cur)) return;
    f32x4 acc[2][2][4][2];
#pragma unroll
    for (int a = 0; a < 2; ++a)
#pragma unroll
        for (int b = 0; b < 2; ++b)
#pragma unroll
            for (int m = 0; m < 4; ++m)
#pragma unroll
                for (int n = 0; n < 2; ++n) acc[a][b][m][n] = (f32x4){0.f, 0.f, 0.f, 0.f};
    bf16x8 At[4][2], B0[2][2], B1[2][2];
    const char* cA = PG8_ABASE(g, cur) + (size_t)cur.pm * tstepA; const char* cB = (const char*)g.Bt + (size_t)cur.g * g.sB + (size_t)cur.pn * tstepB;
    S.a_ready(cur);
    if constexpr (SP2) {
        PG8_STAGE(PG8_SB(0, 0), cB, voffB); PG8_STAGE(PG8_SB(0, 1), cB + hstepB, voffB); PG8_STAGE(PG8_SA(0, 0), cA, voffA); PG8_STAGE(PG8_SA(0, 1), cA + hstepA, voffA);
        if (wr == 1) PG8_BAR;
        PG8_WAIT_V(2); PG8_BAR;
        PG8_STAGE(PG8_SB(1, 0), cB + kstep, voffB); PG8_STAGE(PG8_SA(1, 0), cA + kstep, voffA); PG8_STAGE(PG8_SB(1, 1), cB + hstepB + kstep, voffB);
        PG8_WAIT_V(6); PG8_BAR;
    } else {
        PG8_STAGE(PG8_SB(0, 0), cB, voffB); PG8_STAGE(PG8_SA(0, 0), cA, voffA); PG8_STAGE(PG8_SB(0, 1), cB + hstepB, voffB); PG8_STAGE(PG8_SA(0, 1), cA + hstepA, voffA);
        if (wr == 1) PG8_BAR;
        PG8_WAIT_V(4); PG8_BAR;
        PG8_STAGE(PG8_SB(1, 0), cB + kstep, voffB); PG8_STAGE(PG8_SA(1, 0), cA + kstep, voffA); PG8_STAGE(PG8_SB(1, 1), cB + hstepB + kstep, voffB);
        PG8_WAIT_V(6); PG8_BAR;
    }
    for (;;) {
        const bool has_next = S.next(ui + 1, nxt);
        const char* nA = has_next ? PG8_ABASE(g, nxt) + (size_t)nxt.pm * tstepA : cA; const char* nB = has_next ? (const char*)g.Bt + (size_t)nxt.g * g.sB + (size_t)nxt.pn * tstepB : cB;
        for (int t = 0; t < nt; t += 2) {
            const bool last = (t == nt - 2);
            const char* a1 = cA + (size_t)(t + 1) * kstep;
            const char* a2 = last ? nA : cA + (size_t)(t + 2) * kstep; const char* b2 = last ? nB : cB + (size_t)(t + 2) * kstep;
            const char* a3 = a2 + kstep; const char* b3 = b2 + kstep;
            if (last && has_next) S.a_ready(nxt);
            if constexpr (SP2) {
            PG8_LDB(B0, 0, 0); PG8_LDB(B1, 0, 1); PG8_SCHED; PG8_LDA(At, 0, 0); PG8_STAGE(PG8_SA(1, 1), a1 + hstepA, voffA);
            PG8_WAIT_V(8); PG8_WAIT_L(0); PG8_BAR; PG8_MMA(0, 0, At, B0); PG8_MMA(0, 1, At, B1); PG8_BAR; PG8_SCHED;
            PG8_LDA(At, 0, 1); PG8_STAGE(PG8_SB(0, 0), b2, voffB); PG8_STAGE(PG8_SB(0, 1), b2 + hstepB, voffB); PG8_STAGE(PG8_SA(0, 0), a2, voffA);
            PG8_WAIT_V(8); PG8_WAIT_L(0); PG8_BAR; PG8_MMA(1, 0, At, B0); PG8_MMA(1, 1, At, B1); PG8_BAR; PG8_SCHED;
            PG8_LDB(B0, 1, 0); PG8_LDB(B1, 1, 1); PG8_SCHED; PG8_LDA(At, 1, 0); PG8_STAGE(PG8_SA(0, 1), a2 + hstepA, voffA);
            PG8_WAIT_V(8); PG8_WAIT_L(0); PG8_BAR; PG8_MMA(0, 0, At, B0); PG8_MMA(0, 1, At, B1); PG8_BAR; PG8_SCHED;
            PG8_LDA(At, 1, 1); PG8_STAGE(PG8_SB(1, 0), b3, voffB); PG8_STAGE(PG8_SB(1, 1), b3 + hstepB, voffB); PG8_STAGE(PG8_SA(1, 0), a3, voffA);
            PG8_WAIT_V(8); PG8_WAIT_L(0); PG8_BAR; PG8_MMA(1, 0, At, B0); PG8_MMA(1, 1, At, B1); PG8_BAR; PG8_SCHED;
            } else {
            PG8_LDB(B0, 0, 0); PG8_SCHED; PG8_LDA(At, 0, 0); PG8_STAGE(PG8_SA(1, 1), a1 + hstepA, voffA);
            PG8_WAIT_L(8); PG8_BAR; PG8_WAIT_L(0); PG8_MMA(0, 0, At, B0); PG8_BAR; PG8_SCHED;
            PG8_LDB(B1, 0, 1); PG8_STAGE(PG8_SB(0, 0), b2, voffB);
            PG8_BAR; PG8_WAIT_L(0); PG8_MMA(0, 1, At, B1); PG8_BAR;
            PG8_LDA(At, 0, 1); PG8_STAGE(PG8_SA(0, 0), a2, voffA);
            PG8_BAR; PG8_WAIT_L(0); PG8_MMA(1, 0, At, B0); PG8_BAR; PG8_SCHED;
            PG8_STAGE(PG8_SB(0, 1), b2 + hstepB, voffB);
            PG8_WAIT_V(6); PG8_BAR; PG8_MMA(1, 1, At, B1); PG8_BAR;
            PG8_LDB(B0, 1, 0); PG8_SCHED; PG8_LDA(At, 1, 0); PG8_STAGE(PG8_SA(0, 1), a2 + hstepA, voffA);
            PG8_WAIT_L(8); PG8_BAR; PG8_WAIT_L(0); PG8_MMA(0, 0, At, B0); PG8_BAR; PG8_SCHED;
            PG8_LDB(B1, 1, 1); PG8_STAGE(PG8_SB(1, 0), b3, voffB);
            PG8_BAR; PG8_WAIT_L(0); PG8_MMA(0, 1, At, B1); PG8_BAR;
            PG8_LDA(At, 1, 1); PG8_STAGE(PG8_SA(1, 0), a3, voffA);
            PG8_BAR; PG8_WAIT_L(0); PG8_MMA(1, 0, At, B0); PG8_BAR; PG8_SCHED;
            PG8_STAGE(PG8_SB(1, 1), b3 + hstepB, voffB);
            PG8_WAIT_V(6); PG8_BAR; PG8_MMA(1, 1, At, B1); PG8_BAR;
            }
        }
        if constexpr (ALIGN_EPI) { if (wr == 0) PG8_BAR; }
        if constexpr (!Epi::AFTER_DRAIN) { E(acc, cur, wr, wc, fr, fq); S.done(cur); }
        if (!has_next) break;
#pragma unroll
        for (int a = 0; a < 2; ++a)
#pragma unroll
            for (int b = 0; b < 2; ++b)
#pragma unroll
                for (int m = 0; m < 4; ++m)
#pragma unroll
                    for (int n = 0; n < 2; ++n) acc[a][b][m][n] = (f32x4){0.f, 0.f, 0.f, 0.f};
        cur = nxt; cA = nA; cB = nB; ++ui;
        if constexpr (ALIGN_EPI) { if (wr == 1) PG8_BAR; }
    }
    PG8_WAIT_V(0);
    if constexpr (!ALIGN_EPI) { if (wr == 0) PG8_BAR; }
    PG8_BAR;
    if constexpr (Epi::AFTER_DRAIN) { E.fused(acc, cur, wr, wc, fr, fq, lds, wid, lane); S.done(cur); }
#undef PG8_SA
#undef PG8_SB
#undef PG8_STAGE
#undef PG8_LDA
#undef PG8_LDB
#undef PG8_MMA
#undef PG8_WAIT_V
#undef PG8_WAIT_L
#undef PG8_BAR
#undef PG8_SCHED
}
}
#include <hip/hip_bf16.h>
namespace attn_body {
using bf16=__hip_bfloat16;
using bf16x8=__attribute__((ext_vector_type(8)))short;
using s16x4=__attribute__((ext_vector_type(4)))short;
using f32x16=__attribute__((ext_vector_type(16)))float;
using u32x4=__attribute__((ext_vector_type(4)))unsigned;
constexpr int BATCH=4,NHEAD=8,NKV=2,SEQ=4096,D=64,DM=3072,DMO=512;
constexpr int NW=8,QBLK=32,QB=QBLK*NW,KVBLK=64,NQB=SEQ/QB;
constexpr int ATTN_PITCH=DM, ATTN_UNIT_ROWS=QB;
__device__ __forceinline__ int crow(int r,int hi){return (r&3)+8*(r>>2)+4*hi;}
#define SBAR() __builtin_amdgcn_sched_barrier(0)
__device__ __forceinline__ void cmask(f32x16&p0,f32x16&p1,int jb,int qrel,int hi){
  const float NEG=-INFINITY; int kb=64*jb+4*hi;
  #pragma unroll
  for(int r=0;r<16;++r){int kv=kb+(r&3)+8*(r>>2); if(kv>qrel)p0[r]=NEG; if(kv+32>qrel)p1[r]=NEG;}
}

constexpr int NSLOT=3, SLOTB=8192;
constexpr int LDS_K=0, LDS_V=NSLOT*SLOTB, LDS_WS=2*NSLOT*SLOTB, LDS_OST=LDS_WS+NW*64*4, LDS_BYTES=LDS_OST+NW*4096;
constexpr float C2=0.125f*1.4426950408889634f;
__device__ __forceinline__ void glds16(const void*gsrc,unsigned lds_dst){unsigned keep;
  asm volatile("s_mov_b32 %0, m0\n\ts_mov_b32 m0, %2\n\ts_nop 0\n\tglobal_load_lds_dwordx4 %1, off\n\ts_mov_b32 m0, %0":"=&s"(keep):"v"(gsrc),"s"(lds_dst):"memory");}
__device__ __forceinline__ float max3f(float a,float b,float c){float r;asm("v_max3_f32 %0, %1, %2, %3":"=v"(r):"v"(a),"v"(b),"v"(c));return r;}
__device__ __forceinline__ float max2f(float a,float b){float r;asm("v_max_f32_e32 %0, %1, %2":"=v"(r):"v"(a),"v"(b));return r;}
__device__ __forceinline__ float fadd_s(float a,float b){float r;asm("v_add_f32_e32 %0, %1, %2":"=v"(r):"v"(a),"v"(b));return r;}
__device__ __forceinline__ float fsub_s(float a,float b){float r;asm("v_sub_f32_e32 %0, %1, %2":"=v"(r):"v"(a),"v"(b));return r;}
typedef float f32x2_t __attribute__((ext_vector_type(2))); typedef __bf16 bf16x2_t __attribute__((ext_vector_type(2)));
__device__ __forceinline__ unsigned cvtpk_s(float lo,float hi){f32x2_t v={lo,hi};bf16x2_t b=__builtin_convertvector(v,bf16x2_t);return __builtin_bit_cast(unsigned,b);}
#define WAIT_BAR(N) asm volatile("s_waitcnt vmcnt(" #N ") lgkmcnt(0)\n\ts_barrier":::"memory")

__device__ __forceinline__ void qkt(f32x16&p0,f32x16&p1,const char*Kslot,const bf16x8*qr,const f32x16&negm,int r32,int hi){
  const char*kb=Kslot+hi*1024+r32*16;
  #pragma unroll
  for(int d0=0;d0<4;++d0){
    const bf16x8 b0=*reinterpret_cast<const bf16x8*>(kb+d0*2048);
    const bf16x8 b1=*reinterpret_cast<const bf16x8*>(kb+d0*2048+512);
    if(d0==0){p0=__builtin_amdgcn_mfma_f32_32x32x16_bf16(b0,qr[0],negm,0,0,0);p1=__builtin_amdgcn_mfma_f32_32x32x16_bf16(b1,qr[0],negm,0,0,0);}
    else{p0=__builtin_amdgcn_mfma_f32_32x32x16_bf16(b0,qr[d0],p0,0,0,0);p1=__builtin_amdgcn_mfma_f32_32x32x16_bf16(b1,qr[d0],p1,0,0,0);}}
}
typedef __attribute__((address_space(3))) const char* lds_cptr;
typedef short v4i16_t __attribute__((ext_vector_type(4)));
__device__ __forceinline__ void kload8(bf16x8*kf,lds_cptr kp){
  kf[0]=*(const __attribute__((address_space(3))) bf16x8*)(kp);      kf[1]=*(const __attribute__((address_space(3))) bf16x8*)(kp+512);
  kf[2]=*(const __attribute__((address_space(3))) bf16x8*)(kp+2048); kf[3]=*(const __attribute__((address_space(3))) bf16x8*)(kp+2560);
  kf[4]=*(const __attribute__((address_space(3))) bf16x8*)(kp+4096); kf[5]=*(const __attribute__((address_space(3))) bf16x8*)(kp+4608);
  kf[6]=*(const __attribute__((address_space(3))) bf16x8*)(kp+6144); kf[7]=*(const __attribute__((address_space(3))) bf16x8*)(kp+6656);
}
__device__ __forceinline__ void kload2(bf16x8*kf,lds_cptr kp,int j){ kf[2*j]=*(const __attribute__((address_space(3))) bf16x8*)(kp+j*2048); kf[2*j+1]=*(const __attribute__((address_space(3))) bf16x8*)(kp+j*2048+512); }
__device__ __forceinline__ s16x4 vtr(lds_cptr p){ return __builtin_bit_cast(s16x4,__builtin_amdgcn_ds_read_tr16_b64_v4i16((__attribute__((address_space(3))) v4i16_t*)p)); }
__device__ __forceinline__ float rowmax(const f32x16&p0,const f32x16&p1){
  float a=max3f(p0[0],p0[1],p1[0]),b=max3f(p0[2],p0[3],p1[1]);a=max3f(a,p1[2],p1[3]);
  #pragma unroll
  for(int r=4;r<16;r+=4){a=max3f(a,p0[r],p0[r+1]);b=max3f(b,p0[r+2],p0[r+3]);a=max3f(a,p1[r],p1[r+1]);b=max3f(b,p1[r+2],p1[r+3]);}
  const float m=max2f(a,b);
  auto rr=__builtin_amdgcn_permlane32_swap(__float_as_uint(m),__float_as_uint(m),false,false);
  return max2f(__uint_as_float(rr[0]),__uint_as_float(rr[1]));
}
__device__ __forceinline__ void pv(f32x16*o,int vb,bf16x8 pa0,bf16x8 pa1,bf16x8 pa2,bf16x8 pa3){
  #pragma unroll
  for(int d0=0;d0<2;++d0){s16x4 lo[4],hi[4];
    #pragma unroll
    for(int ks=0;ks<4;++ks){
      asm volatile("ds_read_b64_tr_b16 %0,%1 offset:%c2":"=&v"(lo[ks]):"v"(vb),"i"(d0*4096+ks*1024):"memory");
      asm volatile("ds_read_b64_tr_b16 %0,%1 offset:%c2":"=&v"(hi[ks]):"v"(vb),"i"(d0*4096+ks*1024+512):"memory");}
    asm volatile("s_waitcnt lgkmcnt(0)":::"memory");SBAR();
    #define PK(k) (bf16x8){lo[k][0],lo[k][1],lo[k][2],lo[k][3],hi[k][0],hi[k][1],hi[k][2],hi[k][3]}
    o[d0]=__builtin_amdgcn_mfma_f32_32x32x16_bf16(pa0,PK(0),o[d0],0,0,0);
    o[d0]=__builtin_amdgcn_mfma_f32_32x32x16_bf16(pa1,PK(1),o[d0],0,0,0);
    o[d0]=__builtin_amdgcn_mfma_f32_32x32x16_bf16(pa2,PK(2),o[d0],0,0,0);
    o[d0]=__builtin_amdgcn_mfma_f32_32x32x16_bf16(pa3,PK(3),o[d0],0,0,0);
    #undef PK
  }
}

#ifndef ATTN_STORE16
#define ATTN_STORE16(p,v) (*(u32x4*)(p)=(v))
#endif
template<int THRL> __device__ __forceinline__ void attn_unit(int b,int h,int qb,const bf16*Q,const bf16*__restrict__ K,const bf16*__restrict__ V,bf16*O,char*shm){
  int tid_o=threadIdx.x; asm volatile("":"+v"(tid_o)); const int tid=tid_o,lane=tid&63,r32=lane&31,hi=lane>>5; const int wid=__builtin_amdgcn_readfirstlane(tid>>6);
  const long rowbase=(long)b*SEQ; const int q0=qb*QB;
  const bf16*Qw=Q+(rowbase+q0+wid*QBLK)*DM+h*D;
  const bf16*Kh=K+rowbase*DM+(h>>2)*D,*Vh=V+rowbase*DM+(h>>2)*D;
  const unsigned lds0=(unsigned)(uintptr_t)shm;
  float*wsf=(float*)(shm+LDS_WS)+wid*64;
  const bf16*ksrc=Kh+(long)lane*DM+wid*8;
  const bf16*vsrc=Vh+(long)(16*(wid&3)+(lane>>2))*DM+(wid>>2)*32+(lane&3)*8;
  const unsigned kdst=lds0+LDS_K+wid*1024, vdst=lds0+LDS_V+wid*1024;
  #define DMA_K(t,slot) glds16(ksrc+(long)(t)*KVBLK*DM,(unsigned)__builtin_amdgcn_readfirstlane(kdst+(slot)))
  #define DMA_V(t,slot) glds16(vsrc+(long)(t)*KVBLK*DM,(unsigned)__builtin_amdgcn_readfirstlane(vdst+(slot)))
  const int vb0=(int)(lds0+LDS_V)+((lane>>4)&1)*32+(lane&3)*8+(4*hi+((lane&15)>>2))*64;
  const char*Kbase=shm+LDS_K; bf16x8 kf[8];
  const lds_cptr shm3=(lds_cptr)shm; const lds_cptr kp0=shm3+LDS_K+hi*1024+r32*16; const lds_cptr vp0=shm3+LDS_V+((lane>>4)&1)*32+(lane&3)*8+(4*hi+((lane&15)>>2))*64;
  const int NT=SEQ/KVBLK;
  DMA_K(0,0);DMA_V(0,0);DMA_K(1,SLOTB);
  bf16x8 qr[4];
  #pragma unroll
  for(int d0=0;d0<4;++d0)qr[d0]=*reinterpret_cast<const bf16x8*>(&Qw[(long)r32*DM+d0*16+hi*8]);
  float mhat=0.f,l_reg=0.f;f32x16 o[2];o[0]=f32x16{};o[1]=f32x16{};f32x16 negm=f32x16{};asm volatile("":"+v"(negm));

  #define CMASK(P0,P1,t) do{}while(0)
  bool resc=false;
  #define START(P0,P1) do{ const float rm=rowmax(P0,P1); resc=false; \
    { const float dl=rm; mhat=fadd_s(mhat,dl); \
      _Pragma("unroll") for(int r=0;r<16;++r){P0[r]=fsub_s(P0[r],dl);P1[r]=fsub_s(P1[r],dl);} \
      _Pragma("unroll") for(int r=0;r<16;++r)negm[r]=-mhat; asm volatile("":"+v"(negm)); } \
    _Pragma("unroll") for(int r=0;r<16;++r)P0[r]=__builtin_amdgcn_exp2f(P0[r]); }while(0)
  #define RESC() do{ if(resc){ asm volatile("s_waitcnt lgkmcnt(0)":::"memory"); \
      _Pragma("unroll") for(int d_=0;d_<2;++d_) _Pragma("unroll") for(int r=0;r<16;++r)o[d_][r]*=wsf[crow(r,hi)]; } }while(0)
  f32x16 pA0,pA1,pB0,pB1;
  int sl_prev=0,sl_cur=0,sl_next=SLOTB;
  #define ROT() do{sl_prev=sl_cur;sl_cur=sl_next;sl_next=(sl_next==(NSLOT-1)*SLOTB)?0:sl_next+SLOTB;}while(0)
  DMA_K(2,2*SLOTB);
  WAIT_BAR(3);
  qkt(pA0,pA1,Kbase,qr,negm,r32,hi);asm volatile("s_nop 15\n\ts_nop 7":"+v"(pA0),"+v"(pA1));CMASK(pA0,pA1,0);
  START(pA0,pA1);
  _Pragma("unroll") for(int r=0;r<16;++r)pA1[r]=__builtin_amdgcn_exp2f(pA1[r]);
  WAIT_BAR(0);
  DMA_K(3,0);DMA_V(1,SLOTB);
  ROT();
  kload8(kf,kp0+sl_cur);
  WAIT_BAR(2);
  s16x4 vlo[8],vhi[8]; u32x4 pw0,pw1,pw2,pw3;
  #define PKW(P,B) cvtpk_s(P[B],P[B+1])
  #define PAF(k) __builtin_bit_cast(bf16x8,pw##k)
  #define VFR(i) (bf16x8){vlo[i][0],vlo[i][1],vlo[i][2],vlo[i][3],vhi[i][0],vhi[i][1],vhi[i][2],vhi[i][3]}
  #define PIN(x) asm volatile("":"+v"(x))
  #define MX3(a,b,c) __builtin_fmaxf(__builtin_fmaxf((a),(b)),(c))
  #define GAPA(MF,A0,A1,A2,A3,W0,W1,PW) do{ MF; sacc+=A0; sacc+=A1; sacc+=A2; sacc+=A3; PIN(sacc); W0; W1; PIN(PW); SBAR(); }while(0)
  #define EX(v) __builtin_amdgcn_exp2f(v)
  #define GAPB(MF,X,B) do{ MF; X[B]=EX(X[B]); X[B+1]=EX(X[B+1]); X[B+2]=EX(X[B+2]); X[B+3]=EX(X[B+3]); PIN(X); SBAR(); }while(0)
  #define VRD(i) do{ vlo[i]=vtr(vp_+(((i)>>2)*4096+((i)&3)*1024)); vhi[i]=vtr(vp_+(((i)>>2)*4096+((i)&3)*1024+512)); }while(0)
  #define KRD(G,j) do{ if(G){ kload2(kf,kp0+sl_next,j); SBAR(); } }while(0)
  #define STEP(C0,C1,P0,P1,t,GK,GV,GL) do{ SBAR(); \
    const lds_cptr vp_=vp0+sl_prev; \
    VRD(0); SBAR(); float sacc=(P0[0]+P0[1]); \
    GAPA(C0=__builtin_amdgcn_mfma_f32_32x32x16_bf16(kf[0],qr[0],negm,0,0,0), P0[2],P0[3],P0[4],P0[5],     pw0[0]=PKW(P0,0), pw0[1]=PKW(P0,2), pw0); \
    VRD(4); SBAR(); GAPA(C1=__builtin_amdgcn_mfma_f32_32x32x16_bf16(kf[1],qr[0],negm,0,0,0), P0[6],P0[7],P0[8],P0[9],     pw0[2]=PKW(P0,4), pw0[3]=PKW(P0,6), pw0); \
    VRD(1); SBAR(); GAPA(C0=__builtin_amdgcn_mfma_f32_32x32x16_bf16(kf[2],qr[1],C0,0,0,0),   P0[10],P0[11],P0[12],P0[13], pw1[0]=PKW(P0,8), pw1[1]=PKW(P0,10), pw1); \
    VRD(5); SBAR(); GAPA(C1=__builtin_amdgcn_mfma_f32_32x32x16_bf16(kf[3],qr[1],C1,0,0,0),   P0[14],P0[15],P1[0],P1[1],   pw1[2]=PKW(P0,12),pw1[3]=PKW(P0,14), pw1); \
    VRD(2); SBAR(); GAPA(C0=__builtin_amdgcn_mfma_f32_32x32x16_bf16(kf[4],qr[2],C0,0,0,0),   P1[2],P1[3],P1[4],P1[5],     pw2[0]=PKW(P1,0), pw2[1]=PKW(P1,2), pw2); \
    VRD(6); SBAR(); GAPA(C1=__builtin_amdgcn_mfma_f32_32x32x16_bf16(kf[5],qr[2],C1,0,0,0),   P1[6],P1[7],P1[8],P1[9],     pw2[2]=PKW(P1,4), pw2[3]=PKW(P1,6), pw2); \
    VRD(3); SBAR(); GAPA(C0=__builtin_amdgcn_mfma_f32_32x32x16_bf16(kf[6],qr[3],C0,0,0,0),   P1[10],P1[11],P1[12],P1[13], pw3[0]=PKW(P1,8), pw3[1]=PKW(P1,10), pw3); \
    VRD(7); SBAR(); GAPA(C1=__builtin_amdgcn_mfma_f32_32x32x16_bf16(kf[7],qr[3],C1,0,0,0),   P1[14],P1[15],0.f,0.f,       pw3[2]=PKW(P1,12),pw3[3]=PKW(P1,14), pw3); \
    l_reg+=sacc; \
    if(GK){DMA_K((t)+3,sl_cur);} if(GV){DMA_V((t)+1,sl_next);} \
    CMASK(C0,C1,t); \
    { float a=MX3(C0[0],C0[1],C1[0]),b=MX3(C0[2],C0[3],C1[1]); a=MX3(a,C1[2],C1[3]); \
      _Pragma("unroll") for(int r=4;r<16;r+=4){a=MX3(a,C0[r],C0[r+1]);b=MX3(b,C0[r+2],C0[r+3]);a=MX3(a,C1[r],C1[r+1]);b=MX3(b,C1[r+2],C1[r+3]);} \
      float rm=__builtin_fmaxf(a,b); { auto rr=__builtin_amdgcn_permlane32_swap(__float_as_uint(rm),__float_as_uint(rm),false,false); rm=__builtin_fmaxf(__uint_as_float(rr[0]),__uint_as_float(rr[1])); } \
      resc=false; \
      if(__builtin_expect(__any(rm>(float)THRL),0)){ const float dl=__builtin_fmaxf(rm,0.f); mhat+=dl; \
        _Pragma("unroll") for(int r=0;r<16;++r){C0[r]-=dl;C1[r]-=dl;} \
        _Pragma("unroll") for(int r=0;r<16;++r)negm[r]=-mhat; asm volatile("":"+v"(negm)); \
        const float f=__builtin_amdgcn_exp2f(-dl); l_reg*=f; if(hi==0)wsf[r32]=f; resc=true; } } \
    SBAR(); \
    GAPB(o[0]=__builtin_amdgcn_mfma_f32_32x32x16_bf16(PAF(0),VFR(0),o[0],0,0,0), C0,0); \
    GAPB(o[1]=__builtin_amdgcn_mfma_f32_32x32x16_bf16(PAF(0),VFR(4),o[1],0,0,0), C0,4); \
    KRD(GL,0); GAPB(o[0]=__builtin_amdgcn_mfma_f32_32x32x16_bf16(PAF(1),VFR(1),o[0],0,0,0), C0,8); \
    KRD(GL,1); GAPB(o[1]=__builtin_amdgcn_mfma_f32_32x32x16_bf16(PAF(1),VFR(5),o[1],0,0,0), C0,12); \
    KRD(GL,2); GAPB(o[0]=__builtin_amdgcn_mfma_f32_32x32x16_bf16(PAF(2),VFR(2),o[0],0,0,0), C1,0); \
    KRD(GL,3); GAPB(o[1]=__builtin_amdgcn_mfma_f32_32x32x16_bf16(PAF(2),VFR(6),o[1],0,0,0), C1,4); \
    GAPB(o[0]=__builtin_amdgcn_mfma_f32_32x32x16_bf16(PAF(3),VFR(3),o[0],0,0,0), C1,8); \
    GAPB(o[1]=__builtin_amdgcn_mfma_f32_32x32x16_bf16(PAF(3),VFR(7),o[1],0,0,0), C1,12); \
    }while(0)
  int t=1;
  #undef CMASK
  #define CMASK(P0,P1,t) do{}while(0)
  for(;t+5<NT;t+=2){
    STEP(pB0,pB1,pA0,pA1,t,true,true,true);     WAIT_BAR(2); RESC(); ROT();
    STEP(pA0,pA1,pB0,pB1,t+1,true,true,true);   WAIT_BAR(2); RESC(); ROT();
  }
  #undef CMASK
  #define CMASK(P0,P1,t) do{}while(0)
  #define ENDW(tt) do{ if((tt)+3<NT){WAIT_BAR(2);} else if((tt)+2<NT){WAIT_BAR(1);} else {WAIT_BAR(0);} }while(0)
  for(;t+1<NT;t+=2){
    STEP(pB0,pB1,pA0,pA1,t,(t+3<NT),(t+1<NT),(t+1<NT));       ENDW(t);   RESC(); ROT();
    STEP(pA0,pA1,pB0,pB1,t+1,(t+4<NT),(t+2<NT),(t+2<NT));     ENDW(t+1); RESC(); ROT();
  }
  STEP(pB0,pB1,pA0,pA1,NT-1,false,false,false); RESC();
  { float sacc=pB0[0]+pB0[1]; _Pragma("unroll") for(int r=2;r<16;++r)sacc+=pB0[r]; _Pragma("unroll") for(int r=0;r<16;++r)sacc+=pB1[r]; l_reg+=sacc;
    pw0=(u32x4){PKW(pB0,0),PKW(pB0,2),PKW(pB0,4),PKW(pB0,6)};pw1=(u32x4){PKW(pB0,8),PKW(pB0,10),PKW(pB0,12),PKW(pB0,14)};pw2=(u32x4){PKW(pB1,0),PKW(pB1,2),PKW(pB1,4),PKW(pB1,6)};pw3=(u32x4){PKW(pB1,8),PKW(pB1,10),PKW(pB1,12),PKW(pB1,14)};
    SBAR(); pv(o,vb0+sl_cur,PAF(0),PAF(1),PAF(2),PAF(3)); }
  #undef PKW
  #undef PAF
  #undef VFR
  #undef PIN
  #undef MX3
  #undef GAPA
  #undef GAPB
  #undef EX
  #undef VRD
  #undef KRD
  #undef STEP
  #undef ENDW
  {auto rr=__builtin_amdgcn_permlane32_swap(__float_as_uint(l_reg),__float_as_uint(l_reg),false,false);l_reg=__uint_as_float(rr[0])+__uint_as_float(rr[1]);}
  if(hi==0)wsf[32+r32]=l_reg;asm volatile("s_waitcnt lgkmcnt(0)":::"memory");
  float rli[16];
  #pragma unroll
  for(int r=0;r<16;++r)rli[r]=__builtin_amdgcn_rcpf(wsf[32+crow(r,hi)]);
  bf16*Ow=O+(rowbase+q0+wid*QBLK)*DMO+h*D;
  { bf16*stg=(bf16*)(shm+LDS_OST)+wid*2048;
    #pragma unroll
    for(int r=0;r<16;++r){const int orow=crow(r,hi);
      #pragma unroll
      for(int d0=0;d0<2;++d0)stg[orow*64+d0*32+r32]=__float2bfloat16(o[d0][r]*rli[r]);}
    asm volatile("s_waitcnt lgkmcnt(0)":::"memory");
    #pragma unroll
    for(int i=0;i<4;++i){const int row=i*8+(lane>>3),ch=lane&7; const u32x4 v=*(const u32x4*)(stg+row*64+ch*8); ATTN_STORE16(Ow+(long)row*DMO+ch*8,v);} }
  asm volatile("s_waitcnt lgkmcnt(0)\n\ts_barrier":::"memory");
  #undef DMA_K
  #undef DMA_V
  #undef CMASK
  #undef START
  #undef RESC
  #undef ROT
}
constexpr int ATTN_LDS_BYTES=LDS_BYTES;
struct AttnTensors { const bf16* Q; const bf16* K; const bf16* V; bf16* O; };
struct AttnUnit { int bh; int qb; };
struct StaticOrder {
  int vcu, G;
  __device__ __forceinline__ explicit StaticOrder(int grid,int block):vcu((grid%8==0)?(block%8)*(grid/8)+block/8:block),G(grid){}
  __device__ __forceinline__ bool next(int i,AttnUnit&u)const{ const int L=i*G+vcu; if(L>=BATCH*NHEAD*NQB)return false; u.bh=L/NQB; u.qb=L%NQB; return true; }
  __device__ __forceinline__ void a_ready(const AttnUnit&)const{}
  __device__ __forceinline__ void done(const AttnUnit&)const{}
};
template<class Sched,int THRL=8> __device__ __forceinline__ void attn_phase(char*lds,const AttnTensors&T,const Sched&S){
  AttnUnit u;
  for(int i=0;S.next(i,u);++i){ S.a_ready(u); attn_unit<THRL>(u.bh/NHEAD,u.bh%NHEAD,u.qb,T.Q,T.K,T.V,T.O,lds); S.done(u); }
}
#undef SBAR
#undef WAIT_BAR
}
#define LAS __attribute__((address_space(3)))
typedef unsigned short bf16r;
typedef unsigned v4u __attribute__((ext_vector_type(4)));
typedef float f32x4 __attribute__((ext_vector_type(4)));
constexpr int M = 16384, DMODEL = 1024, FF = 2816, NPROJ = 3072, NWIN = 3584, SEQ = 4096, NWAVES = 8;
constexpr int LDS_BYTES = 147456;
constexpr int STOP_L = 99, STOP_P = 99;
constexpr size_t MiB = 1u << 20;
constexpr size_t WS_TAB = 0;
constexpr size_t WS_SS = 53 * MiB;
constexpr size_t WS_W = 1 * MiB;
constexpr size_t W_GU1 = WS_W, W_D1 = W_GU1 + (size_t)5632 * 1024 * 2, W_GU2 = W_D1 + (size_t)1024 * 2816 * 2, W_D2 = W_GU2 + (size_t)5632 * 1024 * 2,
                 W_IN = W_D2 + (size_t)1024 * 2816 * 2, W_MG = W_IN + (size_t)NWIN * 1024 * 2, W_GLU = W_MG + (size_t)3072 * 1024 * 2, W_BR = W_GLU + (size_t)512 * 512 * 2,
                 W_OUT = W_BR + (size_t)3 * 1024 * 512 * 2, W_END = W_OUT + (size_t)1024 * 1024 * 2;
constexpr size_t WS_XB = 56 * MiB, WS_BIG = 88 * MiB  , WS_UG = 184 * MiB  , WS_W1T = 208 * MiB  ,
                 WS_BTY = 216 * MiB  , WS_E = 240 * MiB  , WS_KT = 256 * MiB  ,
                 WS_ACC = 200 * MiB, WS_MG16 = 216 * MiB  , WS_YS5 = WS_UG, WS_GEB = 232 * MiB, WS_YGLA = 248 * MiB, WS_END = 264 * MiB;
static_assert(W_END <= WS_SS && WS_SS + 3 * (size_t)M * 64 <= WS_XB, "weights fit");
constexpr int PC_GQ = 0, PC_GK = 512, PC_GV = 1024, PC_GG = 1536, PC_AQ = 2048, PC_AK = 2560, PC_AV = 2688, PC_Z = 2816;

struct Args { const float* in[32]; float* out; unsigned char* ws; };

__device__ __forceinline__ unsigned f2bf(float f) { unsigned u = __builtin_bit_cast(unsigned, f); return (u + 0x7fffu + ((u >> 16) & 1u)) >> 16; }
__device__ __forceinline__ unsigned pk2(float lo, float hi) { return f2bf(lo) | (f2bf(hi) << 16); }
__device__ __forceinline__ float bf2f(bf16r v) { return __builtin_bit_cast(float, (unsigned)v << 16); }
__device__ __forceinline__ float wave_sum(float v) {
#pragma unroll
    for (int o = 1; o < 64; o <<= 1) v += __shfl_xor(v, o);
    return v;
}
#define LDS_WAIT() asm volatile("s_waitcnt lgkmcnt(0)" ::: "memory")

template <class P, class Gn> __device__ __forceinline__ void conv_item(P src, Gn gain, int K, int Nd, bf16r* WT, LAS float* scr, int item, int lane) {
    const int nblk = Nd / 32, kb = item / nblk, nb = item % nblk, k0 = 64 * kb, n0 = 32 * nb;
    const int nq = lane & 7, kr = lane >> 3;
    f32x4 v[8];
#pragma unroll
    for (int i = 0; i < 8; ++i) { const float* s = src(k0 + 8 * i + kr, n0 + 4 * nq); v[i] = s ? *(const f32x4*)s : (f32x4){0.f, 0.f, 0.f, 0.f}; }
#pragma unroll
    for (int i = 0; i < 8; ++i) { const int kk = 8 * i + kr; const float gk = gain(k0 + kk); LAS float* d = scr + kk * 33 + 4 * nq; d[0] = v[i][0] * gk; d[1] = v[i][1] * gk; d[2] = v[i][2] * gk; d[3] = v[i][3] * gk; }
    LDS_WAIT(); asm volatile("" ::: "memory");
    const int c = lane & 7;
#pragma unroll
    for (int j = 0; j < 4; ++j) { const int n = (lane >> 3) + 8 * j; const LAS float* s = scr + (8 * c) * 33 + n;
        v4u o; o.x = pk2(s[0 * 33], s[1 * 33]); o.y = pk2(s[2 * 33], s[3 * 33]); o.z = pk2(s[4 * 33], s[5 * 33]); o.w = pk2(s[6 * 33], s[7 * 33]);
        *(v4u*)(WT + (size_t)(n0 + n) * K + k0 + 8 * c) = o; }
    LDS_WAIT(); asm volatile("" ::: "memory");
}
template <class P, class Gn> __device__ __forceinline__ void conv_all(P src, Gn gain, int K, int Nd, bf16r* WT, LAS float* scr, int gw, int NGW, int lane) {
    const int items = (K / 64) * (Nd / 32);
    for (int it = gw; it < items; it += NGW) conv_item(src, gain, K, Nd, WT, scr, it, lane);
}

__device__ __forceinline__ float gelu_tanh(float x) { const float z = 0.7978845608028654f * (x + 0.044715f * x * x * x); const float t = 1.0f - 2.0f * __builtin_amdgcn_rcpf(__expf(2.0f * z) + 1.0f); return 0.5f * x * (1.0f + t); }
__device__ __forceinline__ float silu_(float x) { return x * __builtin_amdgcn_rcpf(1.0f + __expf(-x)); }


constexpr size_t WS_S5X = 264 * MiB;
constexpr size_t WS_GDT = 266 * MiB;
constexpr size_t WS_GE = WS_GEB;
constexpr size_t WS_NEED = 267 * MiB;
typedef float f32x2v __attribute__((ext_vector_type(2)));
template <bool OUT> __device__ __forceinline__ void gla_unit(const float* const* TAB, int l, int unit, int tid, const bf16r* PROJ, float* ACC, bf16r* OB, float* GE, float* GDT, LAS unsigned char* ldsl) {
    const int c = unit & 7, h = (unit >> 3) & 3, b = (unit >> 5) & 3, dir = unit >> 7;
    LAS float* sa = (LAS float*)ldsl; LAS float* sq = sa + 1024; LAS float* sk = sq + 1024; LAS float* sv = sk + 1024; LAS float* sop = sv + 1024;
    const int dks = tid & 127;
    const int dvg = tid & 31, dkg = tid >> 5;
    f32x2v S2[8][2];
#pragma unroll
    for (int j = 0; j < 8; ++j) { S2[j][0] = (f32x2v){0.f, 0.f}; S2[j][1] = (f32x2v){0.f, 0.f}; }
    if (OUT) {
        for (int cc = 0; cc < 8; ++cc) { const int c2 = dir ? 7 - cc : cc; if (c2 == c) break; const size_t u2 = (size_t)(unit - c + c2);
            const f32x4 d0 = *(const f32x4*)(GDT + u2 * 128 + dkg * 8), d1 = *(const f32x4*)(GDT + u2 * 128 + dkg * 8 + 4);
#pragma unroll
            for (int j = 0; j < 8; ++j) { const f32x4 g4 = *(const f32x4*)(GE + (u2 * 128 + dkg * 8 + j) * 128 + 4 * dvg); const float dd = j < 4 ? d0[j & 3] : d1[j & 3];
                S2[j][0] = dd * S2[j][0] + (f32x2v){g4[0], g4[1]}; S2[j][1] = dd * S2[j][1] + (f32x2v){g4[2], g4[3]}; } }
    }
    const float* wal = TAB[16] + ((size_t)(l * 2 + dir) * 16) * 512 + h * 128 + dks; const float bal = TAB[17][(l * 2 + dir) * 512 + h * 128 + dks];
    float wr_[16];
#pragma unroll
    for (int r = 0; r < 16; ++r) wr_[r] = wal[r * 512];
    const int zcol = PC_Z + dir * 16;
    float lsum = 0.f;
    v4u rz0[2], rz1[2]; bf16r rq[2], rk[2], rvv[2];
#define GLA_LOAD(BLK) do { _Pragma("unroll") for (int i = 0; i < 2; ++i) { const int idx = tid + 512 * i, s = idx >> 7, dk = idx & 127; const int step = (BLK) * 8 + s, t = dir ? (c * 512 + 511 - step) : (c * 512 + step); \
        const bf16r* pr = PROJ + ((size_t)b * SEQ + t) * NPROJ; rz0[i] = *(const v4u*)(pr + zcol); rz1[i] = *(const v4u*)(pr + zcol + 8); \
        rq[i] = OUT ? pr[PC_GQ + h * 128 + dk] : (bf16r)0; rk[i] = pr[PC_GK + h * 128 + dk]; rvv[i] = pr[PC_GV + h * 128 + dk]; } } while (0)
    GLA_LOAD(0);
    for (int blk = 0; blk <= 64; ++blk) {
        if (blk < 64) {
#pragma unroll
            for (int i = 0; i < 2; ++i) { const int idx = tid + 512 * i;
                const v4u z0 = rz0[i], z1 = rz1[i];
                float lg = bal;
                lg += pg8::bflo(z0.x) * wr_[0] + pg8::bfhi(z0.x) * wr_[1] + pg8::bflo(z0.y) * wr_[2] + pg8::bfhi(z0.y) * wr_[3] + pg8::bflo(z0.z) * wr_[4] + pg8::bfhi(z0.z) * wr_[5] + pg8::bflo(z0.w) * wr_[6] + pg8::bfhi(z0.w) * wr_[7];
                lg += pg8::bflo(z1.x) * wr_[8] + pg8::bfhi(z1.x) * wr_[9] + pg8::bflo(z1.y) * wr_[10] + pg8::bfhi(z1.y) * wr_[11] + pg8::bflo(z1.z) * wr_[12] + pg8::bfhi(z1.z) * wr_[13] + pg8::bflo(z1.w) * wr_[14] + pg8::bfhi(z1.w) * wr_[15];
                const float ls = (fminf(lg, 0.f) - log1pf(expf(-fabsf(lg)))) * (1.0f / 16.0f);
                lsum += ls;
                sa[idx] = expf(ls); if (OUT) sq[idx] = bf2f(rq[i]) * 0.08838834764831845f; sk[idx] = bf2f(rk[i]); sv[idx] = bf2f(rvv[i]); }
            if (blk + 1 < 64) GLA_LOAD(blk + 1);
        }
        if (OUT && blk > 0) {
#pragma unroll
            for (int i = 0; i < 2; ++i) { const int idx = tid + 512 * i, s = idx >> 7, dvv = idx & 127; const int step = (blk - 1) * 8 + s, t = dir ? (c * 512 + 511 - step) : (c * 512 + step);
                float val = 0.f;
#pragma unroll
                for (int gq = 0; gq < 16; ++gq) val += sop[gq * 1024 + idx];
                const size_t oi = ((size_t)b * SEQ + t) * 512 + h * 128 + dvv; if (dir) OB[oi] = (bf16r)f2bf(val); else ACC[oi] = val; }
        }
        __syncthreads();
        if (blk < 64) {
            for (int s = 0; s < 8; ++s) {
                const f32x4 v4 = *(const LAS f32x4*)(sv + s * 128 + 4 * dvg); const f32x2v v01 = (f32x2v){v4[0], v4[1]}, v23 = (f32x2v){v4[2], v4[3]};
                const LAS f32x4* pa = (const LAS f32x4*)(sa + s * 128 + dkg * 8); const LAS f32x4* pq = (const LAS f32x4*)(sq + s * 128 + dkg * 8); const LAS f32x4* pk = (const LAS f32x4*)(sk + s * 128 + dkg * 8);
                f32x2v o01 = (f32x2v){0.f, 0.f}, o23 = (f32x2v){0.f, 0.f};
#pragma unroll
                for (int jj = 0; jj < 2; ++jj) { const f32x4 a4 = pa[jj], k4 = pk[jj]; f32x4 q4 = (f32x4){0.f, 0.f, 0.f, 0.f}; if (OUT) q4 = pq[jj];
#pragma unroll
                    for (int e = 0; e < 4; ++e) { const int j = jj * 4 + e;
                        S2[j][0] = a4[e] * S2[j][0] + k4[e] * v01; S2[j][1] = a4[e] * S2[j][1] + k4[e] * v23;
                        if (OUT) { o01 = o01 + q4[e] * S2[j][0]; o23 = o23 + q4[e] * S2[j][1]; } } }
                if (OUT) *(LAS f32x4*)(sop + (dkg * 8 + s) * 128 + 4 * dvg) = (f32x4){o01.x, o01.y, o23.x, o23.y}; }
        }
        __syncthreads();
    }
    if (!OUT) {
#pragma unroll
        for (int j = 0; j < 8; ++j) *(f32x4*)(GE + ((size_t)unit * 128 + dkg * 8 + j) * 128 + 4 * dvg) = (f32x4){S2[j][0].x, S2[j][0].y, S2[j][1].x, S2[j][1].y};
        sop[tid] = lsum; __syncthreads();
#undef GLA_LOAD
        if (tid < 128) GDT[(size_t)unit * 128 + tid] = expf((sop[tid] + sop[128 + tid]) + (sop[256 + tid] + sop[384 + tid]));
        __syncthreads();
    }
}

typedef short gbf16x8 __attribute__((ext_vector_type(8)));
__device__ __forceinline__ void gla_passA_mfma(const float* const* TAB, int l, int unit, int tid, const bf16r* PROJ, bf16r* GE, float* GDT, LAS unsigned char* ldsl) {
    const int c = unit & 7, h = (unit >> 3) & 3, b = (unit >> 5) & 3, dir = unit >> 7;
    LAS float* LB = (LAS float*)ldsl;
    LAS bf16r* KET = (LAS bf16r*)(ldsl + 32768);
    LAS bf16r* VT = (LAS bf16r*)(ldsl + 32768 + 18432);
    LAS float* DD = (LAS float*)(ldsl + 32768 + 2 * 18432);
    LAS float* TT = (LAS float*)(ldsl + 126976);
    const int lane = tid & 63, w = tid >> 6, fr = lane & 15, fq = lane >> 4;
    const int col = tid & 127, rq = tid >> 7;
    const float* wal = TAB[16] + ((size_t)(l * 2 + dir) * 16) * 512 + h * 128 + col; const float bal = TAB[17][(l * 2 + dir) * 512 + h * 128 + col];
    float wr_[16];
#pragma unroll
    for (int r = 0; r < 16; ++r) wr_[r] = wal[r * 512];
    const int zcol = PC_Z + dir * 16;
    f32x4 S[8];
#pragma unroll
    for (int mt = 0; mt < 8; ++mt) S[mt] = (f32x4){0.f, 0.f, 0.f, 0.f};
    float ltot = 0.f;
    for (int sc = 0; sc < 8; ++sc) {
        bf16r rk[16], rv[16];
#pragma unroll
        for (int r = 0; r < 16; ++r) { const int step = sc * 64 + rq * 16 + r, t = dir ? (c * 512 + 511 - step) : (c * 512 + step); const bf16r* pr = PROJ + ((size_t)b * SEQ + t) * NPROJ;
            rk[r] = pr[PC_GK + h * 128 + col]; rv[r] = pr[PC_GV + h * 128 + col]; }
        float lav[16];
#pragma unroll
        for (int half = 0; half < 4; ++half) {
            v4u z0[4], z1[4];
#pragma unroll
            for (int r = 0; r < 4; ++r) { const int step = sc * 64 + rq * 16 + half * 4 + r, t = dir ? (c * 512 + 511 - step) : (c * 512 + step); const bf16r* pr = PROJ + ((size_t)b * SEQ + t) * NPROJ;
                z0[r] = *(const v4u*)(pr + zcol); z1[r] = *(const v4u*)(pr + zcol + 8); }
#pragma unroll
            for (int r = 0; r < 4; ++r) { float lg = bal;
                lg += pg8::bflo(z0[r].x) * wr_[0] + pg8::bfhi(z0[r].x) * wr_[1] + pg8::bflo(z0[r].y) * wr_[2] + pg8::bfhi(z0[r].y) * wr_[3] + pg8::bflo(z0[r].z) * wr_[4] + pg8::bfhi(z0[r].z) * wr_[5] + pg8::bflo(z0[r].w) * wr_[6] + pg8::bfhi(z0[r].w) * wr_[7];
                lg += pg8::bflo(z1[r].x) * wr_[8] + pg8::bfhi(z1[r].x) * wr_[9] + pg8::bflo(z1[r].y) * wr_[10] + pg8::bfhi(z1[r].y) * wr_[11] + pg8::bflo(z1[r].z) * wr_[12] + pg8::bfhi(z1[r].z) * wr_[13] + pg8::bflo(z1[r].w) * wr_[14] + pg8::bfhi(z1[r].w) * wr_[15];
                lav[half * 4 + r] = (fminf(lg, 0.f) - __logf(1.0f + __expf(-fabsf(lg)))) * (1.0f / 16.0f); }
        }
#pragma unroll
        for (int r = 1; r < 16; ++r) lav[r] += lav[r - 1];
        TT[rq * 128 + col] = lav[15];
        __syncthreads();
        float off = 0.f, bl = 0.f;
#pragma unroll
        for (int q = 0; q < 4; ++q) { const float tq = TT[q * 128 + col]; bl += tq; off += (q < rq) ? tq : 0.f; }
        if (rq == 0) { DD[col] = __expf(bl); ltot += bl; }
        { unsigned kw[8], vw[8];
#pragma unroll
          for (int r = 0; r < 8; ++r) { kw[r] = pk2(bf2f(rk[2 * r]) * __expf(bl - (lav[2 * r] + off)), bf2f(rk[2 * r + 1]) * __expf(bl - (lav[2 * r + 1] + off))); vw[r] = (unsigned)rv[2 * r] | ((unsigned)rv[2 * r + 1] << 16); }
          LAS v4u* kd = (LAS v4u*)(KET + col * 72 + rq * 16); kd[0] = (v4u){kw[0], kw[1], kw[2], kw[3]}; kd[1] = (v4u){kw[4], kw[5], kw[6], kw[7]};
          LAS v4u* vd = (LAS v4u*)(VT + col * 72 + rq * 16); vd[0] = (v4u){vw[0], vw[1], vw[2], vw[3]}; vd[1] = (v4u){vw[4], vw[5], vw[6], vw[7]}; }
        __syncthreads();
        { gbf16x8 bfr[2];
#pragma unroll
          for (int ks = 0; ks < 2; ++ks) bfr[ks] = *(const LAS gbf16x8*)(VT + (16 * w + fr) * 72 + 32 * ks + 8 * fq);
#pragma unroll
          for (int mt = 0; mt < 8; ++mt) { const f32x4 d4 = *(const LAS f32x4*)(DD + 16 * mt + 4 * fq); f32x4 acc = S[mt] * d4;
#pragma unroll
              for (int ks = 0; ks < 2; ++ks) { const gbf16x8 afr = *(const LAS gbf16x8*)(KET + (16 * mt + fr) * 72 + 32 * ks + 8 * fq); acc = __builtin_amdgcn_mfma_f32_16x16x32_bf16(afr, bfr[ks], acc, 0, 0, 0); }
              S[mt] = acc; } }
        __syncthreads();
    }
#pragma unroll
    for (int mt = 0; mt < 8; ++mt)
#pragma unroll
        for (int jj = 0; jj < 4; ++jj) GE[((size_t)unit * 128 + 16 * mt + 4 * fq + jj) * 128 + 16 * w + fr] = (bf16r)f2bf(S[mt][jj]);
    if (tid < 128) GDT[(size_t)unit * 128 + tid] = expf(ltot);
}

__device__ __forceinline__ void gla_passB_mfma(const float* const* TAB, int l, int unit, int tid, const bf16r* PROJ, float* ACC, bf16r* OB, const bf16r* GE, const float* GDT, LAS unsigned char* ldsl) {
    const int c = unit & 7, h = (unit >> 3) & 3, b = (unit >> 5) & 3, dir = unit >> 7;
    LAS float* LB = (LAS float*)ldsl;
    LAS bf16r* KET = (LAS bf16r*)(ldsl + 34816);
    LAS bf16r* VT = (LAS bf16r*)(ldsl + 53248);
    LAS float* DD = (LAS float*)(ldsl + 71680);
    LAS bf16r* QD = (LAS bf16r*)(ldsl + 72192);
    LAS bf16r* KD = (LAS bf16r*)(ldsl + 89600);
    LAS bf16r* PP = (LAS bf16r*)(ldsl + 107008);
    LAS float* TT = (LAS float*)(ldsl + 126976);
    const int lane = tid & 63, w = tid >> 6, fr = lane & 15, fq = lane >> 4;
    LAS bf16r* STw = (LAS bf16r*)ldsl + w * (16 * 136);
    const int col = tid & 127, rq = tid >> 7;
    const float* wal = TAB[16] + ((size_t)(l * 2 + dir) * 16) * 512 + h * 128 + col; const float bal = TAB[17][(l * 2 + dir) * 512 + h * 128 + col];
    float wr_[16];
#pragma unroll
    for (int r = 0; r < 16; ++r) wr_[r] = wal[r * 512];
    const int zcol = PC_Z + dir * 16;
    f32x4 S[8];
#pragma unroll
    for (int mt = 0; mt < 8; ++mt) S[mt] = (f32x4){0.f, 0.f, 0.f, 0.f};
    for (int cc = 0; cc < 8; ++cc) { const int c2 = dir ? 7 - cc : cc; if (c2 == c) break; const size_t u2 = (size_t)(unit - c + c2);
#pragma unroll
        for (int mt = 0; mt < 8; ++mt) { const f32x4 d4 = *(const f32x4*)(GDT + u2 * 128 + 16 * mt + 4 * fq);
#pragma unroll
            for (int jj = 0; jj < 4; ++jj) S[mt][jj] = d4[jj] * S[mt][jj] + bf2f(GE[(u2 * 128 + 16 * mt + 4 * fq + jj) * 128 + 16 * w + fr]); } }
    for (int sc = 0; sc < 8; ++sc) {
        bf16r rqv[16], rk[16], rv[16];
#pragma unroll
        for (int r = 0; r < 16; ++r) { const int step = sc * 64 + rq * 16 + r, t = dir ? (c * 512 + 511 - step) : (c * 512 + step); const bf16r* pr = PROJ + ((size_t)b * SEQ + t) * NPROJ;
            rqv[r] = pr[PC_GQ + h * 128 + col]; rk[r] = pr[PC_GK + h * 128 + col]; rv[r] = pr[PC_GV + h * 128 + col]; }
        float lav[16];
#pragma unroll
        for (int half = 0; half < 4; ++half) {
            v4u z0[4], z1[4];
#pragma unroll
            for (int r = 0; r < 4; ++r) { const int step = sc * 64 + rq * 16 + half * 4 + r, t = dir ? (c * 512 + 511 - step) : (c * 512 + step); const bf16r* pr = PROJ + ((size_t)b * SEQ + t) * NPROJ;
                z0[r] = *(const v4u*)(pr + zcol); z1[r] = *(const v4u*)(pr + zcol + 8); }
#pragma unroll
            for (int r = 0; r < 4; ++r) { float lg = bal;
                lg += pg8::bflo(z0[r].x) * wr_[0] + pg8::bfhi(z0[r].x) * wr_[1] + pg8::bflo(z0[r].y) * wr_[2] + pg8::bfhi(z0[r].y) * wr_[3] + pg8::bflo(z0[r].z) * wr_[4] + pg8::bfhi(z0[r].z) * wr_[5] + pg8::bflo(z0[r].w) * wr_[6] + pg8::bfhi(z0[r].w) * wr_[7];
                lg += pg8::bflo(z1[r].x) * wr_[8] + pg8::bfhi(z1[r].x) * wr_[9] + pg8::bflo(z1[r].y) * wr_[10] + pg8::bfhi(z1[r].y) * wr_[11] + pg8::bflo(z1[r].z) * wr_[12] + pg8::bfhi(z1[r].z) * wr_[13] + pg8::bflo(z1[r].w) * wr_[14] + pg8::bfhi(z1[r].w) * wr_[15];
                lav[half * 4 + r] = (fminf(lg, 0.f) - __logf(1.0f + __expf(-fabsf(lg)))) * (1.0f / 16.0f); }
        }
#pragma unroll
        for (int r = 1; r < 16; ++r) lav[r] += lav[r - 1];
        TT[rq * 128 + col] = lav[15];
        __syncthreads();
        { float off = 0.f, bl = 0.f;
#pragma unroll
          for (int q = 0; q < 4; ++q) { const float tq = TT[q * 128 + col]; bl += tq; off += (q < rq) ? tq : 0.f; }
          if (rq == 0) DD[col] = __expf(bl);
          unsigned kw[8], vw[8];
#pragma unroll
          for (int r = 0; r < 16; ++r) { const int j = rq * 16 + r; const float bj = lav[r] + off, kf = bf2f(rk[r]);
              QD[j * 136 + col] = (bf16r)f2bf(bf2f(rqv[r]) * 0.08838834764831845f * __expf(bj)); KD[j * 136 + col] = (bf16r)f2bf(kf * __expf(-bj));
              const unsigned ke = f2bf(kf * __expf(bl - bj));
              if (r & 1) { kw[r >> 1] |= ke << 16; vw[r >> 1] |= (unsigned)rv[r] << 16; } else { kw[r >> 1] = ke; vw[r >> 1] = (unsigned)rv[r]; } }
          LAS v4u* kd = (LAS v4u*)(KET + col * 72 + rq * 16); kd[0] = (v4u){kw[0], kw[1], kw[2], kw[3]}; kd[1] = (v4u){kw[4], kw[5], kw[6], kw[7]};
          LAS v4u* vd = (LAS v4u*)(VT + col * 72 + rq * 16); vd[0] = (v4u){vw[0], vw[1], vw[2], vw[3]}; vd[1] = (v4u){vw[4], vw[5], vw[6], vw[7]}; }
        __syncthreads();
#pragma unroll
        for (int mt = 0; mt < 8; ++mt) { unsigned long long pk = (unsigned long long)pk2(S[mt][0], S[mt][1]) | ((unsigned long long)pk2(S[mt][2], S[mt][3]) << 32);
            *(LAS unsigned long long*)(STw + fr * 136 + 16 * mt + 4 * fq) = pk; }
#pragma unroll
        for (int tt = 0; tt < 2; ++tt) { const int tile = 2 * w + tt, mi = tile >> 2, nj = tile & 3; f32x4 acc = (f32x4){0.f, 0.f, 0.f, 0.f};
            if (nj <= mi) {
#pragma unroll
                for (int ks = 0; ks < 4; ++ks) { const gbf16x8 afr = *(const LAS gbf16x8*)(QD + (16 * mi + fr) * 136 + 32 * ks + 8 * fq); const gbf16x8 bfr = *(const LAS gbf16x8*)(KD + (16 * nj + fr) * 136 + 32 * ks + 8 * fq);
                    acc = __builtin_amdgcn_mfma_f32_16x16x32_bf16(afr, bfr, acc, 0, 0, 0); } }
#pragma unroll
            for (int jj = 0; jj < 4; ++jj) { const int i = 16 * mi + 4 * fq + jj, j = 16 * nj + fr; PP[i * 72 + j] = (bf16r)f2bf(j <= i ? acc[jj] : 0.f); } }
        __syncthreads();
        { gbf16x8 vb[2], sb[4];
#pragma unroll
          for (int ks = 0; ks < 2; ++ks) vb[ks] = *(const LAS gbf16x8*)(VT + (16 * w + fr) * 72 + 32 * ks + 8 * fq);
#pragma unroll
          for (int ks = 0; ks < 4; ++ks) sb[ks] = *(const LAS gbf16x8*)(STw + fr * 136 + 32 * ks + 8 * fq);
#pragma unroll
          for (int mi = 0; mi < 4; ++mi) { f32x4 acc = (f32x4){0.f, 0.f, 0.f, 0.f};
#pragma unroll
              for (int ks = 0; ks < 2; ++ks) { const gbf16x8 afr = *(const LAS gbf16x8*)(PP + (16 * mi + fr) * 72 + 32 * ks + 8 * fq); acc = __builtin_amdgcn_mfma_f32_16x16x32_bf16(afr, vb[ks], acc, 0, 0, 0); }
#pragma unroll
              for (int ks = 0; ks < 4; ++ks) { const gbf16x8 afr = *(const LAS gbf16x8*)(QD + (16 * mi + fr) * 136 + 32 * ks + 8 * fq); acc = __builtin_amdgcn_mfma_f32_16x16x32_bf16(afr, sb[ks], acc, 0, 0, 0); }
#pragma unroll
              for (int jj = 0; jj < 4; ++jj) { const int step = sc * 64 + 16 * mi + 4 * fq + jj, t = dir ? (c * 512 + 511 - step) : (c * 512 + step);
                  const size_t oi = ((size_t)b * SEQ + t) * 512 + h * 128 + 16 * w + fr; if (dir) OB[oi] = (bf16r)f2bf(acc[jj]); else ((bf16r*)ACC)[oi] = (bf16r)f2bf(acc[jj]); } }
#pragma unroll
          for (int mt = 0; mt < 8; ++mt) { const f32x4 d4 = *(const LAS f32x4*)(DD + 16 * mt + 4 * fq); f32x4 acc = S[mt] * d4;
#pragma unroll
              for (int ks = 0; ks < 2; ++ks) { const gbf16x8 afr = *(const LAS gbf16x8*)(KET + (16 * mt + fr) * 72 + 32 * ks + 8 * fq); acc = __builtin_amdgcn_mfma_f32_16x16x32_bf16(afr, vb[ks], acc, 0, 0, 0); }
              S[mt] = acc; } }
        __syncthreads();
    }
}

constexpr size_t WS_BAR = 4096;
constexpr size_t WS_ROPE = 32768;
constexpr int MISC_OFF = 131072 + 320;
typedef __attribute__((address_space(1))) unsigned gu32;
#define RLX_AGENT __ATOMIC_RELAXED, __HIP_MEMORY_SCOPE_AGENT
#define XB_TMO      128
#define XB_XCNT(j)  (256  + 64 * (j))
#define XB_XSUB(j)  (1280 + 64 * (j))
#define XB_XGEN(j)  (2304 + 64 * (j))
#define XB_TOP      3328
#define XB_TOPGEN   3392
#define XCD_BAR_WORDS 3456
#define XB_SPIN_CAP (1u << 18)

__device__ __forceinline__ unsigned xb_ld(unsigned* p)              { return __hip_atomic_load(p, __ATOMIC_RELAXED, __HIP_MEMORY_SCOPE_AGENT); }
__device__ __forceinline__ unsigned xb_add(unsigned* p, unsigned v) { return __hip_atomic_fetch_add(p, v, __ATOMIC_RELAXED, __HIP_MEMORY_SCOPE_AGENT); }
__device__ __forceinline__ unsigned xb_xcc_id() { return (unsigned)__builtin_amdgcn_s_getreg((3 << 11) | 20) & 0xFu; }
#define XB_SPIN(cond, bar) do { unsigned _sp = 0; while (cond) { __builtin_amdgcn_s_sleep(1); \
    if ((++_sp & 255u) == 0u) { if (xb_ld(&(bar)[XB_TMO])) break; if (_sp > XB_SPIN_CAP) { atomicAdd(&(bar)[XB_TMO], 1u); break; } } } } while (0)

struct XcdBarrier {
    unsigned* bar; unsigned x;
    volatile LAS unsigned* st;
};

__device__ __forceinline__ XcdBarrier xcd_barrier_post(unsigned* bar, volatile LAS unsigned* st) {
    XcdBarrier b; b.bar = bar; b.x = xb_xcc_id(); b.st = st;
    if (threadIdx.x == 0) (void)xb_add(&bar[XB_XCNT(b.x)], 1u);
    return b;
}
__device__ __forceinline__ void xcd_barrier_complete(unsigned* bar, unsigned x, unsigned& nloc, unsigned& nx) {
    const unsigned G = gridDim.x * gridDim.y * gridDim.z;
    unsigned sum, cnt, mine, sp = 0u;
    for (;;) {
        sum = 0u; cnt = 0u; mine = 0u;
#pragma unroll
        for (unsigned j = 0; j < 16; ++j) { const unsigned c = xb_ld(&bar[XB_XCNT(j)]); sum += c; cnt += (c > 0u) ? 1u : 0u; mine = (j == x) ? c : mine; }
        if (sum == G) break;
        __builtin_amdgcn_s_sleep(1);
        if ((++sp & 255u) == 0u) { if (xb_ld(&bar[XB_TMO])) break; if (sp > XB_SPIN_CAP) { atomicAdd(&bar[XB_TMO], 1u); break; } }
    }
    nloc = mine > 0u ? mine : 1u; nx = cnt > 0u ? cnt : 1u;
}

__device__ __forceinline__ void xcd_barrier(const XcdBarrier& b) {
    asm volatile("s_waitcnt vmcnt(0)" ::: "memory");
    __syncthreads();
    if (threadIdx.x == 0) {
        unsigned* bar = b.bar;
        __builtin_amdgcn_s_waitcnt(0);
        unsigned nloc = b.st[0], nx = b.st[1];
        if (nloc == 0u) { xcd_barrier_complete(bar, b.x, nloc, nx); b.st[0] = nloc; b.st[1] = nx; }
        const unsigned old = xb_add(&bar[XB_XSUB(b.x)], 1u);
        const unsigned gen = old / nloc;
        if (old + 1u == (gen + 1u) * nloc) {
            __builtin_amdgcn_fence(__ATOMIC_RELEASE, "agent");
            asm volatile("s_waitcnt vmcnt(0)" ::: "memory");
            const unsigned og = xb_add(&bar[XB_TOP], 1u);
            const unsigned tg = og / nx;
            if (og + 1u == (tg + 1u) * nx) xb_add(&bar[XB_TOPGEN], 1u);
            else XB_SPIN(xb_ld(&bar[XB_TOPGEN]) == tg, bar);
            __builtin_amdgcn_fence(__ATOMIC_ACQUIRE, "agent");
            xb_add(&bar[XB_XGEN(b.x)], 1u);
            asm volatile("s_waitcnt vmcnt(0)" ::: "memory");
        } else {
            XB_SPIN(xb_ld(&bar[XB_XGEN(b.x)]) == gen, bar);
            __builtin_amdgcn_fence(__ATOMIC_ACQUIRE, "agent");
            asm volatile("s_waitcnt vmcnt(0)" ::: "memory");
        }
    }
    __syncthreads();
}

__global__ void __launch_bounds__(NWAVES * 64, 2) fwd_kernel(Args args) {
    extern __shared__ __attribute__((aligned(16))) unsigned char lds[];
    cg::grid_group grid = cg::this_grid();
    unsigned seam = 0; int fin_buf = 0;
    grid.sync();
    for (int u = threadIdx.x; u < (LDS_BYTES - 131072) / 4; u += NWAVES * 64) ((LAS unsigned*)((LAS unsigned char*)lds + 131072))[u] = 0u;
    __syncthreads();
    (void)xcd_barrier_post((unsigned*)(args.ws + WS_BAR), (volatile LAS unsigned*)((LAS unsigned char*)lds + MISC_OFF) + 8);
#define GSYNC() do { XcdBarrier xb_; xb_.bar = (unsigned*)(args.ws + WS_BAR); xb_.x = xb_xcc_id(); xb_.st = (volatile LAS unsigned*)((LAS unsigned char*)lds + MISC_OFF) + 8; xcd_barrier(xb_); } while (0)
#define PH \
    __attribute__((address_space(1))) unsigned char* ws_g = (__attribute__((address_space(1))) unsigned char*)args.ws; asm volatile("" : "+s"(ws_g)); unsigned char* ws = (unsigned char*)ws_g; \
    __attribute__((address_space(1))) float* X_g = (__attribute__((address_space(1))) float*)args.out; asm volatile("" : "+s"(X_g)); float* X = (float*)X_g; \
    int tid = threadIdx.x; asm volatile("" : "+v"(tid)); const int lane = tid & 63, wave = __builtin_amdgcn_readfirstlane(tid >> 6); \
    int G = gridDim.x; asm volatile("" : "+s"(G)); const int bx = blockIdx.x; const int gw = bx * NWAVES + wave, NGW = G * NWAVES; const long gt = (long)bx * 512 + tid, NGT = (long)G * 512; \
    const float* const* TAB = (const float* const*)(ws + WS_TAB); float* SS = (float*)(ws + WS_SS); bf16r* XB = (bf16r*)(ws + WS_XB); bf16r* HB = (bf16r*)(ws + WS_BIG); bf16r* PROJ = (bf16r*)(ws + WS_BIG); \
    bf16r* GSCR = (bf16r*)(ws + WS_BIG); float* MERGED = (float*)(ws + WS_BIG + 32 * MiB); float* ACC = (float*)(ws + WS_ACC); bf16r* YATT = (bf16r*)(ws + WS_ACC); bf16r* YS5 = (bf16r*)(ws + WS_YS5); bf16r* YGLA = (bf16r*)(ws + WS_YGLA); \
    LAS unsigned char* ldsl = (LAS unsigned char*)lds; LAS float* scr = (LAS float*)(ldsl + wave * 16384); \
    (void)TAB; (void)SS; (void)XB; (void)HB; (void)PROJ; (void)GSCR; (void)MERGED; (void)ACC; (void)YATT; (void)YS5; (void)YGLA; (void)scr; (void)gw; (void)NGW; (void)gt; (void)NGT; (void)X; (void)lane;
    { PH
      if (bx == 0 && tid == 0) { const float** tw = (const float**)(ws + WS_TAB);
#pragma unroll
        for (int i = 0; i < 32; ++i) tw[i] = args.in[i]; } }
    { PH
        const float* xin = args.in[0];
        for (int m = gw; m < M; m += NGW) {
            const f32x4* xr = (const f32x4*)(xin + (size_t)m * 1024) + lane; f32x4* xo = (f32x4*)(X + (size_t)m * 1024) + lane;
            unsigned long long* o8 = (unsigned long long*)(XB + (size_t)m * 1024) + lane; float s = 0.f;
#pragma unroll
            for (int j = 0; j < 4; ++j) { const f32x4 v = xr[64 * j]; s += (v.x * v.x + v.y * v.y) + (v.z * v.z + v.w * v.w);
                o8[64 * j] = (unsigned long long)pk2(v.x, v.y) | ((unsigned long long)pk2(v.z, v.w) << 32); }
            s = wave_sum(s); if (lane < 16) SS[(size_t)m * 16 + lane] = lane == 0 ? s : 0.f;
        }
        for (long i = gt; i < 1024; i += NGT) { const int pos = (int)(i >> 4), fq_ = (int)(i & 15); float sn, cs; sincosf((float)pos * exp2f(-(float)fq_ * (13.287712379549449f / 16.0f)), &sn, &cs);
            float* rp = (float*)(ws + WS_ROPE); rp[2 * i] = cs; rp[2 * i + 1] = sn; }
    }
    GSYNC();

    { constexpr int l = 0;

        { PH
            const float* n1 = TAB[1] + l * 1024; const float* n2 = TAB[27] + l * 1024; const float* nm = TAB[5] + l * 1024;
            { const float* Wg = TAB[2] + (size_t)l * 1024 * FF; const float* Wu = TAB[3] + (size_t)l * 1024 * FF;
              conv_all([=](int k, int n) { const int ff = (n >> 8) * 128 + (n & 127); return ((n & 128) ? Wu : Wg) + (size_t)k * FF + ff; }, [=](int k) { return n1[k]; }, 1024, 5632, (bf16r*)(ws + W_GU1), scr, gw, NGW, lane); }
            { const float* Wd = TAB[4] + (size_t)l * FF * 1024;
              conv_all([=](int k, int n) { return Wd + (size_t)k * 1024 + n; }, [](int) { return 1.0f; }, FF, 1024, (bf16r*)(ws + W_D1), scr, gw, NGW, lane); }
            { const float* Wg = TAB[28] + (size_t)l * 1024 * FF; const float* Wu = TAB[29] + (size_t)l * 1024 * FF;
              conv_all([=](int k, int n) { const int ff = (n >> 8) * 128 + (n & 127); return ((n & 128) ? Wu : Wg) + (size_t)k * FF + ff; }, [=](int k) { return n2[k]; }, 1024, 5632, (bf16r*)(ws + W_GU2), scr, gw, NGW, lane); }
            { const float* Wd = TAB[30] + (size_t)l * FF * 1024;
              conv_all([=](int k, int n) { return Wd + (size_t)k * 1024 + n; }, [](int) { return 1.0f; }, FF, 1024, (bf16r*)(ws + W_D2), scr, gw, NGW, lane); }
            { const float* Wi = TAB[6] + (size_t)l * 1024 * 3360;
              conv_all([=](int k, int n) { const int sc = n < 2560 ? n : (n < 3328 ? n + 32 : (n < 3360 ? n - 3328 + 2560 : -1)); return sc >= 0 ? Wi + (size_t)k * 3360 + sc : (const float*)nullptr; }, [=](int k) { return nm[k]; }, 1024, NWIN, (bf16r*)(ws + W_IN), scr, gw, NGW, lane); }
            { const float* Wm = TAB[24] + (size_t)l * 1024 * 3072;
              conv_all([=](int k, int n) { return Wm + (size_t)k * 3072 + n; }, [=](int k) { return nm[k]; }, 1024, 3072, (bf16r*)(ws + W_MG), scr, gw, NGW, lane); }
            { const float* Wx = TAB[15] + (size_t)l * 512 * 512;
              conv_all([=](int k, int n) { return Wx + (size_t)k * 512 + n; }, [](int) { return 1.0f; }, 512, 512, (bf16r*)(ws + W_GLU), scr, gw, NGW, lane); }
#pragma unroll
            for (int b = 0; b < 3; ++b) { const float* Wx = TAB[21 + b] + (size_t)l * 512 * 1024;
              conv_all([=](int k, int n) { return Wx + (size_t)k * 1024 + n; }, [](int) { return 1.0f; }, 512, 1024, (bf16r*)(ws + W_BR) + (size_t)b * 1024 * 512, scr, gw, NGW, lane); }
            { const float* Wx = TAB[26] + (size_t)l * 1024 * 1024;
              conv_all([=](int k, int n) { return Wx + (size_t)k * 1024 + n; }, [](int) { return 1.0f; }, 1024, 1024, (bf16r*)(ws + W_OUT), scr, gw, NGW, lane); }
            { bf16r* W1T = (bf16r*)(ws + WS_W1T); bf16r* BTY = (bf16r*)(ws + WS_BTY); float* KT = (float*)(ws + WS_KT);
              __syncthreads();
              { LAS float* LP = (LAS float*)ldsl; LAS float* FB = LP + 1024; LAS float* CC = FB + 2048;
                for (int unit = bx; unit < 256; unit += G) { const int dq = unit & 3, dir = (unit >> 2) & 1, g = unit >> 3;
                  const size_t o1 = ((size_t)(l * 2 + dir) * 32 + g); const float dt = expf(TAB[9][o1]);
                  { const int p = tid & 63, d8 = tid >> 6; const float lre = TAB[7][o1 * 64 + p], lim = TAB[8][o1 * 64 + p];
                    const float ed = (float)(dq * 8 + d8); const float mg = expf(ed * lre * dt), an = ed * lim * dt;
                    LP[(d8 * 64 + p) * 2] = mg * cosf(an); LP[(d8 * 64 + p) * 2 + 1] = mg * sinf(an);
                    const float mag1 = expf(lre * dt), ang1 = lim * dt, lbr = mag1 * cosf(ang1), lbi = mag1 * sinf(ang1);
                    const float den = lre * lre + lim * lim, nr = lbr - 1.0f, ni = lbi, fr = (nr * lre + ni * lim) / den, fi = (ni * lre - nr * lim) / den;
#pragma unroll
                    for (int k = 0; k < 2; ++k) { const int hp = d8 * 2 + k; const float br = TAB[10][(o1 * 64 + p) * 16 + hp], bi = TAB[11][(o1 * 64 + p) * 16 + hp];
                        FB[(p * 16 + hp) * 2] = fr * br - fi * bi; FB[(p * 16 + hp) * 2 + 1] = fr * bi + fi * br;
                        CC[(hp * 64 + p) * 2] = TAB[12][(o1 * 16 + hp) * 64 + p]; CC[(hp * 64 + p) * 2 + 1] = TAB[13][(o1 * 16 + hp) * 64 + p]; } }
                  __syncthreads();
#pragma unroll
                  for (int k = 0; k < 4; ++k) { const int o = tid + 512 * k, hp = o & 15, h = (o >> 4) & 15, d8 = o >> 8; float acc = 0.f;
                      for (int p = 0; p < 64; ++p) { const float cr = CC[(h * 64 + p) * 2], ci = CC[(h * 64 + p) * 2 + 1], pr = LP[(d8 * 64 + p) * 2], pi = LP[(d8 * 64 + p) * 2 + 1];
                          const float wr = cr * pr - ci * pi, wi = cr * pi + ci * pr; acc += wr * FB[(p * 16 + hp) * 2] - wi * FB[(p * 16 + hp) * 2 + 1]; }
                      KT[((((size_t)(g * 2 + dir) * 32 + dq * 8 + d8) * 16 + h) * 16) + hp] = acc; }
                  __syncthreads(); } } }
        }
        GSYNC();
        { PH pg8::Gemm g{XB, (const bf16r*)(ws + W_GU1), M, 5632, 1024, 1024, 1024}; pg8::StaticOrder S; S.init(M, 5632, G, bx);
          pg8::EpiSwiGLU E{HB, SS + (size_t)((3 * l + 0) % 3) * M * 16, FF};
          pg8::gemm_phase<pg8::EpiSwiGLU, pg8::StaticOrder, true, true>(ldsl, g, S, E); }
        { PH
          if (bx >= 128) { const long gt2 = (long)(bx - 128) * 512 + tid, NGT2 = (long)(G - 128) * 512;
            { bf16r* W1T = (bf16r*)(ws + WS_W1T); bf16r* BTY = (bf16r*)(ws + WS_BTY);
              for (long i = gt2; i < 131072; i += NGT2) { const int jq = (int)i & 31, p = (int)(i >> 5) & 63, dir = (int)(i >> 11) & 1, g = (int)(i >> 12);
                const size_t o1 = ((size_t)(l * 2 + dir) * 32 + g);
                const float lre = TAB[7][o1 * 64 + p], lim = TAB[8][o1 * 64 + p], dt = expf(TAB[9][o1]);
                const float mag1 = expf(lre * dt), ang1 = lim * dt, lbr = mag1 * cosf(ang1), lbi = mag1 * sinf(ang1);
                const float den = lre * lre + lim * lim, nr = lbr - 1.0f, ni = lbi, fr = (nr * lre + ni * lim) / den, fi = (ni * lre - nr * lim) / den;
                { const float e1 = (float)(dir ? jq : 31 - jq); const float mg = expf(e1 * lre * dt), an = e1 * lim * dt, pr = mg * cosf(an), pi = mg * sinf(an);
                  const float wr = pr * fr - pi * fi, wi = pr * fi + pi * fr;
                  float re[16], im[16];
#pragma unroll
                  for (int h = 0; h < 16; ++h) { const float br = TAB[10][(o1 * 64 + p) * 16 + h], bi = TAB[11][(o1 * 64 + p) * 16 + h]; re[h] = wr * br - wi * bi; im[h] = wr * bi + wi * br; }
                  v4u* d0 = (v4u*)(W1T + ((size_t)(g * 256 + dir * 128 + 2 * p) * 512 + jq * 16)); v4u* d1 = (v4u*)(W1T + ((size_t)(g * 256 + dir * 128 + 2 * p + 1) * 512 + jq * 16));
                  d0[0] = (v4u){pk2(re[0], re[1]), pk2(re[2], re[3]), pk2(re[4], re[5]), pk2(re[6], re[7])}; d0[1] = (v4u){pk2(re[8], re[9]), pk2(re[10], re[11]), pk2(re[12], re[13]), pk2(re[14], re[15])};
                  d1[0] = (v4u){pk2(im[0], im[1]), pk2(im[2], im[3]), pk2(im[4], im[5]), pk2(im[6], im[7])}; d1[1] = (v4u){pk2(im[8], im[9]), pk2(im[10], im[11]), pk2(im[12], im[13]), pk2(im[14], im[15])}; }
                { const float e2 = (float)(dir ? 32 - jq : jq + 1); const float mg = expf(e2 * lre * dt), an = e2 * lim * dt, pr = mg * cosf(an), pi = mg * sinf(an);
#pragma unroll
                  for (int h = 0; h < 16; ++h) { const float cr = TAB[12][(o1 * 16 + h) * 64 + p], ci = TAB[13][(o1 * 16 + h) * 64 + p]; const float wre = cr * pr - ci * pi, wim = cr * pi + ci * pr;
                      *(unsigned*)(BTY + ((size_t)(g * 512 + jq * 16 + h) * 768 + dir * 128 + 2 * p)) = pk2(wre, -wim); } } }
            }
            {
            const float* KT = (const float*)(ws + WS_KT); bf16r* BTY = (bf16r*)(ws + WS_BTY); const float* dsk = TAB[14] + l * 512;
            for (long it = gt2; it < 524288; it += NGT2) { const int j = (int)it & 31, n = (int)(it >> 5) & 511, g = (int)(it >> 14); const int i = n >> 4, h = n & 15;
                const float* kf = KT + (size_t)((g * 2 + 0) * 32) * 256 + h * 16; const float* kb = KT + (size_t)((g * 2 + 1) * 32) * 256 + h * 16;
                float v[16];
                if (i > j) {
#pragma unroll
                    for (int q = 0; q < 4; ++q) { const f32x4 x = *(const f32x4*)(kf + (i - j) * 256 + 4 * q); v[4 * q] = x[0]; v[4 * q + 1] = x[1]; v[4 * q + 2] = x[2]; v[4 * q + 3] = x[3]; }
                } else if (j > i) {
#pragma unroll
                    for (int q = 0; q < 4; ++q) { const f32x4 x = *(const f32x4*)(kb + (j - i) * 256 + 4 * q); v[4 * q] = x[0]; v[4 * q + 1] = x[1]; v[4 * q + 2] = x[2]; v[4 * q + 3] = x[3]; }
                } else { const float dd = dsk[16 * g + h];
#pragma unroll
                    for (int q = 0; q < 4; ++q) { const f32x4 x = *(const f32x4*)(kf + 4 * q) + *(const f32x4*)(kb + 4 * q); v[4 * q] = x[0]; v[4 * q + 1] = x[1]; v[4 * q + 2] = x[2]; v[4 * q + 3] = x[3]; }
#pragma unroll
                    for (int hp = 0; hp < 16; ++hp) v[hp] += (hp == h) ? dd : 0.f; }
                v4u* dst = (v4u*)(BTY + ((size_t)(g * 512 + n) * 768 + 256 + j * 16));
                dst[0] = (v4u){pk2(v[0], v[1]), pk2(v[2], v[3]), pk2(v[4], v[5]), pk2(v[6], v[7])}; dst[1] = (v4u){pk2(v[8], v[9]), pk2(v[10], v[11]), pk2(v[12], v[13]), pk2(v[14], v[15])}; }
            }
          }
        }
        GSYNC();
        { PH pg8::Gemm g{HB, (const bf16r*)(ws + W_D1), M, 1024, FF, FF, FF}; pg8::StaticOrder S; S.init(M, 1024, G, bx);
          pg8::EpiResid E{(l == 0 ? TAB[0] : (const float*)X), X, XB, SS + (size_t)((3 * l + 1) % 3) * M * 16, 0.5f};
          pg8::gemm_phase<pg8::EpiResid, pg8::StaticOrder, true, true>(ldsl, g, S, E); }
        GSYNC();
        if (l == STOP_L && STOP_P == 2) { fin_buf = 1; goto final_norm; }
        { PH pg8::Gemm g{XB, (const bf16r*)(ws + W_IN), M, 2048, 1024, 1024, 1024}; pg8::StaticOrder S; S.init(M, 2048, G, bx);
          pg8::EpiInSplit E{PROJ, NPROJ, (bf16r*)(ws + WS_UG), SS + (size_t)((3 * l + 1) % 3) * M * 16};
          pg8::gemm_phase<pg8::EpiInSplit, pg8::StaticOrder, true, true>(ldsl, g, S, E); }
        GSYNC();
        { PH pg8::Gemm g{(const bf16r*)(ws + WS_UG) + 256, (const bf16r*)(ws + WS_W1T), 512, 256, 512, 768, 512, (size_t)512 * 768 * 2, (size_t)256 * 512 * 2}; pg8::BatchOrder S; S.init(2, 1, 32, G, bx);
          pg8::EpiF32B E{(float*)(ws + WS_E), 256, (size_t)512 * 256};
          pg8::gemm_phase<pg8::EpiF32B, pg8::BatchOrder, true, true>(ldsl, g, S, E); }
        { PH pg8::Gemm g{XB, (const bf16r*)(ws + W_IN) + (size_t)3072 * 1024, M, 512, 1024, 1024, 1024}; pg8::StaticOrder S; S.init(M, 512, G, (bx + G - 64) % G);
          pg8::EpiScaleBf16 E{PROJ + 2560, NPROJ, SS + (size_t)((3 * l + 1) % 3) * M * 16};
          pg8::gemm_phase<pg8::EpiScaleBf16, pg8::StaticOrder, true, true>(ldsl, g, S, E); }
        GSYNC();
        { PH
            const float* E = (const float*)(ws + WS_E); bf16r* UG = (bf16r*)(ws + WS_UG);
            for (long i = gt; i < 16384; i += NGT) { const int p = (int)i & 63, bb = (int)(i >> 6) & 3, dir = (int)(i >> 8) & 1, g = (int)(i >> 9);
                const size_t o1 = ((size_t)(l * 2 + dir) * 32 + g);
                const float lre = TAB[7][o1 * 64 + p], lim = TAB[8][o1 * 64 + p], dt = expf(TAB[9][o1]);
                const float mg = expf(32.0f * lre * dt), an = 32.0f * lim * dt, ar = mg * cosf(an), ai = mg * sinf(an);
                float xr = 0.f, xi = 0.f;
                for (int c0 = 0; c0 < 128; c0 += 8) { float er[8], ei[8];
#pragma unroll
                    for (int k = 0; k < 8; ++k) { const int c = dir ? 127 - (c0 + k) : c0 + k; const float* pe = E + ((size_t)(g * 512 + bb * 128 + c) * 256 + dir * 128 + 2 * p); er[k] = pe[0]; ei[k] = pe[1]; }
#pragma unroll
                    for (int k = 0; k < 8; ++k) { const int c = dir ? 127 - (c0 + k) : c0 + k;
                        *(unsigned*)(UG + ((size_t)(g * 512 + bb * 128 + c) * 768 + dir * 128 + 2 * p)) = pk2(xr, xi);
                        const float nr = ar * xr - ai * xi + er[k], ni = ar * xi + ai * xr + ei[k]; xr = nr; xi = ni; } } }
        }
        GSYNC();
        { PH pg8::Gemm g{(const bf16r*)(ws + WS_UG), (const bf16r*)(ws + WS_BTY), 512, 512, 768, 768, 768, (size_t)512 * 768 * 2, (size_t)512 * 768 * 2}; pg8::BatchOrder S; S.init(2, 2, 32, G, bx);
          pg8::EpiS5Y E{(bf16r*)(ws + WS_E)};
          pg8::gemm_phase<pg8::EpiS5Y, pg8::BatchOrder, true, true>(ldsl, g, S, E); }
        { PH pg8::Gemm g{XB, (const bf16r*)(ws + W_IN) + (size_t)2048 * 1024, M, 512, 1024, 1024, 1024}; pg8::StaticOrder S; S.init(M, 512, G, (bx + G - 128) % G);
          pg8::EpiScaleBf16 E{PROJ + 1536, NPROJ, SS + (size_t)((3 * l + 1) % 3) * M * 16};
          pg8::gemm_phase<pg8::EpiScaleBf16, pg8::StaticOrder, true, true>(ldsl, g, S, E); }
        GSYNC();
        { PH pg8::Gemm g{(const bf16r*)(ws + WS_E), (const bf16r*)(ws + W_GLU), M, 512, 512, 512, 512}; pg8::StaticOrder S; S.init(M, 512, G, bx);
          pg8::EpiGlu E{(const bf16r*)(ws + WS_E), 512, YS5, 512};
          pg8::gemm_phase<pg8::EpiGlu, pg8::StaticOrder, true, true>(ldsl, g, S, E); }
        { PH pg8::Gemm g{XB, (const bf16r*)(ws + W_IN) + (size_t)2560 * 1024, M, 512, 1024, 1024, 1024}; pg8::StaticOrder S; S.init(M, 512, G, (bx + G - 128) % G);
          pg8::EpiScaleBf16 E{PROJ + 2048, NPROJ, SS + (size_t)((3 * l + 1) % 3) * M * 16};
          pg8::gemm_phase<pg8::EpiScaleBf16, pg8::StaticOrder, true, true>(ldsl, g, S, E); }
        GSYNC();
        { PH
          for (int unit = bx; unit < 256; unit += G) gla_passA_mfma(TAB, l, unit, tid, PROJ, (bf16r*)(ws + WS_GE), (float*)(ws + WS_GDT), ldsl);
          __syncthreads();
          {
            const float* qg = TAB[19] + l * 64; const float* kg = TAB[20] + l * 64;
            const int d = lane, e = d & 31, fi_ = e & 15; const bool second = e >= 16;
            const float* ROPE = (const float*)(ws + WS_ROPE);
            for (long it = gw; it < (long)M * 10; it += NGW) {
                const int row = (int)(it / 10), j = (int)(it % 10); const int tt = row & (SEQ - 1);
                bf16r* px = PROJ + (size_t)row * NPROJ + (j < 8 ? PC_AQ + 64 * j : PC_AK + 64 * (j - 8)) + d;
                const float x = bf2f(*px); const float ssq = wave_sum(x * x);
                const float gain = j < 8 ? qg[d] : kg[d];
                const float y = x * rsqrtf(ssq * (1.0f / 64.0f) + 1e-6f) * gain;
                const int posi = (d < 32) ? (tt >> 6) : (tt & 63);
                const float cs = ROPE[(posi * 16 + fi_) * 2], sn = ROPE[(posi * 16 + fi_) * 2 + 1];
                const float partner = __shfl_xor(y, 16);
                float o = second ? (y * cs + partner * sn) : (y * cs - partner * sn);
                if (j < 8) o *= 0.125f * 1.4426950408889634f;
                *px = (bf16r)f2bf(o);
            }
          }
        }
        GSYNC();
        { PH
          for (int unit = bx; unit < 256; unit += G) gla_passB_mfma(TAB, l, unit, tid, PROJ, ACC, YGLA, (const bf16r*)(ws + WS_GE), (const float*)(ws + WS_GDT), ldsl); }
        GSYNC();
        { PH
            const float* gn = TAB[18] + l * 128;
            for (long it = gw; it < (long)M * 4; it += NGW) { const int row = (int)(it >> 2), h = (int)(it & 3);
                const unsigned oa = *(const unsigned*)((const bf16r*)ACC + (size_t)row * 512 + h * 128 + 2 * lane); const unsigned ob = *(const unsigned*)(YGLA + (size_t)row * 512 + h * 128 + 2 * lane); const float o0 = pg8::bflo(oa) + pg8::bflo(ob), o1 = pg8::bfhi(oa) + pg8::bfhi(ob);
                const float ssq = wave_sum(o0 * o0 + o1 * o1); const float r = rsqrtf(ssq * (1.0f / 128.0f) + 1e-6f);
                const unsigned gg = *(const unsigned*)(PROJ + (size_t)row * NPROJ + PC_GG + h * 128 + 2 * lane);
                const float y0 = o0 * r * gn[2 * lane] * silu_(pg8::bflo(gg)), y1 = o1 * r * gn[2 * lane + 1] * silu_(pg8::bfhi(gg));
                *(unsigned*)(YGLA + (size_t)row * 512 + h * 128 + 2 * lane) = pk2(y0, y1); }
        }
        GSYNC();
#ifndef NO_ATT
        { PH
            const attn_body::AttnTensors AT{(const attn_body::bf16*)(PROJ + PC_AQ), (const attn_body::bf16*)(PROJ + PC_AK), (const attn_body::bf16*)(PROJ + PC_AV), (attn_body::bf16*)YATT};
            const attn_body::StaticOrder S(G, bx);
            attn_body::attn_phase<attn_body::StaticOrder>((char*)lds, AT, S);
        }
#endif
        GSYNC();
#ifndef NO_MERGE
        { PH
            { pg8::Gemm g{XB, (const bf16r*)(ws + W_MG), M, 1024, 1024, 1024, 1024, 0, (size_t)1024 * 1024 * 2}; pg8::TileBatchOrder S; S.init(M, 1024, 3, G, bx);
              pg8::EpiGate3 E{GSCR, TAB[25] + l * 3072, SS + (size_t)((3 * l + 1) % 3) * M * 16};
              pg8::gemm_phase<pg8::EpiGate3, pg8::TileBatchOrder, true, true>(ldsl, g, S, E); }
            { pg8::Gemm g{YS5, (const bf16r*)(ws + W_BR), M, 1024, 512, 512, 512, 0, (size_t)1024 * 512 * 2, {0, (size_t)(WS_YGLA - WS_YS5), (size_t)(WS_ACC - WS_YS5)}, 1}; pg8::TileBatchOrder S; S.init(M, 1024, 3, G, bx);
              pg8::EpiMerge3 E{GSCR, (bf16r*)(ws + WS_MG16)};
              pg8::gemm_phase<pg8::EpiMerge3, pg8::TileBatchOrder, true, true>(ldsl, g, S, E); }
        }
#endif
        GSYNC();
        { PH pg8::Gemm g{GSCR, (const bf16r*)(ws + W_OUT), M, 1024, 1024, 1024, 1024}; pg8::StaticOrder S; S.init(M, 1024, G, bx);
          pg8::EpiResid E{X, X, XB, SS + (size_t)((3 * l + 2) % 3) * M * 16, 1.0f};
          pg8::gemm_phase<pg8::EpiResid, pg8::StaticOrder, true, true>(ldsl, g, S, E); }
        GSYNC();
        if (l == STOP_L && STOP_P == 10) { fin_buf = 2; goto final_norm; }
        { PH pg8::Gemm g{XB, (const bf16r*)(ws + W_GU2), M, 5632, 1024, 1024, 1024}; pg8::StaticOrder S; S.init(M, 5632, G, bx);
          pg8::EpiSwiGLU E{HB, SS + (size_t)((3 * l + 2) % 3) * M * 16, FF};
          pg8::gemm_phase<pg8::EpiSwiGLU, pg8::StaticOrder, true, true>(ldsl, g, S, E); }
        GSYNC();
        { PH pg8::Gemm g{HB, (const bf16r*)(ws + W_D2), M, 1024, FF, FF, FF}; pg8::StaticOrder S; S.init(M, 1024, G, bx);
          pg8::EpiResid E{X, X, XB, SS + (size_t)((3 * l + 3) % 3) * M * 16, 0.5f};
          pg8::gemm_phase<pg8::EpiResid, pg8::StaticOrder, true, true>(ldsl, g, S, E); }
        GSYNC();
        if (l == STOP_L && STOP_P == 12) { fin_buf = 0; goto final_norm; }

    }
    { constexpr int l = 1;

        { PH
            const float* n1 = TAB[1] + l * 1024; const float* n2 = TAB[27] + l * 1024; const float* nm = TAB[5] + l * 1024;
            { const float* Wg = TAB[2] + (size_t)l * 1024 * FF; const float* Wu = TAB[3] + (size_t)l * 1024 * FF;
              conv_all([=](int k, int n) { const int ff = (n >> 8) * 128 + (n & 127); return ((n & 128) ? Wu : Wg) + (size_t)k * FF + ff; }, [=](int k) { return n1[k]; }, 1024, 5632, (bf16r*)(ws + W_GU1), scr, gw, NGW, lane); }
            { const float* Wd = TAB[4] + (size_t)l * FF * 1024;
              conv_all([=](int k, int n) { return Wd + (size_t)k * 1024 + n; }, [](int) { return 1.0f; }, FF, 1024, (bf16r*)(ws + W_D1), scr, gw, NGW, lane); }
            { const float* Wg = TAB[28] + (size_t)l * 1024 * FF; const float* Wu = TAB[29] + (size_t)l * 1024 * FF;
              conv_all([=](int k, int n) { const int ff = (n >> 8) * 128 + (n & 127); return ((n & 128) ? Wu : Wg) + (size_t)k * FF + ff; }, [=](int k) { return n2[k]; }, 1024, 5632, (bf16r*)(ws + W_GU2), scr, gw, NGW, lane); }
            { const float* Wd = TAB[30] + (size_t)l * FF * 1024;
              conv_all([=](int k, int n) { return Wd + (size_t)k * 1024 + n; }, [](int) { return 1.0f; }, FF, 1024, (bf16r*)(ws + W_D2), scr, gw, NGW, lane); }
            { const float* Wi = TAB[6] + (size_t)l * 1024 * 3360;
              conv_all([=](int k, int n) { const int sc = n < 2560 ? n : (n < 3328 ? n + 32 : (n < 3360 ? n - 3328 + 2560 : -1)); return sc >= 0 ? Wi + (size_t)k * 3360 + sc : (const float*)nullptr; }, [=](int k) { return nm[k]; }, 1024, NWIN, (bf16r*)(ws + W_IN), scr, gw, NGW, lane); }
            { const float* Wm = TAB[24] + (size_t)l * 1024 * 3072;
              conv_all([=](int k, int n) { return Wm + (size_t)k * 3072 + n; }, [=](int k) { return nm[k]; }, 1024, 3072, (bf16r*)(ws + W_MG), scr, gw, NGW, lane); }
            { const float* Wx = TAB[15] + (size_t)l * 512 * 512;
              conv_all([=](int k, int n) { return Wx + (size_t)k * 512 + n; }, [](int) { return 1.0f; }, 512, 512, (bf16r*)(ws + W_GLU), scr, gw, NGW, lane); }
#pragma unroll
            for (int b = 0; b < 3; ++b) { const float* Wx = TAB[21 + b] + (size_t)l * 512 * 1024;
              conv_all([=](int k, int n) { return Wx + (size_t)k * 1024 + n; }, [](int) { return 1.0f; }, 512, 1024, (bf16r*)(ws + W_BR) + (size_t)b * 1024 * 512, scr, gw, NGW, lane); }
            { const float* Wx = TAB[26] + (size_t)l * 1024 * 1024;
              conv_all([=](int k, int n) { return Wx + (size_t)k * 1024 + n; }, [](int) { return 1.0f; }, 1024, 1024, (bf16r*)(ws + W_OUT), scr, gw, NGW, lane); }
            { bf16r* W1T = (bf16r*)(ws + WS_W1T); bf16r* BTY = (bf16r*)(ws + WS_BTY); float* KT = (float*)(ws + WS_KT);
              __syncthreads();
              { LAS float* LP = (LAS float*)ldsl; LAS float* FB = LP + 1024; LAS float* CC = FB + 2048;
                for (int unit = bx; unit < 256; unit += G) { const int dq = unit & 3, dir = (unit >> 2) & 1, g = unit >> 3;
                  const size_t o1 = ((size_t)(l * 2 + dir) * 32 + g); const float dt = expf(TAB[9][o1]);
                  { const int p = tid & 63, d8 = tid >> 6; const float lre = TAB[7][o1 * 64 + p], lim = TAB[8][o1 * 64 + p];
                    const float ed = (float)(dq * 8 + d8); const float mg = expf(ed * lre * dt), an = ed * lim * dt;
                    LP[(d8 * 64 + p) * 2] = mg * cosf(an); LP[(d8 * 64 + p) * 2 + 1] = mg * sinf(an);
                    const float mag1 = expf(lre * dt), ang1 = lim * dt, lbr = mag1 * cosf(ang1), lbi = mag1 * sinf(ang1);
                    const float den = lre * lre + lim * lim, nr = lbr - 1.0f, ni = lbi, fr = (nr * lre + ni * lim) / den, fi = (ni * lre - nr * lim) / den;
#pragma unroll
                    for (int k = 0; k < 2; ++k) { const int hp = d8 * 2 + k; const float br = TAB[10][(o1 * 64 + p) * 16 + hp], bi = TAB[11][(o1 * 64 + p) * 16 + hp];
                        FB[(p * 16 + hp) * 2] = fr * br - fi * bi; FB[(p * 16 + hp) * 2 + 1] = fr * bi + fi * br;
                        CC[(hp * 64 + p) * 2] = TAB[12][(o1 * 16 + hp) * 64 + p]; CC[(hp * 64 + p) * 2 + 1] = TAB[13][(o1 * 16 + hp) * 64 + p]; } }
                  __syncthreads();
#pragma unroll
                  for (int k = 0; k < 4; ++k) { const int o = tid + 512 * k, hp = o & 15, h = (o >> 4) & 15, d8 = o >> 8; float acc = 0.f;
                      for (int p = 0; p < 64; ++p) { const float cr = CC[(h * 64 + p) * 2], ci = CC[(h * 64 + p) * 2 + 1], pr = LP[(d8 * 64 + p) * 2], pi = LP[(d8 * 64 + p) * 2 + 1];
                          const float wr = cr * pr - ci * pi, wi = cr * pi + ci * pr; acc += wr * FB[(p * 16 + hp) * 2] - wi * FB[(p * 16 + hp) * 2 + 1]; }
                      KT[((((size_t)(g * 2 + dir) * 32 + dq * 8 + d8) * 16 + h) * 16) + hp] = acc; }
                  __syncthreads(); } } }
        }
        GSYNC();
        { PH pg8::Gemm g{XB, (const bf16r*)(ws + W_GU1), M, 5632, 1024, 1024, 1024}; pg8::StaticOrder S; S.init(M, 5632, G, bx);
          pg8::EpiSwiGLU E{HB, SS + (size_t)((3 * l + 0) % 3) * M * 16, FF};
          pg8::gemm_phase<pg8::EpiSwiGLU, pg8::StaticOrder, true, true>(ldsl, g, S, E); }
        { PH
          if (bx >= 128) { const long gt2 = (long)(bx - 128) * 512 + tid, NGT2 = (long)(G - 128) * 512;
            { bf16r* W1T = (bf16r*)(ws + WS_W1T); bf16r* BTY = (bf16r*)(ws + WS_BTY);
              for (long i = gt2; i < 131072; i += NGT2) { const int jq = (int)i & 31, p = (int)(i >> 5) & 63, dir = (int)(i >> 11) & 1, g = (int)(i >> 12);
                const size_t o1 = ((size_t)(l * 2 + dir) * 32 + g);
                const float lre = TAB[7][o1 * 64 + p], lim = TAB[8][o1 * 64 + p], dt = expf(TAB[9][o1]);
                const float mag1 = expf(lre * dt), ang1 = lim * dt, lbr = mag1 * cosf(ang1), lbi = mag1 * sinf(ang1);
                const float den = lre * lre + lim * lim, nr = lbr - 1.0f, ni = lbi, fr = (nr * lre + ni * lim) / den, fi = (ni * lre - nr * lim) / den;
                { const float e1 = (float)(dir ? jq : 31 - jq); const float mg = expf(e1 * lre * dt), an = e1 * lim * dt, pr = mg * cosf(an), pi = mg * sinf(an);
                  const float wr = pr * fr - pi * fi, wi = pr * fi + pi * fr;
                  float re[16], im[16];
#pragma unroll
                  for (int h = 0; h < 16; ++h) { const float br = TAB[10][(o1 * 64 + p) * 16 + h], bi = TAB[11][(o1 * 64 + p) * 16 + h]; re[h] = wr * br - wi * bi; im[h] = wr * bi + wi * br; }
                  v4u* d0 = (v4u*)(W1T + ((size_t)(g * 256 + dir * 128 + 2 * p) * 512 + jq * 16)); v4u* d1 = (v4u*)(W1T + ((size_t)(g * 256 + dir * 128 + 2 * p + 1) * 512 + jq * 16));
                  d0[0] = (v4u){pk2(re[0], re[1]), pk2(re[2], re[3]), pk2(re[4], re[5]), pk2(re[6], re[7])}; d0[1] = (v4u){pk2(re[8], re[9]), pk2(re[10], re[11]), pk2(re[12], re[13]), pk2(re[14], re[15])};
                  d1[0] = (v4u){pk2(im[0], im[1]), pk2(im[2], im[3]), pk2(im[4], im[5]), pk2(im[6], im[7])}; d1[1] = (v4u){pk2(im[8], im[9]), pk2(im[10], im[11]), pk2(im[12], im[13]), pk2(im[14], im[15])}; }
                { const float e2 = (float)(dir ? 32 - jq : jq + 1); const float mg = expf(e2 * lre * dt), an = e2 * lim * dt, pr = mg * cosf(an), pi = mg * sinf(an);
#pragma unroll
                  for (int h = 0; h < 16; ++h) { const float cr = TAB[12][(o1 * 16 + h) * 64 + p], ci = TAB[13][(o1 * 16 + h) * 64 + p]; const float wre = cr * pr - ci * pi, wim = cr * pi + ci * pr;
                      *(unsigned*)(BTY + ((size_t)(g * 512 + jq * 16 + h) * 768 + dir * 128 + 2 * p)) = pk2(wre, -wim); } } }
            }
            {
            const float* KT = (const float*)(ws + WS_KT); bf16r* BTY = (bf16r*)(ws + WS_BTY); const float* dsk = TAB[14] + l * 512;
            for (long it = gt2; it < 524288; it += NGT2) { const int j = (int)it & 31, n = (int)(it >> 5) & 511, g = (int)(it >> 14); const int i = n >> 4, h = n & 15;
                const float* kf = KT + (size_t)((g * 2 + 0) * 32) * 256 + h * 16; const float* kb = KT + (size_t)((g * 2 + 1) * 32) * 256 + h * 16;
                float v[16];
                if (i > j) {
#pragma unroll
                    for (int q = 0; q < 4; ++q) { const f32x4 x = *(const f32x4*)(kf + (i - j) * 256 + 4 * q); v[4 * q] = x[0]; v[4 * q + 1] = x[1]; v[4 * q + 2] = x[2]; v[4 * q + 3] = x[3]; }
                } else if (j > i) {
#pragma unroll
                    for (int q = 0; q < 4; ++q) { const f32x4 x = *(const f32x4*)(kb + (j - i) * 256 + 4 * q); v[4 * q] = x[0]; v[4 * q + 1] = x[1]; v[4 * q + 2] = x[2]; v[4 * q + 3] = x[3]; }
                } else { const float dd = dsk[16 * g + h];
#pragma unroll
                    for (int q = 0; q < 4; ++q) { const f32x4 x = *(const f32x4*)(kf + 4 * q) + *(const f32x4*)(kb + 4 * q); v[4 * q] = x[0]; v[4 * q + 1] = x[1]; v[4 * q + 2] = x[2]; v[4 * q + 3] = x[3]; }
#pragma unroll
                    for (int hp = 0; hp < 16; ++hp) v[hp] += (hp == h) ? dd : 0.f; }
                v4u* dst = (v4u*)(BTY + ((size_t)(g * 512 + n) * 768 + 256 + j * 16));
                dst[0] = (v4u){pk2(v[0], v[1]), pk2(v[2], v[3]), pk2(v[4], v[5]), pk2(v[6], v[7])}; dst[1] = (v4u){pk2(v[8], v[9]), pk2(v[10], v[11]), pk2(v[12], v[13]), pk2(v[14], v[15])}; }
            }
          }
        }
        GSYNC();
        { PH pg8::Gemm g{HB, (const bf16r*)(ws + W_D1), M, 1024, FF, FF, FF}; pg8::StaticOrder S; S.init(M, 1024, G, bx);
          pg8::EpiResid E{(l == 0 ? TAB[0] : (const float*)X), X, XB, SS + (size_t)((3 * l + 1) % 3) * M * 16, 0.5f};
          pg8::gemm_phase<pg8::EpiResid, pg8::StaticOrder, true, true>(ldsl, g, S, E); }
        GSYNC();
        if (l == STOP_L && STOP_P == 2) { fin_buf = 1; goto final_norm; }
        { PH pg8::Gemm g{XB, (const bf16r*)(ws + W_IN), M, 2048, 1024, 1024, 1024}; pg8::StaticOrder S; S.init(M, 2048, G, bx);
          pg8::EpiInSplit E{PROJ, NPROJ, (bf16r*)(ws + WS_UG), SS + (size_t)((3 * l + 1) % 3) * M * 16};
          pg8::gemm_phase<pg8::EpiInSplit, pg8::StaticOrder, true, true>(ldsl, g, S, E); }
        GSYNC();
        { PH pg8::Gemm g{(const bf16r*)(ws + WS_UG) + 256, (const bf16r*)(ws + WS_W1T), 512, 256, 512, 768, 512, (size_t)512 * 768 * 2, (size_t)256 * 512 * 2}; pg8::BatchOrder S; S.init(2, 1, 32, G, bx);
          pg8::EpiF32B E{(float*)(ws + WS_E), 256, (size_t)512 * 256};
          pg8::gemm_phase<pg8::EpiF32B, pg8::BatchOrder, true, true>(ldsl, g, S, E); }
        { PH pg8::Gemm g{XB, (const bf16r*)(ws + W_IN) + (size_t)3072 * 1024, M, 512, 1024, 1024, 1024}; pg8::StaticOrder S; S.init(M, 512, G, (bx + G - 64) % G);
          pg8::EpiScaleBf16 E{PROJ + 2560, NPROJ, SS + (size_t)((3 * l + 1) % 3) * M * 16};
          pg8::gemm_phase<pg8::EpiScaleBf16, pg8::StaticOrder, true, true>(ldsl, g, S, E); }
        GSYNC();
        { PH
            const float* E = (const float*)(ws + WS_E); bf16r* UG = (bf16r*)(ws + WS_UG);
            for (long i = gt; i < 16384; i += NGT) { const int p = (int)i & 63, bb = (int)(i >> 6) & 3, dir = (int)(i >> 8) & 1, g = (int)(i >> 9);
                const size_t o1 = ((size_t)(l * 2 + dir) * 32 + g);
                const float lre = TAB[7][o1 * 64 + p], lim = TAB[8][o1 * 64 + p], dt = expf(TAB[9][o1]);
                const float mg = expf(32.0f * lre * dt), an = 32.0f * lim * dt, ar = mg * cosf(an), ai = mg * sinf(an);
                float xr = 0.f, xi = 0.f;
                for (int c0 = 0; c0 < 128; c0 += 8) { float er[8], ei[8];
#pragma unroll
                    for (int k = 0; k < 8; ++k) { const int c = dir ? 127 - (c0 + k) : c0 + k; const float* pe = E + ((size_t)(g * 512 + bb * 128 + c) * 256 + dir * 128 + 2 * p); er[k] = pe[0]; ei[k] = pe[1]; }
#pragma unroll
                    for (int k = 0; k < 8; ++k) { const int c = dir ? 127 - (c0 + k) : c0 + k;
                        *(unsigned*)(UG + ((size_t)(g * 512 + bb * 128 + c) * 768 + dir * 128 + 2 * p)) = pk2(xr, xi);
                        const float nr = ar * xr - ai * xi + er[k], ni = ar * xi + ai * xr + ei[k]; xr = nr; xi = ni; } } }
        }
        GSYNC();
        { PH pg8::Gemm g{(const bf16r*)(ws + WS_UG), (const bf16r*)(ws + WS_BTY), 512, 512, 768, 768, 768, (size_t)512 * 768 * 2, (size_t)512 * 768 * 2}; pg8::BatchOrder S; S.init(2, 2, 32, G, bx);
          pg8::EpiS5Y E{(bf16r*)(ws + WS_E)};
          pg8::gemm_phase<pg8::EpiS5Y, pg8::BatchOrder, true, true>(ldsl, g, S, E); }
        { PH pg8::Gemm g{XB, (const bf16r*)(ws + W_IN) + (size_t)2048 * 1024, M, 512, 1024, 1024, 1024}; pg8::StaticOrder S; S.init(M, 512, G, (bx + G - 128) % G);
          pg8::EpiScaleBf16 E{PROJ + 1536, NPROJ, SS + (size_t)((3 * l + 1) % 3) * M * 16};
          pg8::gemm_phase<pg8::EpiScaleBf16, pg8::StaticOrder, true, true>(ldsl, g, S, E); }
        GSYNC();
        { PH pg8::Gemm g{(const bf16r*)(ws + WS_E), (const bf16r*)(ws + W_GLU), M, 512, 512, 512, 512}; pg8::StaticOrder S; S.init(M, 512, G, bx);
          pg8::EpiGlu E{(const bf16r*)(ws + WS_E), 512, YS5, 512};
          pg8::gemm_phase<pg8::EpiGlu, pg8::StaticOrder, true, true>(ldsl, g, S, E); }
        { PH pg8::Gemm g{XB, (const bf16r*)(ws + W_IN) + (size_t)2560 * 1024, M, 512, 1024, 1024, 1024}; pg8::StaticOrder S; S.init(M, 512, G, (bx + G - 128) % G);
          pg8::EpiScaleBf16 E{PROJ + 2048, NPROJ, SS + (size_t)((3 * l + 1) % 3) * M * 16};
          pg8::gemm_phase<pg8::EpiScaleBf16, pg8::StaticOrder, true, true>(ldsl, g, S, E); }
        GSYNC();
        { PH
          for (int unit = bx; unit < 256; unit += G) gla_passA_mfma(TAB, l, unit, tid, PROJ, (bf16r*)(ws + WS_GE), (float*)(ws + WS_GDT), ldsl);
          __syncthreads();
          {
            const float* qg = TAB[19] + l * 64; const float* kg = TAB[20] + l * 64;
            const int d = lane, e = d & 31, fi_ = e & 15; const bool second = e >= 16;
            const float* ROPE = (const float*)(ws + WS_ROPE);
            for (long it = gw; it < (long)M * 10; it += NGW) {
                const int row = (int)(it / 10), j = (int)(it % 10); const int tt = row & (SEQ - 1);
                bf16r* px = PROJ + (size_t)row * NPROJ + (j < 8 ? PC_AQ + 64 * j : PC_AK + 64 * (j - 8)) + d;
                const float x = bf2f(*px); const float ssq = wave_sum(x * x);
                const float gain = j < 8 ? qg[d] : kg[d];
                const float y = x * rsqrtf(ssq * (1.0f / 64.0f) + 1e-6f) * gain;
                const int posi = (d < 32) ? (tt >> 6) : (tt & 63);
                const float cs = ROPE[(posi * 16 + fi_) * 2], sn = ROPE[(posi * 16 + fi_) * 2 + 1];
                const float partner = __shfl_xor(y, 16);
                float o = second ? (y * cs + partner * sn) : (y * cs - partner * sn);
                if (j < 8) o *= 0.125f * 1.4426950408889634f;
                *px = (bf16r)f2bf(o);
            }
          }
        }
        GSYNC();
        { PH
          for (int unit = bx; unit < 256; unit += G) gla_passB_mfma(TAB, l, unit, tid, PROJ, ACC, YGLA, (const bf16r*)(ws + WS_GE), (const float*)(ws + WS_GDT), ldsl); }
        GSYNC();
        { PH
            const float* gn = TAB[18] + l * 128;
            for (long it = gw; it < (long)M * 4; it += NGW) { const int row = (int)(it >> 2), h = (int)(it & 3);
                const unsigned oa = *(const unsigned*)((const bf16r*)ACC + (size_t)row * 512 + h * 128 + 2 * lane); const unsigned ob = *(const unsigned*)(YGLA + (size_t)row * 512 + h * 128 + 2 * lane); const float o0 = pg8::bflo(oa) + pg8::bflo(ob), o1 = pg8::bfhi(oa) + pg8::bfhi(ob);
                const float ssq = wave_sum(o0 * o0 + o1 * o1); const float r = rsqrtf(ssq * (1.0f / 128.0f) + 1e-6f);
                const unsigned gg = *(const unsigned*)(PROJ + (size_t)row * NPROJ + PC_GG + h * 128 + 2 * lane);
                const float y0 = o0 * r * gn[2 * lane] * silu_(pg8::bflo(gg)), y1 = o1 * r * gn[2 * lane + 1] * silu_(pg8::bfhi(gg));
                *(unsigned*)(YGLA + (size_t)row * 512 + h * 128 + 2 * lane) = pk2(y0, y1); }
        }
        GSYNC();
#ifndef NO_ATT
        { PH
            const attn_body::AttnTensors AT{(const attn_body::bf16*)(PROJ + PC_AQ), (const attn_body::bf16*)(PROJ + PC_AK), (const attn_body::bf16*)(PROJ + PC_AV), (attn_body::bf16*)YATT};
            const attn_body::StaticOrder S(G, bx);
            attn_body::attn_phase<attn_body::StaticOrder>((char*)lds, AT, S);
        }
#endif
        GSYNC();
#ifndef NO_MERGE
        { PH
            { pg8::Gemm g{XB, (const bf16r*)(ws + W_MG), M, 1024, 1024, 1024, 1024, 0, (size_t)1024 * 1024 * 2}; pg8::TileBatchOrder S; S.init(M, 1024, 3, G, bx);
              pg8::EpiGate3 E{GSCR, TAB[25] + l * 3072, SS + (size_t)((3 * l + 1) % 3) * M * 16};
              pg8::gemm_phase<pg8::EpiGate3, pg8::TileBatchOrder, true, true>(ldsl, g, S, E); }
            { pg8::Gemm g{YS5, (const bf16r*)(ws + W_BR), M, 1024, 512, 512, 512, 0, (size_t)1024 * 512 * 2, {0, (size_t)(WS_YGLA - WS_YS5), (size_t)(WS_ACC - WS_YS5)}, 1}; pg8::TileBatchOrder S; S.init(M, 1024, 3, G, bx);
              pg8::EpiMerge3 E{GSCR, (bf16r*)(ws + WS_MG16)};
              pg8::gemm_phase<pg8::EpiMerge3, pg8::TileBatchOrder, true, true>(ldsl, g, S, E); }
        }
#endif
        GSYNC();
        { PH pg8::Gemm g{GSCR, (const bf16r*)(ws + W_OUT), M, 1024, 1024, 1024, 1024}; pg8::StaticOrder S; S.init(M, 1024, G, bx);
          pg8::EpiResid E{X, X, XB, SS + (size_t)((3 * l + 2) % 3) * M * 16, 1.0f};
          pg8::gemm_phase<pg8::EpiResid, pg8::StaticOrder, true, true>(ldsl, g, S, E); }
        GSYNC();
        if (l == STOP_L && STOP_P == 10) { fin_buf = 2; goto final_norm; }
        { PH pg8::Gemm g{XB, (const bf16r*)(ws + W_GU2), M, 5632, 1024, 1024, 1024}; pg8::StaticOrder S; S.init(M, 5632, G, bx);
          pg8::EpiSwiGLU E{HB, SS + (size_t)((3 * l + 2) % 3) * M * 16, FF};
          pg8::gemm_phase<pg8::EpiSwiGLU, pg8::StaticOrder, true, true>(ldsl, g, S, E); }
        GSYNC();
        { PH pg8::Gemm g{HB, (const bf16r*)(ws + W_D2), M, 1024, FF, FF, FF}; pg8::StaticOrder S; S.init(M, 1024, G, bx);
          pg8::EpiResid E{X, X, XB, SS + (size_t)((3 * l + 3) % 3) * M * 16, 0.5f};
          pg8::gemm_phase<pg8::EpiResid, pg8::StaticOrder, true, true>(ldsl, g, S, E); }
        GSYNC();
        if (l == STOP_L && STOP_P == 12) { fin_buf = 0; goto final_norm; }

    }
    final_norm:
    { PH
        const float* fg = TAB[31];
        for (int m = gw; m < M; m += NGW) { f32x4* xo = (f32x4*)(X + (size_t)m * 1024) + lane; const float r = pg8::rstd1024(SS + (size_t)fin_buf * M * 16, m);
#pragma unroll
            for (int j = 0; j < 4; ++j) { f32x4 v = xo[64 * j]; const f32x4 gq = ((const f32x4*)fg)[lane + 64 * j]; v = v * r * gq; xo[64 * j] = v; } }
    }
}

extern "C" void kernel_launch(void* const* d_in, const int* in_sizes, int n_in, void* d_out, int out_size, void* d_ws, size_t ws_size, hipStream_t stream) {
    static int grid = 0;
    if (grid == 0) {
        if (n_in != 32 || out_size != M * 1024 || ws_size < WS_NEED) { fprintf(stderr, "kernel_launch: unexpected sizes (n_in %d out %d ws %zu)\n", n_in, out_size, ws_size); grid = -1; return; }
        int dev = 0, cus = 0, per_cu = 0;
        hipGetDevice(&dev); hipDeviceGetAttribute(&cus, hipDeviceAttributeMultiprocessorCount, dev);
        hipFuncSetAttribute((const void*)fwd_kernel, hipFuncAttributeMaxDynamicSharedMemorySize, LDS_BYTES);
        hipOccupancyMaxActiveBlocksPerMultiprocessor(&per_cu, (const void*)fwd_kernel, NWAVES * 64, LDS_BYTES);
        if (per_cu < 1) per_cu = 1;
        grid = cus * per_cu; if (grid > 256) grid = 256;
        (void)hipGetLastError();
    }
    if (grid < 0) return;
    if (hipMemsetAsync((char*)d_ws + WS_BAR, 0, 16384, stream) != hipSuccess) { fprintf(stderr, "memset failed\n"); return; }
    Args a{};
    for (int i = 0; i < 32; ++i) a.in[i] = (const float*)d_in[i];
    a.out = (float*)d_out; a.ws = (unsigned char*)d_ws;
    void* kargs[] = {&a};
    hipError_t e = hipLaunchCooperativeKernel((const void*)fwd_kernel, dim3(grid), dim3(NWAVES * 64), kargs, LDS_BYTES, stream);
    if (e != hipSuccess) fprintf(stderr, "cooperative launch failed: %s (grid %d)\n", hipGetErrorString(e), grid);
}
```

```cpp
#include <hip/hip_runtime.h>
#include <hip/hip_cooperative_groups.h>
#include <hip/hip_bf16.h>
#include <cstdio>
#include <cstdint>
#include <cmath>
namespace cg = cooperative_groups;

namespace pg8 {
#define PG8_LAS __attribute__((address_space(3)))
typedef unsigned short bf16_t;
typedef short bf16x8 __attribute__((ext_vector_type(8)));
typedef float f32x4 __attribute__((ext_vector_type(4)));
typedef unsigned u32x4 __attribute__((ext_vector_type(4)));
constexpr int BM = 256, BK = 64, HALF = 128, HTB = HALF * BK * 2  , STAGE_BYTES = 8 * HTB, NXCD = 8, WGM = 8;

__host__ __device__ __forceinline__ int lds_byte(int r, int c) { const int st = (r >> 4) * 2 + (c >> 5), rr = r & 15, cc = c & 31, ob = rr * 64 + cc * 2; return st * 1024 + (ob ^ (((ob >> 9) & 1) << 5)); }
__host__ __device__ __forceinline__ void stage_rc(int b, int& R, int& C) { const int st = b / 1024, sb = b % 1024, swz = sb ^ (((sb >> 9) & 1) << 5); R = (st >> 1) * 16 + swz / 64; C = (st & 1) * 32 + (swz % 64) / 2; }
__host__ __device__ __forceinline__ int perm32(int rho) { const int n = rho >> 4, i = rho & 15; return 8 * (i >> 2) + 4 * n + (i & 3); }

struct Unit { int pm, pn, g; };

struct StaticOrder {
    int nM, nN, nwg, G, c;
    __host__ __device__ void init(int M, int N, int G_, int c_) { nM = M / BM; nN = N / BM; nwg = nM * nN; G = G_; c = c_; }
    __host__ __device__ bool next(int i, Unit& u) const {
        const long L = (long)i * G + c; if (L >= nwg) return false;
        int wgid = (int)L; { const int q = nwg / NXCD, r = nwg % NXCD, xcd = wgid % NXCD, off = wgid / NXCD; wgid = (xcd < r ? xcd * (q + 1) : r * (q + 1) + (xcd - r) * q) + off; }
        const int nig = WGM * nN, gid = wgid / nig, fm = gid * WGM, gsz = (nM - fm) < WGM ? (nM - fm) : WGM;
        u.pm = fm + ((wgid % nig) % gsz); u.pn = (wgid % nig) / gsz; u.g = 0; return true;
    }
    __device__ __forceinline__ void a_ready(const Unit&) const {}
    __device__ __forceinline__ void done(const Unit&) const {}
};

struct Gemm { const bf16_t* A; const bf16_t* Bt; int M, N, K, lda, ldb; size_t sA, sB; size_t aoff[3]; int useoff; };
#define PG8_ABASE(G_, U_) ((const char*)(G_).A + ((G_).useoff ? ((U_).g == 0 ? (G_).aoff[0] : ((U_).g == 1 ? (G_).aoff[1] : (G_).aoff[2])) : (size_t)(U_).g * (G_).sA))
__device__ __forceinline__ unsigned cvt_pk_bf16(float lo, float hi) { unsigned r; asm volatile("v_cvt_pk_bf16_f32 %0, %1, %2" : "=v"(r) : "v"(lo), "v"(hi)); return r; }
__device__ __forceinline__ float bflo(unsigned w) { return __builtin_bit_cast(float, w << 16); }
__device__ __forceinline__ float bfhi(unsigned w) { return __builtin_bit_cast(float, w & 0xffff0000u); }
__device__ __forceinline__ float rstd1024(const float* ss, int row) { const f32x4* p = (const f32x4*)(ss + (size_t)row * 16); const f32x4 a = p[0], b = p[1], c = p[2], d = p[3];
    const float t = ((a[0] + a[1]) + (a[2] + a[3])) + ((b[0] + b[1]) + (b[2] + b[3])) + ((c[0] + c[1]) + (c[2] + c[3])) + ((d[0] + d[1]) + (d[2] + d[3])); return rsqrtf(t * (1.0f / 1024.0f) + 1e-6f); }
__device__ __forceinline__ float sigmoidf_(float x) { return __builtin_amdgcn_rcpf(1.0f + __expf(-x)); }
__device__ __forceinline__ u32x4 pack8(f32x4 a, f32x4 b) { u32x4 w; w.x = cvt_pk_bf16(a[0], a[1]); w.y = cvt_pk_bf16(a[2], a[3]); w.z = cvt_pk_bf16(b[0], b[1]); w.w = cvt_pk_bf16(b[2], b[3]); return w; }
__device__ __forceinline__ void unpack8(u32x4 w, f32x4& a, f32x4& b) { a = (f32x4){bflo(w.x), bfhi(w.x), bflo(w.y), bfhi(w.y)}; b = (f32x4){bflo(w.z), bfhi(w.z), bflo(w.w), bfhi(w.w)}; }

struct EpiSwiGLU {
    static constexpr bool PERM = true, AFTER_DRAIN = false;
    bf16_t* H; const float* ss; int ldh;
    __device__ __forceinline__ void operator()(const f32x4 (&acc)[2][2][4][2], const Unit& u, int wr, int wc, int fr, int fq) const {
        const int row0 = u.pm * BM + wr * 64 + fr, col0 = u.pn * 128 + wc * 32 + 8 * fq;
#pragma unroll
        for (int ai = 0; ai < 2; ++ai)
#pragma unroll
            for (int m = 0; m < 4; ++m) { const int row = row0 + ai * HALF + m * 16; const float r = rstd1024(ss, row);
                f32x4 o[2];
#pragma unroll
                for (int n = 0; n < 2; ++n)
#pragma unroll
                    for (int j = 0; j < 4; ++j) { const float g = acc[ai][0][m][n][j] * r, up = acc[ai][1][m][n][j] * r; o[n][j] = g * sigmoidf_(g) * up; }
                *(u32x4*)(H + (size_t)row * ldh + col0) = pack8(o[0], o[1]); }
    }
};
struct EpiResid {
    static constexpr bool PERM = true, AFTER_DRAIN = false;
    const float* Xin; float* X; bf16_t* XB; float* ssn; float scale;
    __device__ __forceinline__ void operator()(const f32x4 (&acc)[2][2][4][2], const Unit& u, int wr, int wc, int fr, int fq) const {
        const int row0 = u.pm * BM + wr * 64 + fr, col0 = u.pn * BM + wc * 32 + 8 * fq;
#pragma unroll
        for (int ai = 0; ai < 2; ++ai)
#pragma unroll
            for (int m = 0; m < 4; ++m) { const int row = row0 + ai * HALF + m * 16; float part = 0.f;
#pragma unroll
                for (int bj = 0; bj < 2; ++bj) { float* xp = X + (size_t)row * 1024 + col0 + bj * HALF; const float* xi = Xin + (size_t)row * 1024 + col0 + bj * HALF;
                    f32x4 x0 = *(const f32x4*)xi, x1 = *(const f32x4*)(xi + 4);
                    x0 = x0 + acc[ai][bj][m][0] * scale; x1 = x1 + acc[ai][bj][m][1] * scale;
                    *(f32x4*)xp = x0; *(f32x4*)(xp + 4) = x1;
                    if (XB) *(u32x4*)(XB + (size_t)row * 1024 + col0 + bj * HALF) = pack8(x0, x1);
                    part += (x0[0] * x0[0] + x0[1] * x0[1]) + (x0[2] * x0[2] + x0[3] * x0[3]) + (x1[0] * x1[0] + x1[1] * x1[1]) + (x1[2] * x1[2] + x1[3] * x1[3]); }
                part += __shfl_xor(part, 16); part += __shfl_xor(part, 32);
                if (fq == 0) ssn[(size_t)row * 16 + u.pn * 4 + wc] = part; }
    }
};
struct EpiScaleBf16 {
    static constexpr bool PERM = true, AFTER_DRAIN = false;
    bf16_t* O; int ldo; const float* ss;
    __device__ __forceinline__ void operator()(const f32x4 (&acc)[2][2][4][2], const Unit& u, int wr, int wc, int fr, int fq) const {
        const int row0 = u.pm * BM + wr * 64 + fr, col0 = u.pn * BM + wc * 32 + 8 * fq;
#pragma unroll
        for (int ai = 0; ai < 2; ++ai)
#pragma unroll
            for (int m = 0; m < 4; ++m) { const int row = row0 + ai * HALF + m * 16; const float r = rstd1024(ss, row);
#pragma unroll
                for (int bj = 0; bj < 2; ++bj) *(u32x4*)(O + (size_t)row * ldo + col0 + bj * HALF) = pack8(acc[ai][bj][m][0] * r, acc[ai][bj][m][1] * r); }
    }
};
struct EpiGlu {
    static constexpr bool PERM = true, AFTER_DRAIN = false;
    const bf16_t* YG; int ldg; bf16_t* Y; int ldy;
    __device__ __forceinline__ void operator()(const f32x4 (&acc)[2][2][4][2], const Unit& u, int wr, int wc, int fr, int fq) const {
        const int row0 = u.pm * BM + wr * 64 + fr, col0 = u.pn * BM + wc * 32 + 8 * fq;
#pragma unroll
        for (int ai = 0; ai < 2; ++ai)
#pragma unroll
            for (int m = 0; m < 4; ++m) { const int row = row0 + ai * HALF + m * 16;
#pragma unroll
                for (int bj = 0; bj < 2; ++bj) { const int col = col0 + bj * HALF; f32x4 y0, y1; unpack8(*(const u32x4*)(YG + (size_t)row * ldg + col), y0, y1);
#pragma unroll
                    for (int j = 0; j < 4; ++j) { y0[j] *= sigmoidf_(acc[ai][bj][m][0][j]); y1[j] *= sigmoidf_(acc[ai][bj][m][1][j]); }
                    *(u32x4*)(Y + (size_t)row * ldy + col) = pack8(y0, y1); } }
    }
};
struct EpiGate {
    static constexpr bool PERM = true, AFTER_DRAIN = false;
    bf16_t* G; const float* bias; const float* ss;
    __device__ __forceinline__ void operator()(const f32x4 (&acc)[2][2][4][2], const Unit& u, int wr, int wc, int fr, int fq) const {
        const int row0 = u.pm * BM + wr * 64 + fr, col0 = u.pn * BM + wc * 32 + 8 * fq;
#pragma unroll
        for (int ai = 0; ai < 2; ++ai)
#pragma unroll
            for (int m = 0; m < 4; ++m) { const int row = row0 + ai * HALF + m * 16; const float r = rstd1024(ss, row);
#pragma unroll
                for (int bj = 0; bj < 2; ++bj) { const int col = col0 + bj * HALF; const f32x4 b0 = *(const f32x4*)(bias + col), b1 = *(const f32x4*)(bias + col + 4); f32x4 g0, g1;
#pragma unroll
                    for (int j = 0; j < 4; ++j) { g0[j] = sigmoidf_(acc[ai][bj][m][0][j] * r + b0[j]); g1[j] = sigmoidf_(acc[ai][bj][m][1][j] * r + b1[j]); }
                    *(u32x4*)(G + (size_t)row * 1024 + col) = pack8(g0, g1); } }
    }
};
template <int MODE> struct EpiMerge {
    static constexpr bool PERM = true, AFTER_DRAIN = false;
    bf16_t* G; float* MG;
    __device__ __forceinline__ void operator()(const f32x4 (&acc)[2][2][4][2], const Unit& u, int wr, int wc, int fr, int fq) const {
        const int row0 = u.pm * BM + wr * 64 + fr, col0 = u.pn * BM + wc * 32 + 8 * fq;
#pragma unroll
        for (int ai = 0; ai < 2; ++ai)
#pragma unroll
            for (int m = 0; m < 4; ++m) { const int row = row0 + ai * HALF + m * 16;
#pragma unroll
                for (int bj = 0; bj < 2; ++bj) { const size_t off = (size_t)row * 1024 + col0 + bj * HALF; f32x4 g0, g1; unpack8(*(const u32x4*)(G + off), g0, g1);
                    f32x4 v0 = g0 * acc[ai][bj][m][0], v1 = g1 * acc[ai][bj][m][1];
                    if (MODE != 0) { v0 = v0 + *(const f32x4*)(MG + off); v1 = v1 + *(const f32x4*)(MG + off + 4); }
                    if (MODE != 2) { *(f32x4*)(MG + off) = v0; *(f32x4*)(MG + off + 4) = v1; }
                    else *(u32x4*)(G + off) = pack8(v0, v1); } }
    }
};

struct BatchOrder {
    int nM, nN, per, total, G, c;
    __device__ void init(int nM_, int nN_, int nb, int G_, int c_) { nM = nM_; nN = nN_; per = nM_ * nN_; total = per * nb; G = G_; c = c_; }
    __device__ bool next(int i, Unit& u) const { const int L = i * G + c; if (L >= total) return false; u.g = L / per; const int r = L % per; u.pm = r / nN; u.pn = r % nN; return true; }
    __device__ __forceinline__ void a_ready(const Unit&) const {}
    __device__ __forceinline__ void done(const Unit&) const {}
};
struct TileBatchOrder {
    StaticOrder so; int nb;
    __device__ void init(int M, int N, int nb_, int G_, int c_) { so.init(M, N, G_, c_); nb = nb_; }
    __device__ bool next(int i, Unit& u) const { if (!so.next(i / nb, u)) return false; u.g = i % nb; return true; }
    __device__ __forceinline__ void a_ready(const Unit&) const {}
    __device__ __forceinline__ void done(const Unit&) const {}
};
struct EpiGate3 {
    static constexpr bool PERM = true, AFTER_DRAIN = false;
    bf16_t* G3; const float* bias; const float* ss;
    __device__ __forceinline__ void operator()(const f32x4 (&acc)[2][2][4][2], const Unit& u, int wr, int wc, int fr, int fq) const {
        const int row0 = u.pm * BM + wr * 64 + fr, col0 = u.pn * BM + wc * 32 + 8 * fq;
        bf16_t* Gb = G3 + (size_t)u.g * 16384 * 1024; const float* bb = bias + u.g * 1024;
#pragma unroll
        for (int ai = 0; ai < 2; ++ai)
#pragma unroll
            for (int m = 0; m < 4; ++m) { const int row = row0 + ai * HALF + m * 16; const float r = rstd1024(ss, row);
#pragma unroll
                for (int bj = 0; bj < 2; ++bj) { const int col = col0 + bj * HALF; const f32x4 b0 = *(const f32x4*)(bb + col), b1 = *(const f32x4*)(bb + col + 4); f32x4 g0, g1;
#pragma unroll
                    for (int j = 0; j < 4; ++j) { g0[j] = sigmoidf_(acc[ai][bj][m][0][j] * r + b0[j]); g1[j] = sigmoidf_(acc[ai][bj][m][1][j] * r + b1[j]); }
                    *(u32x4*)(Gb + (size_t)row * 1024 + col) = pack8(g0, g1); } }
    }
};
struct EpiMerge3 {
    static constexpr bool PERM = true, AFTER_DRAIN = false;
    bf16_t* G3; bf16_t* MG;
    __device__ __forceinline__ void operator()(const f32x4 (&acc)[2][2][4][2], const Unit& u, int wr, int wc, int fr, int fq) const {
        const int row0 = u.pm * BM + wr * 64 + fr, col0 = u.pn * BM + wc * 32 + 8 * fq;
        const bf16_t* Gb = G3 + (size_t)u.g * 16384 * 1024;
#pragma unroll
        for (int ai = 0; ai < 2; ++ai)
#pragma unroll
            for (int m = 0; m < 4; ++m) { const int row = row0 + ai * HALF + m * 16;
#pragma unroll
                for (int bj = 0; bj < 2; ++bj) { const size_t off = (size_t)row * 1024 + col0 + bj * HALF; f32x4 g0, g1; unpack8(*(const u32x4*)(Gb + off), g0, g1);
                    f32x4 v0 = g0 * acc[ai][bj][m][0], v1 = g1 * acc[ai][bj][m][1];
                    if (u.g != 0) { f32x4 m0, m1; unpack8(*(const u32x4*)(MG + off), m0, m1); v0 = v0 + m0; v1 = v1 + m1; }
                    if (u.g != 2) *(u32x4*)(MG + off) = pack8(v0, v1); else *(u32x4*)(G3 + off) = pack8(v0, v1); } }
    }
};
struct EpiInSplit {
    static constexpr bool PERM = true, AFTER_DRAIN = false;
    bf16_t* O; int ldo; bf16_t* UG; const float* ss;
    __device__ __forceinline__ void operator()(const f32x4 (&acc)[2][2][4][2], const Unit& u, int wr, int wc, int fr, int fq) const {
        const int row0 = u.pm * BM + wr * 64 + fr;
#pragma unroll
        for (int ai = 0; ai < 2; ++ai)
#pragma unroll
            for (int m = 0; m < 4; ++m) { const int row = row0 + ai * HALF + m * 16; const float r = rstd1024(ss, row);
#pragma unroll
                for (int bj = 0; bj < 2; ++bj) { const u32x4 w = pack8(acc[ai][bj][m][0] * r, acc[ai][bj][m][1] * r);
                    if (u.pn < 2) { const int cidx = u.pn * BM + bj * HALF + wc * 32 + 8 * fq, gg = cidx >> 4, h0 = cidx & 15, b = row >> 12, tt = row & 4095;
                        *(u32x4*)(UG + ((size_t)(gg * 512 + b * 128 + (tt >> 5)) * 768 + 256 + (tt & 31) * 16 + h0)) = w; }
                    else *(u32x4*)(O + (size_t)row * ldo + (u.pn - 2) * BM + bj * HALF + wc * 32 + 8 * fq) = w; } }
    }
};
struct EpiF32B {
    static constexpr bool PERM = true, AFTER_DRAIN = false;
    float* C; int ldc; size_t sC;
    __device__ __forceinline__ void operator()(const f32x4 (&acc)[2][2][4][2], const Unit& u, int wr, int wc, int fr, int fq) const {
        const int row0 = u.pm * BM + wr * 64 + fr, col0 = u.pn * BM + wc * 32 + 8 * fq;
#pragma unroll
        for (int ai = 0; ai < 2; ++ai)
#pragma unroll
            for (int m = 0; m < 4; ++m) { const int row = row0 + ai * HALF + m * 16;
#pragma unroll
                for (int bj = 0; bj < 2; ++bj) { float* p = C + (size_t)u.g * sC + (size_t)row * ldc + col0 + bj * HALF; *(f32x4*)p = acc[ai][bj][m][0]; *(f32x4*)(p + 4) = acc[ai][bj][m][1]; } }
    }
};
__device__ __forceinline__ float gelu_tanh_(float x) { const float z = 0.7978845608028654f * (x + 0.044715f * x * x * x); const float tt = 1.0f - 2.0f * __builtin_amdgcn_rcpf(__expf(2.0f * z) + 1.0f); return 0.5f * x * (1.0f + tt); }
struct EpiS5Y {
    static constexpr bool PERM = true, AFTER_DRAIN = false;
    bf16_t* YG;
    __device__ __forceinline__ void operator()(const f32x4 (&acc)[2][2][4][2], const Unit& u, int wr, int wc, int fr, int fq) const {
        const int row0 = u.pm * BM + wr * 64 + fr, col0 = u.pn * BM + wc * 32 + 8 * fq;
#pragma unroll
        for (int ai = 0; ai < 2; ++ai)
#pragma unroll
            for (int m = 0; m < 4; ++m) { const int r = row0 + ai * HALF + m * 16, b = r >> 7, c = r & 127;
#pragma unroll
                for (int bj = 0; bj < 2; ++bj) { const int n = col0 + bj * HALF, i = n >> 4, h0 = n & 15; f32x4 y0, y1;
#pragma unroll
                    for (int j = 0; j < 4; ++j) { y0[j] = gelu_tanh_(acc[ai][bj][m][0][j]); y1[j] = gelu_tanh_(acc[ai][bj][m][1][j]); }
                    *(u32x4*)(YG + (size_t)(b * 4096 + 32 * c + i) * 512 + 16 * u.g + h0) = pack8(y0, y1); } }
    }
};
template <class Epi, class Sched, bool ALIGN_EPI = false, bool SP2 = false>
__device__ __forceinline__ void gemm_phase(PG8_LAS unsigned char* lds, const Gemm g, const Sched& S, const Epi& E) {
    int tid_o = threadIdx.x; asm volatile("" : "+v"(tid_o));
    const int tid = tid_o, wid = __builtin_amdgcn_readfirstlane(tid >> 6), lane = tid & 63, wr = wid >> 2, wc = wid & 3, fr = lane & 15, fq = lane >> 4;
    const int K = g.K, nt = K / BK;
    unsigned voffA[2], voffB[2];
#pragma unroll
    for (int i = 0; i < 2; ++i) { int R, C; stage_rc(tid * 16 + i * 8192, R, C); const int Rb = Epi::PERM ? ((R & ~31) + perm32(R & 31)) : R;
        voffA[i] = (unsigned)(R * g.lda + C) * 2u; voffB[i] = (unsigned)(Rb * g.ldb + C) * 2u; }
    const size_t kstep = (size_t)(BK * 2);
    const size_t hstepA = (size_t)HALF * g.lda * 2, hstepB = (size_t)HALF * g.ldb * 2;
    const size_t tstepA = 2 * hstepA, tstepB = 2 * hstepB;
    const unsigned ldsw = (unsigned)wid * 1024u;
    const int aoff = lds_byte(wr * 64 + fr, fq * 8), boff = lds_byte(wc * 32 + fr, fq * 8);
#define PG8_SA(b, h) (((b) * 2 + (h)) * HTB)
#define PG8_SB(b, h) ((4 + (b) * 2 + (h)) * HTB)
#define PG8_STAGE(bufoff, gbase, voff) do { _Pragma("unroll") for (int _i = 0; _i < 2; ++_i) \
        __builtin_amdgcn_global_load_lds((const unsigned*)((const char*)(gbase) + (voff)[_i]), (PG8_LAS unsigned*)(lds + (bufoff) + ldsw + _i * 8192), 16, 0, 0); } while (0)
#define PG8_LDA(dst, b, h) do { _Pragma("unroll") for (int m = 0; m < 4; ++m) _Pragma("unroll") for (int k = 0; k < 2; ++k) dst[m][k] = *(const PG8_LAS bf16x8*)(lds + PG8_SA(b, h) + aoff + m * 2048 + k * 1024); } while (0)
#define PG8_LDB(dst, b, h) do { _Pragma("unroll") for (int n = 0; n < 2; ++n) _Pragma("unroll") for (int k = 0; k < 2; ++k) dst[n][k] = *(const PG8_LAS bf16x8*)(lds + PG8_SB(b, h) + boff + n * 2048 + k * 1024); } while (0)
#define PG8_MMA(ai, bj, At, Bt) do { __builtin_amdgcn_s_setprio(1); _Pragma("unroll") for (int m = 0; m < 4; ++m) _Pragma("unroll") for (int n = 0; n < 2; ++n) _Pragma("unroll") for (int k = 0; k < 2; ++k) \
        acc[ai][bj][m][n] = __builtin_amdgcn_mfma_f32_16x16x32_bf16(Bt[n][k], At[m][k], acc[ai][bj][m][n], 0, 0, 0); __builtin_amdgcn_s_setprio(0); } while (0)
#define PG8_WAIT_V(n) asm volatile("s_waitcnt vmcnt(" #n ")" ::: "memory")
#define PG8_WAIT_L(n) asm volatile("s_waitcnt lgkmcnt(" #n ")" ::: "memory")
#define PG8_BAR __builtin_amdgcn_s_barrier()
#define PG8_SCHED __builtin_amdgcn_sched_barrier(0)
    Unit cur, nxt; int ui = 0;
    if (!S.next(0, cur)) return;
    f32x4 acc[2][2][4][2];
#pragma unroll
    for (int a = 0; a < 2; ++a)
#pragma unroll
        for (int b = 0; b < 2; ++b)
#pragma unroll
            for (int m = 0; m < 4; ++m)
#pragma unroll
                for (int n = 0; n < 2; ++n) acc[a][b][m][n] = (f32x4){0.f, 0.f, 0.f, 0.f};
    bf16x8 At[4][2], B0[2][2], B1[2][2];
    const char* cA = PG8_ABASE(g, cur) + (size_t)cur.pm * tstepA; const char* cB = (const char*)g.Bt + (size_t)cur.g * g.sB + (size_t)cur.pn * tstepB;
    S.a_ready(cur);
    if constexpr (SP2) {
        PG8_STAGE(PG8_SB(0, 0), cB, voffB); PG8_STAGE(PG8_SB(0, 1), cB + hstepB, voffB); PG8_STAGE(PG8_SA(0, 0), cA, voffA); PG8_STAGE(PG8_SA(0, 1), cA + hstepA, voffA);
        if (wr == 1) PG8_BAR;
        PG8_WAIT_V(2); PG8_BAR;
        PG8_STAGE(PG8_SB(1, 0), cB + kstep, voffB); PG8_STAGE(PG8_SA(1, 0), cA + kstep, voffA); PG8_STAGE(PG8_SB(1, 1), cB + hstepB + kstep, voffB);
        PG8_WAIT_V(6); PG8_BAR;
    } else {
        PG8_STAGE(PG8_SB(0, 0), cB, voffB); PG8_STAGE(PG8_SA(0, 0), cA, voffA); PG8_STAGE(PG8_SB(0, 1), cB + hstepB, voffB); PG8_STAGE(PG8_SA(0, 1), cA + hstepA, voffA);
        if (wr == 1) PG8_BAR;
        PG8_WAIT_V(4); PG8_BAR;
        PG8_STAGE(PG8_SB(1, 0), cB + kstep, voffB); PG8_STAGE(PG8_SA(1, 0), cA + kstep, voffA); PG8_STAGE(PG8_SB(1, 1), cB + hstepB + kstep, voffB);
        PG8_WAIT_V(6); PG8_BAR;
    }
    for (;;) {
        const bool has_next = S.next(ui + 1, nxt);
        const char* nA = has_next ? PG8_ABASE(g, nxt) + (size_t)nxt.pm * tstepA : cA; const char* nB = has_next ? (const char*)g.Bt + (size_t)nxt.g * g.sB + (size_t)nxt.pn * tstepB : cB;
        for (int t = 0; t < nt; t += 2) {
            const bool last = (t == nt - 2);
            const char* a1 = cA + (size_t)(t + 1) * kstep;
            const char* a2 = last ? nA : cA + (size_t)(t + 2) * kstep; const char* b2 = last ? nB : cB + (size_t)(t + 2) * kstep;
            const char* a3 = a2 + kstep; const char* b3 = b2 + kstep;
            if (last && has_next) S.a_ready(nxt);
            if constexpr (SP2) {
            PG8_LDB(B0, 0, 0); PG8_LDB(B1, 0, 1); PG8_SCHED; PG8_LDA(At, 0, 0); PG8_STAGE(PG8_SA(1, 1), a1 + hstepA, voffA);
            PG8_WAIT_V(8); PG8_WAIT_L(0); PG8_BAR; PG8_MMA(0, 0, At, B0); PG8_MMA(0, 1, At, B1); PG8_BAR; PG8_SCHED;
            PG8_LDA(At, 0, 1); PG8_STAGE(PG8_SB(0, 0), b2, voffB); PG8_STAGE(PG8_SB(0, 1), b2 + hstepB, voffB); PG8_STAGE(PG8_SA(0, 0), a2, voffA);
            PG8_WAIT_V(8); PG8_WAIT_L(0); PG8_BAR; PG8_MMA(1, 0, At, B0); PG8_MMA(1, 1, At, B1); PG8_BAR; PG8_SCHED;
            PG8_LDB(B0, 1, 0); PG8_LDB(B1, 1, 1); PG8_SCHED; PG8_LDA(At, 1, 0); PG8_STAGE(PG8_SA(0, 1), a2 + hstepA, voffA);
            PG8_WAIT_V(8); PG8_WAIT_L(0); PG8_BAR; PG8_MMA(0, 0, At, B0); PG8_MMA(0, 1, At, B1); PG8_BAR; PG8_SCHED;
            PG8_LDA(At, 1, 1); PG8_STAGE(PG8_SB(1, 0), b3, voffB); PG8_STAGE(PG8_SB(1, 1), b3 + hstepB, voffB); PG8_STAGE(PG8_SA(1, 0), a3, voffA);
            PG8_WAIT_V(8); PG8_WAIT_L(0); PG8_BAR; PG8_MMA(1, 0, At, B0); PG8_MMA(1, 1, At, B1); PG8_BAR; PG8_SCHED;
            } else {
            PG8_LDB(B0, 0, 0); PG8_SCHED; PG8_LDA(At, 0, 0); PG8_STAGE(PG8_SA(1, 1), a1 + hstepA, voffA);
            PG8_WAIT_L(8); PG8_BAR; PG8_WAIT_L(0); PG8_MMA(0, 0, At, B0); PG8_BAR; PG8_SCHED;
            PG8_LDB(B1, 0, 1); PG8_STAGE(PG8_SB(0, 0), b2, voffB);
            PG8_BAR; PG8_WAIT_L(0); PG8_MMA(0, 1, At, B1); PG8_BAR;
            PG8_LDA(At, 0, 1); PG8_STAGE(PG8_SA(0, 0), a2, voffA);
            PG8_BAR; PG8_WAIT_L(0); PG8_MMA(1, 0, At, B0); PG8_BAR; PG8_SCHED;
            PG8_STAGE(PG8_SB(0, 1), b2 + hstepB, voffB);
            PG8_WAIT_V(6); PG8_BAR; PG8_MMA(1, 1, At, B1); PG8_BAR;
            PG8_LDB(B0, 1, 0); PG8_SCHED; PG8_LDA(At, 1, 0); PG8_STAGE(PG8_SA(0, 1), a2 + hstepA, voffA);
            PG8_WAIT_L(8); PG8_BAR; PG8_WAIT_L(0); PG8_MMA(0, 0, At, B0); PG8_BAR; PG8_SCHED;
            PG8_LDB(B1, 1, 1); PG8_STAGE(PG8_SB(1, 0), b3, voffB);
            PG8_BAR; PG8_WAIT_L(0); PG8_MMA(0, 1, At, B1); PG8_BAR;
            PG8_LDA(At, 1, 1); PG8_STAGE(PG8_SA(1, 0), a3, voffA);
            PG8_BAR; PG8_WAIT_L(0); PG8_MMA(1, 0, At, B0); PG8_BAR; PG8_SCHED;
            PG8_STAGE(PG8_SB(1, 1), b3 + hstepB, voffB);
            PG8_WAIT_V(6); PG8_BAR; PG8_MMA(1, 1, At, B1); PG8_BAR;
            }
        }
        if constexpr (ALIGN_EPI) { if (wr == 0) PG8_BAR; }
        if constexpr (!Epi::AFTER_DRAIN) { E(acc, cur, wr, wc, fr, fq); S.done(cur); }
        if (!has_next) break;
#pragma unroll
        for (int a = 0; a < 2; ++a)
#pragma unroll
            for (int b = 0; b < 2; ++b)
#pragma unroll
                for (int m = 0; m < 4; ++m)
#pragma unroll
                    for (int n = 0; n < 2; ++n) acc[a][b][m][n] = (f32x4){0.f, 0.f, 0.f, 0.f};
        cur = nxt; cA = nA; cB = nB; ++ui;
        if constexpr (ALIGN_EPI) { if (wr == 1) PG8_BAR; }
    }
    PG8_WAIT_V(0);
    if constexpr (!ALIGN_EPI) { if (wr == 0) PG8_BAR; }
    PG8_BAR;
    if constexpr (Epi::AFTER_DRAIN) { E.fused(acc, cur, wr, wc, fr, fq, lds, wid, lane); S.done(cur); }
#undef PG8_SA
#undef PG8_SB
#undef PG8_STAGE
#undef PG8_LDA
#undef PG8_LDB
#undef PG8_MMA
#undef PG8_WAIT_V
#undef PG8_WAIT_L
#undef PG8_BAR
#undef PG8_SCHED
}
}
#include <hip/hip_bf16.h>
namespace attn_body {
using bf16=__hip_bfloat16;
using bf16x8=__attribute__((ext_vector_type(8)))short;
using s16x4=__attribute__((ext_vector_type(4)))short;
using f32x16=__attribute__((ext_vector_type(16)))float;
using u32x4=__attribute__((ext_vector_type(4)))unsigned;
constexpr int BATCH=4,NHEAD=8,NKV=2,SEQ=4096,D=64,DM=3072,DMO=512;
constexpr int NW=8,QBLK=32,QB=QBLK*NW,KVBLK=64,NQB=SEQ/QB;
constexpr int ATTN_PITCH=DM, ATTN_UNIT_ROWS=QB;
__device__ __forceinline__ int crow(int r,int hi){return (r&3)+8*(r>>2)+4*hi;}
#define SBAR() __builtin_amdgcn_sched_barrier(0)
__device__ __forceinline__ void cmask(f32x16&p0,f32x16&p1,int jb,int qrel,int hi){
  const float NEG=-INFINITY; int kb=64*jb+4*hi;
  #pragma unroll
  for(int r=0;r<16;++r){int kv=kb+(r&3)+8*(r>>2); if(kv>qrel)p0[r]=NEG; if(kv+32>qrel)p1[r]=NEG;}
}

constexpr int NSLOT=3, SLOTB=8192;
constexpr int LDS_K=0, LDS_V=NSLOT*SLOTB, LDS_WS=2*NSLOT*SLOTB, LDS_OST=LDS_WS+NW*64*4, LDS_BYTES=LDS_OST+NW*4096;
constexpr float C2=0.125f*1.4426950408889634f;
__device__ __forceinline__ void glds16(const void*gsrc,unsigned lds_dst){unsigned keep;
  asm volatile("s_mov_b32 %0, m0\n\ts_mov_b32 m0, %2\n\ts_nop 0\n\tglobal_load_lds_dwordx4 %1, off\n\ts_mov_b32 m0, %0":"=&s"(keep):"v"(gsrc),"s"(lds_dst):"memory");}
__device__ __forceinline__ float max3f(float a,float b,float c){float r;asm("v_max3_f32 %0, %1, %2, %3":"=v"(r):"v"(a),"v"(b),"v"(c));return r;}
__device__ __forceinline__ float max2f(float a,float b){float r;asm("v_max_f32_e32 %0, %1, %2":"=v"(r):"v"(a),"v"(b));return r;}
__device__ __forceinline__ float fadd_s(float a,float b){float r;asm("v_add_f32_e32 %0, %1, %2":"=v"(r):"v"(a),"v"(b));return r;}
__device__ __forceinline__ float fsub_s(float a,float b){float r;asm("v_sub_f32_e32 %0, %1, %2":"=v"(r):"v"(a),"v"(b));return r;}
typedef float f32x2_t __attribute__((ext_vector_type(2))); typedef __bf16 bf16x2_t __attribute__((ext_vector_type(2)));
__device__ __forceinline__ unsigned cvtpk_s(float lo,float hi){f32x2_t v={lo,hi};bf16x2_t b=__builtin_convertvector(v,bf16x2_t);return __builtin_bit_cast(unsigned,b);}
#define WAIT_BAR(N) asm volatile("s_waitcnt vmcnt(" #N ") lgkmcnt(0)\n\ts_barrier":::"memory")

__device__ __forceinline__ void qkt(f32x16&p0,f32x16&p1,const char*Kslot,const bf16x8*qr,const f32x16&negm,int r32,int hi){
  const char*kb=Kslot+hi*1024+r32*16;
  #pragma unroll
  for(int d0=0;d0<4;++d0){
    const bf16x8 b0=*reinterpret_cast<const bf16x8*>(kb+d0*2048);
    const bf16x8 b1=*reinterpret_cast<const bf16x8*>(kb+d0*2048+512);
    if(d0==0){p0=__builtin_amdgcn_mfma_f32_32x32x16_bf16(b0,qr[0],negm,0,0,0);p1=__builtin_amdgcn_mfma_f32_32x32x16_bf16(b1,qr[0],negm,0,0,0);}
    else{p0=__builtin_amdgcn_mfma_f32_32x32x16_bf16(b0,qr[d0],p0,0,0,0);p1=__builtin_amdgcn_mfma_f32_32x32x16_bf16(b1,qr[d0],p1,0,0,0);}}
}
typedef __attribute__((address_space(3))) const char* lds_cptr;
typedef short v4i16_t __attribute__((ext_vector_type(4)));
__device__ __forceinline__ void kload8(bf16x8*kf,lds_cptr kp){
  kf[0]=*(const __attribute__((address_space(3))) bf16x8*)(kp);      kf[1]=*(const __attribute__((address_space(3))) bf16x8*)(kp+512);
  kf[2]=*(const __attribute__((address_space(3))) bf16x8*)(kp+2048); kf[3]=*(const __attribute__((address_space(3))) bf16x8*)(kp+2560);
  kf[4]=*(const __attribute__((address_space(3))) bf16x8*)(kp+4096); kf[5]=*(const __attribute__((address_space(3))) bf16x8*)(kp+4608);
  kf[6]=*(const __attribute__((address_space(3))) bf16x8*)(kp+6144); kf[7]=*(const __attribute__((address_space(3))) bf16x8*)(kp+6656);
}
__device__ __forceinline__ void kload2(bf16x8*kf,lds_cptr kp,int j){ kf[2*j]=*(const __attribute__((address_space(3))) bf16x8*)(kp+j*2048); kf[2*j+1]=*(const __attribute__((address_space(3))) bf16x8*)(kp+j*2048+512); }
__device__ __forceinline__ s16x4 vtr(lds_cptr p){ return __builtin_bit_cast(s16x4,__builtin_amdgcn_ds_read_tr16_b64_v4i16((__attribute__((address_space(3))) v4i16_t*)p)); }
__device__ __forceinline__ float rowmax(const f32x16&p0,const f32x16&p1){
  float a=max3f(p0[0],p0[1],p1[0]),b=max3f(p0[2],p0[3],p1[1]);a=max3f(a,p1[2],p1[3]);
  #pragma unroll
  for(int r=4;r<16;r+=4){a=max3f(a,p0[r],p0[r+1]);b=max3f(b,p0[r+2],p0[r+3]);a=max3f(a,p1[r],p1[r+1]);b=max3f(b,p1[r+2],p1[r+3]);}
  const float m=max2f(a,b);
  auto rr=__builtin_amdgcn_permlane32_swap(__float_as_uint(m),__float_as_uint(m),false,false);
  return max2f(__uint_as_float(rr[0]),__uint_as_float(rr[1]));
}
__device__ __forceinline__ void pv(f32x16*o,int vb,bf16x8 pa0,bf16x8 pa1,bf16x8 pa2,bf16x8 pa3){
  #pragma unroll
  for(int d0=0;d0<2;++d0){s16x4 lo[4],hi[4];
    #pragma unroll
    for(int ks=0;ks<4;++ks){
      asm volatile("ds_read_b64_tr_b16 %0,%1 offset:%c2":"=&v"(lo[ks]):"v"(vb),"i"(d0*4096+ks*1024):"memory");
      asm volatile("ds_read_b64_tr_b16 %0,%1 offset:%c2":"=&v"(hi[ks]):"v"(vb),"i"(d0*4096+ks*1024+512):"memory");}
    asm volatile("s_waitcnt lgkmcnt(0)":::"memory");SBAR();
    #define PK(k) (bf16x8){lo[k][0],lo[k][1],lo[k][2],lo[k][3],hi[k][0],hi[k][1],hi[k][2],hi[k][3]}
    o[d0]=__builtin_amdgcn_mfma_f32_32x32x16_bf16(pa0,PK(0),o[d0],0,0,0);
    o[d0]=__builtin_amdgcn_mfma_f32_32x32x16_bf16(pa1,PK(1),o[d0],0,0,0);
    o[d0]=__builtin_amdgcn_mfma_f32_32x32x16_bf16(pa2,PK(2),o[d0],0,0,0);
    o[d0]=__builtin_amdgcn_mfma_f32_32x32x16_bf16(pa3,PK(3),o[d0],0,0,0);
    #undef PK
  }
}

#ifndef ATTN_STORE16
#define ATTN_STORE16(p,v) (*(u32x4*)(p)=(v))
#endif
template<int THRL> __device__ __forceinline__ void attn_unit(int b,int h,int qb,const bf16*Q,const bf16*__restrict__ K,const bf16*__restrict__ V,bf16*O,char*shm){
  int tid_o=threadIdx.x; asm volatile("":"+v"(tid_o)); const int tid=tid_o,lane=tid&63,r32=lane&31,hi=lane>>5; const int wid=__builtin_amdgcn_readfirstlane(tid>>6);
  const long rowbase=(long)b*SEQ; const int q0=qb*QB;
  const bf16*Qw=Q+(rowbase+q0+wid*QBLK)*DM+h*D;
  const bf16*Kh=K+rowbase*DM+(h>>2)*D,*Vh=V+rowbase*DM+(h>>2)*D;
  const unsigned lds0=(unsigned)(uintptr_t)shm;
  float*wsf=(float*)(shm+LDS_WS)+wid*64;
  const bf16*ksrc=Kh+(long)lane*DM+wid*8;
  const bf16*vsrc=Vh+(long)(16*(wid&3)+(lane>>2))*DM+(wid>>2)*32+(lane&3)*8;
  const unsigned kdst=lds0+LDS_K+wid*1024, vdst=lds0+LDS_V+wid*1024;
  #define DMA_K(t,slot) glds16(ksrc+(long)(t)*KVBLK*DM,(unsigned)__builtin_amdgcn_readfirstlane(kdst+(slot)))
  #define DMA_V(t,slot) glds16(vsrc+(long)(t)*KVBLK*DM,(unsigned)__builtin_amdgcn_readfirstlane(vdst+(slot)))
  const int vb0=(int)(lds0+LDS_V)+((lane>>4)&1)*32+(lane&3)*8+(4*hi+((lane&15)>>2))*64;
  const char*Kbase=shm+LDS_K; bf16x8 kf[8];
  const lds_cptr shm3=(lds_cptr)shm; const lds_cptr kp0=shm3+LDS_K+hi*1024+r32*16; const lds_cptr vp0=shm3+LDS_V+((lane>>4)&1)*32+(lane&3)*8+(4*hi+((lane&15)>>2))*64;
  const int NT=SEQ/KVBLK;
  DMA_K(0,0);DMA_V(0,0);DMA_K(1,SLOTB);
  bf16x8 qr[4];
  #pragma unroll
  for(int d0=0;d0<4;++d0)qr[d0]=*reinterpret_cast<const bf16x8*>(&Qw[(long)r32*DM+d0*16+hi*8]);
  float mhat=0.f,l_reg=0.f;f32x16 o[2];o[0]=f32x16{};o[1]=f32x16{};f32x16 negm=f32x16{};asm volatile("":"+v"(negm));

  #define CMASK(P0,P1,t) do{}while(0)
  bool resc=false;
  #define START(P0,P1) do{ const float rm=rowmax(P0,P1); resc=false; \
    { const float dl=rm; mhat=fadd_s(mhat,dl); \
      _Pragma("unroll") for(int r=0;r<16;++r){P0[r]=fsub_s(P0[r],dl);P1[r]=fsub_s(P1[r],dl);} \
      _Pragma("unroll") for(int r=0;r<16;++r)negm[r]=-mhat; asm volatile("":"+v"(negm)); } \
    _Pragma("unroll") for(int r=0;r<16;++r)P0[r]=__builtin_amdgcn_exp2f(P0[r]); }while(0)
  #define RESC() do{ if(resc){ asm volatile("s_waitcnt lgkmcnt(0)":::"memory"); \
      _Pragma("unroll") for(int d_=0;d_<2;++d_) _Pragma("unroll") for(int r=0;r<16;++r)o[d_][r]*=wsf[crow(r,hi)]; } }while(0)
  f32x16 pA0,pA1,pB0,pB1;
  int sl_prev=0,sl_cur=0,sl_next=SLOTB;
  #define ROT() do{sl_prev=sl_cur;sl_cur=sl_next;sl_next=(sl_next==(NSLOT-1)*SLOTB)?0:sl_next+SLOTB;}while(0)
  DMA_K(2,2*SLOTB);
  WAIT_BAR(3);
  qkt(pA0,pA1,Kbase,qr,negm,r32,hi);asm volatile("s_nop 15\n\ts_nop 7":"+v"(pA0),"+v"(pA1));CMASK(pA0,pA1,0);
  START(pA0,pA1);
  _Pragma("unroll") for(int r=0;r<16;++r)pA1[r]=__builtin_amdgcn_exp2f(pA1[r]);
  WAIT_BAR(0);
  DMA_K(3,0);DMA_V(1,SLOTB);
  ROT();
  kload8(kf,kp0+sl_cur);
  WAIT_BAR(2);
  s16x4 vlo[8],vhi[8]; u32x4 pw0,pw1,pw2,pw3;
  #define PKW(P,B) cvtpk_s(P[B],P[B+1])
  #define PAF(k) __builtin_bit_cast(bf16x8,pw##k)
  #define VFR(i) (bf16x8){vlo[i][0],vlo[i][1],vlo[i][2],vlo[i][3],vhi[i][0],vhi[i][1],vhi[i][2],vhi[i][3]}
  #define PIN(x) asm volatile("":"+v"(x))
  #define MX3(a,b,c) __builtin_fmaxf(__builtin_fmaxf((a),(b)),(c))
  #define GAPA(MF,A0,A1,A2,A3,W0,W1,PW) do{ MF; sacc+=A0; sacc+=A1; sacc+=A2; sacc+=A3; PIN(sacc); W0; W1; PIN(PW); SBAR(); }while(0)
  #define EX(v) __builtin_amdgcn_exp2f(v)
  #define GAPB(MF,X,B) do{ MF; X[B]=EX(X[B]); X[B+1]=EX(X[B+1]); X[B+2]=EX(X[B+2]); X[B+3]=EX(X[B+3]); PIN(X); SBAR(); }while(0)
  #define VRD(i) do{ vlo[i]=vtr(vp_+(((i)>>2)*4096+((i)&3)*1024)); vhi[i]=vtr(vp_+(((i)>>2)*4096+((i)&3)*1024+512)); }while(0)
  #define KRD(G,j) do{ if(G){ kload2(kf,kp0+sl_next,j); SBAR(); } }while(0)
  #define STEP(C0,C1,P0,P1,t,GK,GV,GL) do{ SBAR(); \
    const lds_cptr vp_=vp0+sl_prev; \
    VRD(0); SBAR(); float sacc=(P0[0]+P0[1]); \
    GAPA(C0=__builtin_amdgcn_mfma_f32_32x32x16_bf16(kf[0],qr[0],negm,0,0,0), P0[2],P0[3],P0[4],P0[5],     pw0[0]=PKW(P0,0), pw0[1]=PKW(P0,2), pw0); \
    VRD(4); SBAR(); GAPA(C1=__builtin_amdgcn_mfma_f32_32x32x16_bf16(kf[1],qr[0],negm,0,0,0), P0[6],P0[7],P0[8],P0[9],     pw0[2]=PKW(P0,4), pw0[3]=PKW(P0,6), pw0); \
    VRD(1); SBAR(); GAPA(C0=__builtin_amdgcn_mfma_f32_32x32x16_bf16(kf[2],qr[1],C0,0,0,0),   P0[10],P0[11],P0[12],P0[13], pw1[0]=PKW(P0,8), pw1[1]=PKW(P0,10), pw1); \
    VRD(5); SBAR(); GAPA(C1=__builtin_amdgcn_mfma_f32_32x32x16_bf16(kf[3],qr[1],C1,0,0,0),   P0[14],P0[15],P1[0],P1[1],   pw1[2]=PKW(P0,12),pw1[3]=PKW(P0,14), pw1); \
    VRD(2); SBAR(); GAPA(C0=__builtin_amdgcn_mfma_f32_32x32x16_bf16(kf[4],qr[2],C0,0,0,0),   P1[2],P1[3],P1[4],P1[5],     pw2[0]=PKW(P1,0), pw2[1]=PKW(P1,2), pw2); \
    VRD(6); SBAR(); GAPA(C1=__builtin_amdgcn_mfma_f32_32x32x16_bf16(kf[5],qr[2],C1,0,0,0),   P1[6],P1[7],P1[8],P1[9],     pw2[2]=PKW(P1,4), pw2[3]=PKW(P1,6), pw2); \
    VRD(3); SBAR(); GAPA(C0=__builtin_amdgcn_mfma_f32_32x32x16_bf16(kf[6],qr[3],C0,0,0,0),   P1[10],P1[11],P1[12],P1[13], pw3[0]=PKW(P1,8), pw3[1]=PKW(P1,10), pw3); \
    VRD(7); SBAR(); GAPA(C1=__builtin_amdgcn_mfma_f32_32x32x16_bf16(kf[7],qr[3],C1,0,0,0),   P1[14],P1[15],0.f,0.f,       pw3[2]=PKW(P1,12),pw3[3]=PKW(P1,14), pw3); \
    l_reg+=sacc; \
    if(GK){DMA_K((t)+3,sl_cur);} if(GV){DMA_V((t)+1,sl_next);} \
    CMASK(C0,C1,t); \
    { float a=MX3(C0[0],C0[1],C1[0]),b=MX3(C0[2],C0[3],C1[1]); a=MX3(a,C1[2],C1[3]); \
      _Pragma("unroll") for(int r=4;r<16;r+=4){a=MX3(a,C0[r],C0[r+1]);b=MX3(b,C0[r+2],C0[r+3]);a=MX3(a,C1[r],C1[r+1]);b=MX3(b,C1[r+2],C1[r+3]);} \
      float rm=__builtin_fmaxf(a,b); { auto rr=__builtin_amdgcn_permlane32_swap(__float_as_uint(rm),__float_as_uint(rm),false,false); rm=__builtin_fmaxf(__uint_as_float(rr[0]),__uint_as_float(rr[1])); } \
      resc=false; \
      if(__builtin_expect(__any(rm>(float)THRL),0)){ const float dl=__builtin_fmaxf(rm,0.f); mhat+=dl; \
        _Pragma("unroll") for(int r=0;r<16;++r){C0[r]-=dl;C1[r]-=dl;} \
        _Pragma("unroll") for(int r=0;r<16;++r)negm[r]=-mhat; asm volatile("":"+v"(negm)); \
        const float f=__builtin_amdgcn_exp2f(-dl); l_reg*=f; if(hi==0)wsf[r32]=f; resc=true; } } \
    SBAR(); \
    GAPB(o[0]=__builtin_amdgcn_mfma_f32_32x32x16_bf16(PAF(0),VFR(0),o[0],0,0,0), C0,0); \
    GAPB(o[1]=__builtin_amdgcn_mfma_f32_32x32x16_bf16(PAF(0),VFR(4),o[1],0,0,0), C0,4); \
    KRD(GL,0); GAPB(o[0]=__builtin_amdgcn_mfma_f32_32x32x16_bf16(PAF(1),VFR(1),o[0],0,0,0), C0,8); \
    KRD(GL,1); GAPB(o[1]=__builtin_amdgcn_mfma_f32_32x32x16_bf16(PAF(1),VFR(5),o[1],0,0,0), C0,12); \
    KRD(GL,2); GAPB(o[0]=__builtin_amdgcn_mfma_f32_32x32x16_bf16(PAF(2),VFR(2),o[0],0,0,0), C1,0); \
    KRD(GL,3); GAPB(o[1]=__builtin_amdgcn_mfma_f32_32x32x16_bf16(PAF(2),VFR(6),o[1],0,0,0), C1,4); \
    GAPB(o[0]=__builtin_amdgcn_mfma_f32_32x32x16_bf16(PAF(3),VFR(3),o[0],0,0,0), C1,8); \
    GAPB(o[1]=__builtin_amdgcn_mfma_f32_32x32x16_bf16(PAF(3),VFR(7),o[1],0,0,0), C1,12); \
    }while(0)
  int t=1;
  #undef CMASK
  #define CMASK(P0,P1,t) do{}while(0)
  for(;t+5<NT;t+=2){
    STEP(pB0,pB1,pA0,pA1,t,true,true,true);     WAIT_BAR(2); RESC(); ROT();
    STEP(pA0,pA1,pB0,pB1,t+1,true,true,true);   WAIT_BAR(2); RESC(); ROT();
  }
  #undef CMASK
  #define CMASK(P0,P1,t) do{}while(0)
  #define ENDW(tt) do{ if((tt)+3<NT){WAIT_BAR(2);} else if((tt)+2<NT){WAIT_BAR(1);} else {WAIT_BAR(0);} }while(0)
  for(;t+1<NT;t+=2){
    STEP(pB0,pB1,pA0,pA1,t,(t+3<NT),(t+1<NT),(t+1<NT));       ENDW(t);   RESC(); ROT();
    STEP(pA0,pA1,pB0,pB1,t+1,(t+4<NT),(t+2<NT),(t+2<NT));     ENDW(t+1); RESC(); ROT();
  }
  STEP(pB0,pB1,pA0,pA1,NT-1,false,false,false); RESC();
  { float sacc=pB0[0]+pB0[1]; _Pragma("unroll") for(int r=2;r<16;++r)sacc+=pB0[r]; _Pragma("unroll") for(int r=0;r<16;++r)sacc+=pB1[r]; l_reg+=sacc;
    pw0=(u32x4){PKW(pB0,0),PKW(pB0,2),PKW(pB0,4),PKW(pB0,6)};pw1=(u32x4){PKW(pB0,8),PKW(pB0,10),PKW(pB0,12),PKW(pB0,14)};pw2=(u32x4){PKW(pB1,0),PKW(pB1,2),PKW(pB1,4),PKW(pB1,6)};pw3=(u32x4){PKW(pB1,8),PKW(pB1,10),PKW(pB1,12),PKW(pB1,14)};
    SBAR(); pv(o,vb0+sl_cur,PAF(0),PAF(1),PAF(2),PAF(3)); }
  #undef PKW
  #undef PAF
  #undef VFR
  #undef PIN
  #undef MX3
  #undef GAPA
  #undef GAPB
  #undef EX
  #undef VRD
  #undef KRD
  #undef STEP
  #undef ENDW
  {auto rr=__builtin_amdgcn_permlane32_swap(__float_as_uint(l_reg),__float_as_uint(l_reg),false,false);l_reg=__uint_as_float(rr[0])+__uint_as_float(rr[1]);}
  if(hi==0)wsf[32+r32]=l_reg;asm volatile("s_waitcnt lgkmcnt(0)":::"memory");
  float rli[16];
  #pragma unroll
  for(int r=0;r<16;++r)rli[r]=__builtin_amdgcn_rcpf(wsf[32+crow(r,hi)]);
  bf16*Ow=O+(rowbase+q0+wid*QBLK)*DMO+h*D;
  { bf16*stg=(bf16*)(shm+LDS_OST)+wid*2048;
    #pragma unroll
    for(int r=0;r<16;++r){const int orow=crow(r,hi);
      #pragma unroll
      for(int d0=0;d0<2;++d0)stg[orow*64+d0*32+r32]=__float2bfloat16(o[d0][r]*rli[r]);}
    asm volatile("s_waitcnt lgkmcnt(0)":::"memory");
    #pragma unroll
    for(int i=0;i<4;++i){const int row=i*8+(lane>>3),ch=lane&7; const u32x4 v=*(const u32x4*)(stg+row*64+ch*8); ATTN_STORE16(Ow+(long)row*DMO+ch*8,v);} }
  asm volatile("s_waitcnt lgkmcnt(0)\n\ts_barrier":::"memory");
  #undef DMA_K
  #undef DMA_V
  #undef CMASK
  #undef START
  #undef RESC
  #undef ROT
}
constexpr int ATTN_LDS_BYTES=LDS_BYTES;
struct AttnTensors { const bf16* Q; const bf16* K; const bf16* V; bf16* O; };
struct AttnUnit { int bh; int qb; };
struct StaticOrder {
  int vcu, G;
  __device__ __forceinline__ explicit StaticOrder(int grid,int block):vcu((grid%8==0)?(block%8)*(grid/8)+block/8:block),G(grid){}
  __device__ __forceinline__ bool next(int i,AttnUnit&u)const{ const int L=i*G+vcu; if(L>=BATCH*NHEAD*NQB)return false; u.bh=L/NQB; u.qb=L%NQB; return true; }
  __device__ __forceinline__ void a_ready(const AttnUnit&)const{}
  __device__ __forceinline__ void done(const AttnUnit&)const{}
};
template<class Sched,int THRL=8> __device__ __forceinline__ void attn_phase(char*lds,const AttnTensors&T,const Sched&S){
  AttnUnit u;
  for(int i=0;S.next(i,u);++i){ S.a_ready(u); attn_unit<THRL>(u.bh/NHEAD,u.bh%NHEAD,u.qb,T.Q,T.K,T.V,T.O,lds); S.done(u); }
}
#undef SBAR
#undef WAIT_BAR
}
#define LAS __attribute__((address_space(3)))
typedef unsigned short bf16r;
typedef unsigned v4u __attribute__((ext_vector_type(4)));
typedef float f32x4 __attribute__((ext_vector_type(4)));
constexpr int M = 16384, DMODEL = 1024, FF = 2816, NPROJ = 3072, NWIN = 3584, SEQ = 4096, NWAVES = 8;
constexpr int LDS_BYTES = 147456;
constexpr int STOP_L = 99, STOP_P = 99;
constexpr size_t MiB = 1u << 20;
constexpr size_t WS_TAB = 0;
constexpr size_t WS_SS = 53 * MiB;
constexpr size_t WS_W = 1 * MiB;
constexpr size_t W_GU1 = WS_W, W_D1 = W_GU1 + (size_t)5632 * 1024 * 2, W_GU2 = W_D1 + (size_t)1024 * 2816 * 2, W_D2 = W_GU2 + (size_t)5632 * 1024 * 2,
                 W_IN = W_D2 + (size_t)1024 * 2816 * 2, W_MG = W_IN + (size_t)NWIN * 1024 * 2, W_GLU = W_MG + (size_t)3072 * 1024 * 2, W_BR = W_GLU + (size_t)512 * 512 * 2,
                 W_OUT = W_BR + (size_t)3 * 1024 * 512 * 2, W_END = W_OUT + (size_t)1024 * 1024 * 2;
constexpr size_t WS_XB = 56 * MiB, WS_BIG = 88 * MiB  , WS_UG = 184 * MiB  , WS_W1T = 208 * MiB  ,
                 WS_BTY = 216 * MiB  , WS_E = 240 * MiB  , WS_KT = 256 * MiB  ,
                 WS_ACC = 200 * MiB, WS_MG16 = 216 * MiB  , WS_YS5 = WS_UG, WS_GEB = 232 * MiB, WS_YGLA = 248 * MiB, WS_END = 264 * MiB;
static_assert(W_END <= WS_SS && WS_SS + 3 * (size_t)M * 64 <= WS_XB, "weights fit");
constexpr int PC_GQ = 0, PC_GK = 512, PC_GV = 1024, PC_GG = 1536, PC_AQ = 2048, PC_AK = 2560, PC_AV = 2688, PC_Z = 2816;

struct Args { const float* in[32]; float* out; unsigned char* ws; };

__device__ __forceinline__ unsigned f2bf(float f) { unsigned u = __builtin_bit_cast(unsigned, f); return (u + 0x7fffu + ((u >> 16) & 1u)) >> 16; }
__device__ __forceinline__ unsigned pk2(float lo, float hi) { return f2bf(lo) | (f2bf(hi) << 16); }
__device__ __forceinline__ float bf2f(bf16r v) { return __builtin_bit_cast(float, (unsigned)v << 16); }
__device__ __forceinline__ float wave_sum(float v) {
#pragma unroll
    for (int o = 1; o < 64; o <<= 1) v += __shfl_xor(v, o);
    return v;
}
#define LDS_WAIT() asm volatile("s_waitcnt lgkmcnt(0)" ::: "memory")

template <class P, class Gn> __device__ __forceinline__ void conv_item(P src, Gn gain, int K, int Nd, bf16r* WT, LAS float* scr, int item, int lane) {
    const int nblk = Nd / 32, kb = item / nblk, nb = item % nblk, k0 = 64 * kb, n0 = 32 * nb;
    const int nq = lane & 7, kr = lane >> 3;
    f32x4 v[8];
#pragma unroll
    for (int i = 0; i < 8; ++i) { const float* s = src(k0 + 8 * i + kr, n0 + 4 * nq); v[i] = s ? *(const f32x4*)s : (f32x4){0.f, 0.f, 0.f, 0.f}; }
#pragma unroll
    for (int i = 0; i < 8; ++i) { const int kk = 8 * i + kr; const float gk = gain(k0 + kk); LAS float* d = scr + kk * 33 + 4 * nq; d[0] = v[i][0] * gk; d[1] = v[i][1] * gk; d[2] = v[i][2] * gk; d[3] = v[i][3] * gk; }
    LDS_WAIT(); asm volatile("" ::: "memory");
    const int c = lane & 7;
#pragma unroll
    for (int j = 0; j < 4; ++j) { const int n = (lane >> 3) + 8 * j; const LAS float* s = scr + (8 * c) * 33 + n;
        v4u o; o.x = pk2(s[0 * 33], s[1 * 33]); o.y = pk2(s[2 * 33], s[3 * 33]); o.z = pk2(s[4 * 33], s[5 * 33]); o.w = pk2(s[6 * 33], s[7 * 33]);
        *(v4u*)(WT + (size_t)(n0 + n) * K + k0 + 8 * c) = o; }
    LDS_WAIT(); asm volatile("" ::: "memory");
}
template <class P, class Gn> __device__ __forceinline__ void conv_all(P src, Gn gain, int K, int Nd, bf16r* WT, LAS float* scr, int gw, int NGW, int lane) {
    const int items = (K / 64) * (Nd / 32);
    for (int it = gw; it < items; it += NGW) conv_item(src, gain, K, Nd, WT, scr, it, lane);
}

__device__ __forceinline__ float gelu_tanh(float x) { const float z = 0.7978845608028654f * (x + 0.044715f * x * x * x); const float t = 1.0f - 2.0f * __builtin_amdgcn_rcpf(__expf(2.0f * z) + 1.0f); return 0.5f * x * (1.0f + t); }
__device__ __forceinline__ float silu_(float x) { return x * __builtin_amdgcn_rcpf(1.0f + __expf(-x)); }


constexpr size_t WS_S5X = 264 * MiB;
constexpr size_t WS_GDT = 266 * MiB;
constexpr size_t WS_GE = WS_GEB;
constexpr size_t WS_NEED = 267 * MiB;
typedef float f32x2v __attribute__((ext_vector_type(2)));
template <bool OUT> __device__ __forceinline__ void gla_unit(const float* const* TAB, int l, int unit, int tid, const bf16r* PROJ, float* ACC, bf16r* OB, float* GE, float* GDT, LAS unsigned char* ldsl) {
    const int c = unit & 7, h = (unit >> 3) & 3, b = (unit >> 5) & 3, dir = unit >> 7;
    LAS float* sa = (LAS float*)ldsl; LAS float* sq = sa + 1024; LAS float* sk = sq + 1024; LAS float* sv = sk + 1024; LAS float* sop = sv + 1024;
    const int dks = tid & 127;
    const int dvg = tid & 31, dkg = tid >> 5;
    f32x2v S2[8][2];
#pragma unroll
    for (int j = 0; j < 8; ++j) { S2[j][0] = (f32x2v){0.f, 0.f}; S2[j][1] = (f32x2v){0.f, 0.f}; }
    if (OUT) {
        for (int cc = 0; cc < 8; ++cc) { const int c2 = dir ? 7 - cc : cc; if (c2 == c) break; const size_t u2 = (size_t)(unit - c + c2);
            const f32x4 d0 = *(const f32x4*)(GDT + u2 * 128 + dkg * 8), d1 = *(const f32x4*)(GDT + u2 * 128 + dkg * 8 + 4);
#pragma unroll
            for (int j = 0; j < 8; ++j) { const f32x4 g4 = *(const f32x4*)(GE + (u2 * 128 + dkg * 8 + j) * 128 + 4 * dvg); const float dd = j < 4 ? d0[j & 3] : d1[j & 3];
                S2[j][0] = dd * S2[j][0] + (f32x2v){g4[0], g4[1]}; S2[j][1] = dd * S2[j][1] + (f32x2v){g4[2], g4[3]}; } }
    }
    const float* wal = TAB[16] + ((size_t)(l * 2 + dir) * 16) * 512 + h * 128 + dks; const float bal = TAB[17][(l * 2 + dir) * 512 + h * 128 + dks];
    float wr_[16];
#pragma unroll
    for (int r = 0; r < 16; ++r) wr_[r] = wal[r * 512];
    const int zcol = PC_Z + dir * 16;
    float lsum = 0.f;
    v4u rz0[2], rz1[2]; bf16r rq[2], rk[2], rvv[2];
#define GLA_LOAD(BLK) do { _Pragma("unroll") for (int i = 0; i < 2; ++i) { const int idx = tid + 512 * i, s = idx >> 7, dk = idx & 127; const int step = (BLK) * 8 + s, t = dir ? (c * 512 + 511 - step) : (c * 512 + step); \
        const bf16r* pr = PROJ + ((size_t)b * SEQ + t) * NPROJ; rz0[i] = *(const v4u*)(pr + zcol); rz1[i] = *(const v4u*)(pr + zcol + 8); \
        rq[i] = OUT ? pr[PC_GQ + h * 128 + dk] : (bf16r)0; rk[i] = pr[PC_GK + h * 128 + dk]; rvv[i] = pr[PC_GV + h * 128 + dk]; } } while (0)
    GLA_LOAD(0);
    for (int blk = 0; blk <= 64; ++blk) {
        if (blk < 64) {
#pragma unroll
            for (int i = 0; i < 2; ++i) { const int idx = tid + 512 * i;
                const v4u z0 = rz0[i], z1 = rz1[i];
                float lg = bal;
                lg += pg8::bflo(z0.x) * wr_[0] + pg8::bfhi(z0.x) * wr_[1] + pg8::bflo(z0.y) * wr_[2] + pg8::bfhi(z0.y) * wr_[3] + pg8::bflo(z0.z) * wr_[4] + pg8::bfhi(z0.z) * wr_[5] + pg8::bflo(z0.w) * wr_[6] + pg8::bfhi(z0.w) * wr_[7];
                lg += pg8::bflo(z1.x) * wr_[8] + pg8::bfhi(z1.x) * wr_[9] + pg8::bflo(z1.y) * wr_[10] + pg8::bfhi(z1.y) * wr_[11] + pg8::bflo(z1.z) * wr_[12] + pg8::bfhi(z1.z) * wr_[13] + pg8::bflo(z1.w) * wr_[14] + pg8::bfhi(z1.w) * wr_[15];
                const float ls = (fminf(lg, 0.f) - log1pf(expf(-fabsf(lg)))) * (1.0f / 16.0f);
                lsum += ls;
                sa[idx] = expf(ls); if (OUT) sq[idx] = bf2f(rq[i]) * 0.08838834764831845f; sk[idx] = bf2f(rk[i]); sv[idx] = bf2f(rvv[i]); }
            if (blk + 1 < 64) GLA_LOAD(blk + 1);
        }
        if (OUT && blk > 0) {
#pragma unroll
            for (int i = 0; i < 2; ++i) { const int idx = tid + 512 * i, s = idx >> 7, dvv = idx & 127; const int step = (blk - 1) * 8 + s, t = dir ? (c * 512 + 511 - step) : (c * 512 + step);
                float val = 0.f;
#pragma unroll
                for (int gq = 0; gq < 16; ++gq) val += sop[gq * 1024 + idx];
                const size_t oi = ((size_t)b * SEQ + t) * 512 + h * 128 + dvv; if (dir) OB[oi] = (bf16r)f2bf(val); else ACC[oi] = val; }
        }
        __syncthreads();
        if (blk < 64) {
            for (int s = 0; s < 8; ++s) {
                const f32x4 v4 = *(const LAS f32x4*)(sv + s * 128 + 4 * dvg); const f32x2v v01 = (f32x2v){v4[0], v4[1]}, v23 = (f32x2v){v4[2], v4[3]};
                const LAS f32x4* pa = (const LAS f32x4*)(sa + s * 128 + dkg * 8); const LAS f32x4* pq = (const LAS f32x4*)(sq + s * 128 + dkg * 8); const LAS f32x4* pk = (const LAS f32x4*)(sk + s * 128 + dkg * 8);
                f32x2v o01 = (f32x2v){0.f, 0.f}, o23 = (f32x2v){0.f, 0.f};
#pragma unroll
                for (int jj = 0; jj < 2; ++jj) { const f32x4 a4 = pa[jj], k4 = pk[jj]; f32x4 q4 = (f32x4){0.f, 0.f, 0.f, 0.f}; if (OUT) q4 = pq[jj];
#pragma unroll
                    for (int e = 0; e < 4; ++e) { const int j = jj * 4 + e;
                        S2[j][0] = a4[e] * S2[j][0] + k4[e] * v01; S2[j][1] = a4[e] * S2[j][1] + k4[e] * v23;
                        if (OUT) { o01 = o01 + q4[e] * S2[j][0]; o23 = o23 + q4[e] * S2[j][1]; } } }
                if (OUT) *(LAS f32x4*)(sop + (dkg * 8 + s) * 128 + 4 * dvg) = (f32x4){o01.x, o01.y, o23.x, o23.y}; }
        }
        __syncthreads();
    }
    if (!OUT) {
#pragma unroll
        for (int j = 0; j < 8; ++j) *(f32x4*)(GE + ((size_t)unit * 128 + dkg * 8 + j) * 128 + 4 * dvg) = (f32x4){S2[j][0].x, S2[j][0].y, S2[j][1].x, S2[j][1].y};
        sop[tid] = lsum; __syncthreads();
#undef GLA_LOAD
        if (tid < 128) GDT[(size_t)unit * 128 + tid] = expf((sop[tid] + sop[128 + tid]) + (sop[256 + tid] + sop[384 + tid]));
        __syncthreads();
    }
}

typedef short gbf16x8 __attribute__((ext_vector_type(8)));
__device__ __forceinline__ void gla_passA_mfma(const float* const* TAB, int l, int unit, int tid, const bf16r* PROJ, float* GE, float* GDT, LAS unsigned char* ldsl) {
    const int c = unit & 7, h = (unit >> 3) & 3, b = (unit >> 5) & 3, dir = unit >> 7;
    LAS float* LB = (LAS float*)ldsl;
    LAS bf16r* KET = (LAS bf16r*)(ldsl + 32768);
    LAS bf16r* VT = (LAS bf16r*)(ldsl + 32768 + 18432);
    LAS float* DD = (LAS float*)(ldsl + 32768 + 2 * 18432);
    LAS float* TT = (LAS float*)(ldsl + 126976);
    const int lane = tid & 63, w = tid >> 6, fr = lane & 15, fq = lane >> 4;
    const int col = tid & 127, rq = tid >> 7;
    const float* wal = TAB[16] + ((size_t)(l * 2 + dir) * 16) * 512 + h * 128 + col; const float bal = TAB[17][(l * 2 + dir) * 512 + h * 128 + col];
    float wr_[16];
#pragma unroll
    for (int r = 0; r < 16; ++r) wr_[r] = wal[r * 512];
    const int zcol = PC_Z + dir * 16;
    f32x4 S[8];
#pragma unroll
    for (int mt = 0; mt < 8; ++mt) S[mt] = (f32x4){0.f, 0.f, 0.f, 0.f};
    float ltot = 0.f;
    for (int sc = 0; sc < 8; ++sc) {
        bf16r rk[16], rv[16];
#pragma unroll
        for (int r = 0; r < 16; ++r) { const int step = sc * 64 + rq * 16 + r, t = dir ? (c * 512 + 511 - step) : (c * 512 + step); const bf16r* pr = PROJ + ((size_t)b * SEQ + t) * NPROJ;
            rk[r] = pr[PC_GK + h * 128 + col]; rv[r] = pr[PC_GV + h * 128 + col]; }
        float lav[16];
#pragma unroll
        for (int half = 0; half < 4; ++half) {
            v4u z0[4], z1[4];
#pragma unroll
            for (int r = 0; r < 4; ++r) { const int step = sc * 64 + rq * 16 + half * 4 + r, t = dir ? (c * 512 + 511 - step) : (c * 512 + step); const bf16r* pr = PROJ + ((size_t)b * SEQ + t) * NPROJ;
                z0[r] = *(const v4u*)(pr + zcol); z1[r] = *(const v4u*)(pr + zcol + 8); }
#pragma unroll
            for (int r = 0; r < 4; ++r) { float lg = bal;
                lg += pg8::bflo(z0[r].x) * wr_[0] + pg8::bfhi(z0[r].x) * wr_[1] + pg8::bflo(z0[r].y) * wr_[2] + pg8::bfhi(z0[r].y) * wr_[3] + pg8::bflo(z0[r].z) * wr_[4] + pg8::bfhi(z0[r].z) * wr_[5] + pg8::bflo(z0[r].w) * wr_[6] + pg8::bfhi(z0[r].w) * wr_[7];
                lg += pg8::bflo(z1[r].x) * wr_[8] + pg8::bfhi(z1[r].x) * wr_[9] + pg8::bflo(z1[r].y) * wr_[10] + pg8::bfhi(z1[r].y) * wr_[11] + pg8::bflo(z1[r].z) * wr_[12] + pg8::bfhi(z1[r].z) * wr_[13] + pg8::bflo(z1[r].w) * wr_[14] + pg8::bfhi(z1[r].w) * wr_[15];
                lav[half * 4 + r] = (fminf(lg, 0.f) - __logf(1.0f + __expf(-fabsf(lg)))) * (1.0f / 16.0f); }
        }
#pragma unroll
        for (int r = 1; r < 16; ++r) lav[r] += lav[r - 1];
        TT[rq * 128 + col] = lav[15];
        __syncthreads();
        float off = 0.f, bl = 0.f;
#pragma unroll
        for (int q = 0; q < 4; ++q) { const float tq = TT[q * 128 + col]; bl += tq; off += (q < rq) ? tq : 0.f; }
        if (rq == 0) { DD[col] = __expf(bl); ltot += bl; }
        { unsigned kw[8], vw[8];
#pragma unroll
          for (int r = 0; r < 8; ++r) { kw[r] = pk2(bf2f(rk[2 * r]) * __expf(bl - (lav[2 * r] + off)), bf2f(rk[2 * r + 1]) * __expf(bl - (lav[2 * r + 1] + off))); vw[r] = (unsigned)rv[2 * r] | ((unsigned)rv[2 * r + 1] << 16); }
          LAS v4u* kd = (LAS v4u*)(KET + col * 72 + rq * 16); kd[0] = (v4u){kw[0], kw[1], kw[2], kw[3]}; kd[1] = (v4u){kw[4], kw[5], kw[6], kw[7]};
          LAS v4u* vd = (LAS v4u*)(VT + col * 72 + rq * 16); vd[0] = (v4u){vw[0], vw[1], vw[2], vw[3]}; vd[1] = (v4u){vw[4], vw[5], vw[6], vw[7]}; }
        __syncthreads();
        { gbf16x8 bfr[2];
#pragma unroll
          for (int ks = 0; ks < 2; ++ks) bfr[ks] = *(const LAS gbf16x8*)(VT + (16 * w + fr) * 72 + 32 * ks + 8 * fq);
#pragma unroll
          for (int mt = 0; mt < 8; ++mt) { const f32x4 d4 = *(const LAS f32x4*)(DD + 16 * mt + 4 * fq); f32x4 acc = S[mt] * d4;
#pragma unroll
              for (int ks = 0; ks < 2; ++ks) { const gbf16x8 afr = *(const LAS gbf16x8*)(KET + (16 * mt + fr) * 72 + 32 * ks + 8 * fq); acc = __builtin_amdgcn_mfma_f32_16x16x32_bf16(afr, bfr[ks], acc, 0, 0, 0); }
              S[mt] = acc; } }
        __syncthreads();
    }
#pragma unroll
    for (int mt = 0; mt < 8; ++mt)
#pragma unroll
        for (int jj = 0; jj < 4; ++jj) GE[((size_t)unit * 128 + 16 * mt + 4 * fq + jj) * 128 + 16 * w + fr] = S[mt][jj];
    if (tid < 128) GDT[(size_t)unit * 128 + tid] = expf(ltot);
}

__device__ __forceinline__ void gla_passB_mfma(const float* const* TAB, int l, int unit, int tid, const bf16r* PROJ, float* ACC, bf16r* OB, const float* GE, const float* GDT, LAS unsigned char* ldsl) {
    const int c = unit & 7, h = (unit >> 3) & 3, b = (unit >> 5) & 3, dir = unit >> 7;
    LAS float* LB = (LAS float*)ldsl;
    LAS bf16r* KET = (LAS bf16r*)(ldsl + 34816);
    LAS bf16r* VT = (LAS bf16r*)(ldsl + 53248);
    LAS float* DD = (LAS float*)(ldsl + 71680);
    LAS bf16r* QD = (LAS bf16r*)(ldsl + 72192);
    LAS bf16r* KD = (LAS bf16r*)(ldsl + 89600);
    LAS bf16r* PP = (LAS bf16r*)(ldsl + 107008);
    LAS float* TT = (LAS float*)(ldsl + 126976);
    const int lane = tid & 63, w = tid >> 6, fr = lane & 15, fq = lane >> 4;
    LAS bf16r* STw = (LAS bf16r*)ldsl + w * (16 * 136);
    const int col = tid & 127, rq = tid >> 7;
    const float* wal = TAB[16] + ((size_t)(l * 2 + dir) * 16) * 512 + h * 128 + col; const float bal = TAB[17][(l * 2 + dir) * 512 + h * 128 + col];
    float wr_[16];
#pragma unroll
    for (int r = 0; r < 16; ++r) wr_[r] = wal[r * 512];
    const int zcol = PC_Z + dir * 16;
    f32x4 S[8];
#pragma unroll
    for (int mt = 0; mt < 8; ++mt) S[mt] = (f32x4){0.f, 0.f, 0.f, 0.f};
    for (int cc = 0; cc < 8; ++cc) { const int c2 = dir ? 7 - cc : cc; if (c2 == c) break; const size_t u2 = (size_t)(unit - c + c2);
#pragma unroll
        for (int mt = 0; mt < 8; ++mt) { const f32x4 d4 = *(const f32x4*)(GDT + u2 * 128 + 16 * mt + 4 * fq);
#pragma unroll
            for (int jj = 0; jj < 4; ++jj) S[mt][jj] = d4[jj] * S[mt][jj] + GE[(u2 * 128 + 16 * mt + 4 * fq + jj) * 128 + 16 * w + fr]; } }
    for (int sc = 0; sc < 8; ++sc) {
        bf16r rqv[16], rk[16], rv[16];
#pragma unroll
        for (int r = 0; r < 16; ++r) { const int step = sc * 64 + rq * 16 + r, t = dir ? (c * 512 + 511 - step) : (c * 512 + step); const bf16r* pr = PROJ + ((size_t)b * SEQ + t) * NPROJ;
            rqv[r] = pr[PC_GQ + h * 128 + col]; rk[r] = pr[PC_GK + h * 128 + col]; rv[r] = pr[PC_GV + h * 128 + col]; }
        float lav[16];
#pragma unroll
        for (int half = 0; half < 4; ++half) {
            v4u z0[4], z1[4];
#pragma unroll
            for (int r = 0; r < 4; ++r) { const int step = sc * 64 + rq * 16 + half * 4 + r, t = dir ? (c * 512 + 511 - step) : (c * 512 + step); const bf16r* pr = PROJ + ((size_t)b * SEQ + t) * NPROJ;
                z0[r] = *(const v4u*)(pr + zcol); z1[r] = *(const v4u*)(pr + zcol + 8); }
#pragma unroll
            for (int r = 0; r < 4; ++r) { float lg = bal;
                lg += pg8::bflo(z0[r].x) * wr_[0] + pg8::bfhi(z0[r].x) * wr_[1] + pg8::bflo(z0[r].y) * wr_[2] + pg8::bfhi(z0[r].y) * wr_[3] + pg8::bflo(z0[r].z) * wr_[4] + pg8::bfhi(z0[r].z) * wr_[5] + pg8::bflo(z0[r].w) * wr_[6] + pg8::bfhi(z0[r].w) * wr_[7];
                lg += pg8::bflo(z1[r].x) * wr_[8] + pg8::bfhi(z1[r].x) * wr_[9] + pg8::bflo(z1[r].y) * wr_[10] + pg8::bfhi(z1[r].y) * wr_[11] + pg8::bflo(z1[r].z) * wr_[12] + pg8::bfhi(z1[r].z) * wr_[13] + pg8::bflo(z1[r].w) * wr_[14] + pg8::bfhi(z1[r].w) * wr_[15];
                lav[half * 4 + r] = (fminf(lg, 0.f) - __logf(1.0f + __expf(-fabsf(lg)))) * (1.0f / 16.0f); }
        }
#pragma unroll
        for (int r = 1; r < 16; ++r) lav[r] += lav[r - 1];
        TT[rq * 128 + col] = lav[15];
        __syncthreads();
        { float off = 0.f, bl = 0.f;
#pragma unroll
          for (int q = 0; q < 4; ++q) { const float tq = TT[q * 128 + col]; bl += tq; off += (q < rq) ? tq : 0.f; }
          if (rq == 0) DD[col] = __expf(bl);
          unsigned kw[8], vw[8];
#pragma unroll
          for (int r = 0; r < 16; ++r) { const int j = rq * 16 + r; const float bj = lav[r] + off, kf = bf2f(rk[r]);
              QD[j * 136 + col] = (bf16r)f2bf(bf2f(rqv[r]) * 0.08838834764831845f * __expf(bj)); KD[j * 136 + col] = (bf16r)f2bf(kf * __expf(-bj));
              const unsigned ke = f2bf(kf * __expf(bl - bj));
              if (r & 1) { kw[r >> 1] |= ke << 16; vw[r >> 1] |= (unsigned)rv[r] << 16; } else { kw[r >> 1] = ke; vw[r >> 1] = (unsigned)rv[r]; } }
          LAS v4u* kd = (LAS v4u*)(KET + col * 72 + rq * 16); kd[0] = (v4u){kw[0], kw[1], kw[2], kw[3]}; kd[1] = (v4u){kw[4], kw[5], kw[6], kw[7]};
          LAS v4u* vd = (LAS v4u*)(VT + col * 72 + rq * 16); vd[0] = (v4u){vw[0], vw[1], vw[2], vw[3]}; vd[1] = (v4u){vw[4], vw[5], vw[6], vw[7]}; }
        __syncthreads();
#pragma unroll
        for (int mt = 0; mt < 8; ++mt) { unsigned long long pk = (unsigned long long)pk2(S[mt][0], S[mt][1]) | ((unsigned long long)pk2(S[mt][2], S[mt][3]) << 32);
            *(LAS unsigned long long*)(STw + fr * 136 + 16 * mt + 4 * fq) = pk; }
#pragma unroll
        for (int tt = 0; tt < 2; ++tt) { const int tile = 2 * w + tt, mi = tile >> 2, nj = tile & 3; f32x4 acc = (f32x4){0.f, 0.f, 0.f, 0.f};
            if (nj <= mi) {
#pragma unroll
                for (int ks = 0; ks < 4; ++ks) { const gbf16x8 afr = *(const LAS gbf16x8*)(QD + (16 * mi + fr) * 136 + 32 * ks + 8 * fq); const gbf16x8 bfr = *(const LAS gbf16x8*)(KD + (16 * nj + fr) * 136 + 32 * ks + 8 * fq);
                    acc = __builtin_amdgcn_mfma_f32_16x16x32_bf16(afr, bfr, acc, 0, 0, 0); } }
#pragma unroll
            for (int jj = 0; jj < 4; ++jj) { const int i = 16 * mi + 4 * fq + jj, j = 16 * nj + fr; PP[i * 72 + j] = (bf16r)f2bf(j <= i ? acc[jj] : 0.f); } }
        __syncthreads();
        { gbf16x8 vb[2], sb[4];
#pragma unroll
          for (int ks = 0; ks < 2; ++ks) vb[ks] = *(const LAS gbf16x8*)(VT + (16 * w + fr) * 72 + 32 * ks + 8 * fq);
#pragma unroll
          for (int ks = 0; ks < 4; ++ks) sb[ks] = *(const LAS gbf16x8*)(STw + fr * 136 + 32 * ks + 8 * fq);
#pragma unroll
          for (int mi = 0; mi < 4; ++mi) { f32x4 acc = (f32x4){0.f, 0.f, 0.f, 0.f};
#pragma unroll
              for (int ks = 0; ks < 2; ++ks) { const gbf16x8 afr = *(const LAS gbf16x8*)(PP + (16 * mi + fr) * 72 + 32 * ks + 8 * fq); acc = __builtin_amdgcn_mfma_f32_16x16x32_bf16(afr, vb[ks], acc, 0, 0, 0); }
#pragma unroll
              for (int ks = 0; ks < 4; ++ks) { const gbf16x8 afr = *(const LAS gbf16x8*)(QD + (16 * mi + fr) * 136 + 32 * ks + 8 * fq); acc = __builtin_amdgcn_mfma_f32_16x16x32_bf16(afr, sb[ks], acc, 0, 0, 0); }
#pragma unroll
              for (int jj = 0; jj < 4; ++jj) { const int step = sc * 64 + 16 * mi + 4 * fq + jj, t = dir ? (c * 512 + 511 - step) : (c * 512 + step);
                  const size_t oi = ((size_t)b * SEQ + t) * 512 + h * 128 + 16 * w + fr; if (dir) OB[oi] = (bf16r)f2bf(acc[jj]); else ((bf16r*)ACC)[oi] = (bf16r)f2bf(acc[jj]); } }
#pragma unroll
          for (int mt = 0; mt < 8; ++mt) { const f32x4 d4 = *(const LAS f32x4*)(DD + 16 * mt + 4 * fq); f32x4 acc = S[mt] * d4;
#pragma unroll
              for (int ks = 0; ks < 2; ++ks) { const gbf16x8 afr = *(const LAS gbf16x8*)(KET + (16 * mt + fr) * 72 + 32 * ks + 8 * fq); acc = __builtin_amdgcn_mfma_f32_16x16x32_bf16(afr, vb[ks], acc, 0, 0, 0); }
              S[mt] = acc; } }
        __syncthreads();
    }
}

constexpr size_t WS_BAR = 4096;
constexpr size_t WS_ROPE = 32768;
constexpr int MISC_OFF = 131072 + 320;
typedef __attribute__((address_space(1))) unsigned gu32;
#define RLX_AGENT __ATOMIC_RELAXED, __HIP_MEMORY_SCOPE_AGENT
#define XB_TMO      128
#define XB_XCNT(j)  (256  + 64 * (j))
#define XB_XSUB(j)  (1280 + 64 * (j))
#define XB_XGEN(j)  (2304 + 64 * (j))
#define XB_TOP      3328
#define XB_TOPGEN   3392
#define XCD_BAR_WORDS 3456
#define XB_SPIN_CAP (1u << 18)

__device__ __forceinline__ unsigned xb_ld(unsigned* p)              { return __hip_atomic_load(p, __ATOMIC_RELAXED, __HIP_MEMORY_SCOPE_AGENT); }
__device__ __forceinline__ unsigned xb_add(unsigned* p, unsigned v) { return __hip_atomic_fetch_add(p, v, __ATOMIC_RELAXED, __HIP_MEMORY_SCOPE_AGENT); }
__device__ __forceinline__ unsigned xb_xcc_id() { return (unsigned)__builtin_amdgcn_s_getreg((3 << 11) | 20) & 0xFu; }
#define XB_SPIN(cond, bar) do { unsigned _sp = 0; while (cond) { __builtin_amdgcn_s_sleep(1); \
    if ((++_sp & 255u) == 0u) { if (xb_ld(&(bar)[XB_TMO])) break; if (_sp > XB_SPIN_CAP) { atomicAdd(&(bar)[XB_TMO], 1u); break; } } } } while (0)

struct XcdBarrier {
    unsigned* bar; unsigned x;
    volatile LAS unsigned* st;
};

__device__ __forceinline__ XcdBarrier xcd_barrier_post(unsigned* bar, volatile LAS unsigned* st) {
    XcdBarrier b; b.bar = bar; b.x = xb_xcc_id(); b.st = st;
    if (threadIdx.x == 0) (void)xb_add(&bar[XB_XCNT(b.x)], 1u);
    return b;
}
__device__ __forceinline__ void xcd_barrier_complete(unsigned* bar, unsigned x, unsigned& nloc, unsigned& nx) {
    const unsigned G = gridDim.x * gridDim.y * gridDim.z;
    unsigned sum, cnt, mine, sp = 0u;
    for (;;) {
        sum = 0u; cnt = 0u; mine = 0u;
#pragma unroll
        for (unsigned j = 0; j < 16; ++j) { const unsigned c = xb_ld(&bar[XB_XCNT(j)]); sum += c; cnt += (c > 0u) ? 1u : 0u; mine = (j == x) ? c : mine; }
        if (sum == G) break;
        __builtin_amdgcn_s_sleep(1);
        if ((++sp & 255u) == 0u) { if (xb_ld(&bar[XB_TMO])) break; if (sp > XB_SPIN_CAP) { atomicAdd(&bar[XB_TMO], 1u); break; } }
    }
    nloc = mine > 0u ? mine : 1u; nx = cnt > 0u ? cnt : 1u;
}

__device__ __forceinline__ void xcd_barrier(const XcdBarrier& b) {
    asm volatile("s_waitcnt vmcnt(0)" ::: "memory");
    __syncthreads();
    if (threadIdx.x == 0) {
        unsigned* bar = b.bar;
        __builtin_amdgcn_s_waitcnt(0);
        unsigned nloc = b.st[0], nx = b.st[1];
        if (nloc == 0u) { xcd_barrier_complete(bar, b.x, nloc, nx); b.st[0] = nloc; b.st[1] = nx; }
        const unsigned old = xb_add(&bar[XB_XSUB(b.x)], 1u);
        const unsigned gen = old / nloc;
        if (old + 1u == (gen + 1u) * nloc) {
            __builtin_amdgcn_fence(__ATOMIC_RELEASE, "agent");
            asm volatile("s_waitcnt vmcnt(0)" ::: "memory");
            const unsigned og = xb_add(&bar[XB_TOP], 1u);
            const unsigned tg = og / nx;
            if (og + 1u == (tg + 1u) * nx) xb_add(&bar[XB_TOPGEN], 1u);
            else XB_SPIN(xb_ld(&bar[XB_TOPGEN]) == tg, bar);
            __builtin_amdgcn_fence(__ATOMIC_ACQUIRE, "agent");
            xb_add(&bar[XB_XGEN(b.x)], 1u);
            asm volatile("s_waitcnt vmcnt(0)" ::: "memory");
        } else {
            XB_SPIN(xb_ld(&bar[XB_XGEN(b.x)]) == gen, bar);
            __builtin_amdgcn_fence(__ATOMIC_ACQUIRE, "agent");
            asm volatile("s_waitcnt vmcnt(0)" ::: "memory");
        }
    }
    __syncthreads();
}

__global__ void __launch_bounds__(NWAVES * 64, 2) fwd_kernel(Args args) {
    extern __shared__ __attribute__((aligned(16))) unsigned char lds[];
    cg::grid_group grid = cg::this_grid();
    unsigned seam = 0; int fin_buf = 0;
    grid.sync();
    for (int u = threadIdx.x; u < (LDS_BYTES - 131072) / 4; u += NWAVES * 64) ((LAS unsigned*)((LAS unsigned char*)lds + 131072))[u] = 0u;
    __syncthreads();
    (void)xcd_barrier_post((unsigned*)(args.ws + WS_BAR), (volatile LAS unsigned*)((LAS unsigned char*)lds + MISC_OFF) + 8);
#define GSYNC() do { XcdBarrier xb_; xb_.bar = (unsigned*)(args.ws + WS_BAR); xb_.x = xb_xcc_id(); xb_.st = (volatile LAS unsigned*)((LAS unsigned char*)lds + MISC_OFF) + 8; xcd_barrier(xb_); } while (0)
#define PH \
    __attribute__((address_space(1))) unsigned char* ws_g = (__attribute__((address_space(1))) unsigned char*)args.ws; asm volatile("" : "+s"(ws_g)); unsigned char* ws = (unsigned char*)ws_g; \
    __attribute__((address_space(1))) float* X_g = (__attribute__((address_space(1))) float*)args.out; asm volatile("" : "+s"(X_g)); float* X = (float*)X_g; \
    int tid = threadIdx.x; asm volatile("" : "+v"(tid)); const int lane = tid & 63, wave = __builtin_amdgcn_readfirstlane(tid >> 6); \
    int G = gridDim.x; asm volatile("" : "+s"(G)); const int bx = blockIdx.x; const int gw = bx * NWAVES + wave, NGW = G * NWAVES; const long gt = (long)bx * 512 + tid, NGT = (long)G * 512; \
    const float* const* TAB = (const float* const*)(ws + WS_TAB); float* SS = (float*)(ws + WS_SS); bf16r* XB = (bf16r*)(ws + WS_XB); bf16r* HB = (bf16r*)(ws + WS_BIG); bf16r* PROJ = (bf16r*)(ws + WS_BIG); \
    bf16r* GSCR = (bf16r*)(ws + WS_BIG); float* MERGED = (float*)(ws + WS_BIG + 32 * MiB); float* ACC = (float*)(ws + WS_ACC); bf16r* YATT = (bf16r*)(ws + WS_ACC); bf16r* YS5 = (bf16r*)(ws + WS_YS5); bf16r* YGLA = (bf16r*)(ws + WS_YGLA); \
    LAS unsigned char* ldsl = (LAS unsigned char*)lds; LAS float* scr = (LAS float*)(ldsl + wave * 16384); \
    (void)TAB; (void)SS; (void)XB; (void)HB; (void)PROJ; (void)GSCR; (void)MERGED; (void)ACC; (void)YATT; (void)YS5; (void)YGLA; (void)scr; (void)gw; (void)NGW; (void)gt; (void)NGT; (void)X; (void)lane;
    { PH
      if (bx == 0 && tid == 0) { const float** tw = (const float**)(ws + WS_TAB);
#pragma unroll
        for (int i = 0; i < 32; ++i) tw[i] = args.in[i]; } }
    { PH
        const float* xin = args.in[0];
        for (int m = gw; m < M; m += NGW) {
            const f32x4* xr = (const f32x4*)(xin + (size_t)m * 1024) + lane; f32x4* xo = (f32x4*)(X + (size_t)m * 1024) + lane;
            unsigned long long* o8 = (unsigned long long*)(XB + (size_t)m * 1024) + lane; float s = 0.f;
#pragma unroll
            for (int j = 0; j < 4; ++j) { const f32x4 v = xr[64 * j]; s += (v.x * v.x + v.y * v.y) + (v.z * v.z + v.w * v.w);
                o8[64 * j] = (unsigned long long)pk2(v.x, v.y) | ((unsigned long long)pk2(v.z, v.w) << 32); }
            s = wave_sum(s); if (lane < 16) SS[(size_t)m * 16 + lane] = lane == 0 ? s : 0.f;
        }
        for (long i = gt; i < 1024; i += NGT) { const int pos = (int)(i >> 4), fq_ = (int)(i & 15); float sn, cs; sincosf((float)pos * exp2f(-(float)fq_ * (13.287712379549449f / 16.0f)), &sn, &cs);
            float* rp = (float*)(ws + WS_ROPE); rp[2 * i] = cs; rp[2 * i + 1] = sn; }
    }
    GSYNC();

    { constexpr int l = 0;

        { PH
            const float* n1 = TAB[1] + l * 1024; const float* n2 = TAB[27] + l * 1024; const float* nm = TAB[5] + l * 1024;
            { const float* Wg = TAB[2] + (size_t)l * 1024 * FF; const float* Wu = TAB[3] + (size_t)l * 1024 * FF;
              conv_all([=](int k, int n) { const int ff = (n >> 8) * 128 + (n & 127); return ((n & 128) ? Wu : Wg) + (size_t)k * FF + ff; }, [=](int k) { return n1[k]; }, 1024, 5632, (bf16r*)(ws + W_GU1), scr, gw, NGW, lane); }
            { const float* Wd = TAB[4] + (size_t)l * FF * 1024;
              conv_all([=](int k, int n) { return Wd + (size_t)k * 1024 + n; }, [](int) { return 1.0f; }, FF, 1024, (bf16r*)(ws + W_D1), scr, gw, NGW, lane); }
            { const float* Wg = TAB[28] + (size_t)l * 1024 * FF; const float* Wu = TAB[29] + (size_t)l * 1024 * FF;
              conv_all([=](int k, int n) { const int ff = (n >> 8) * 128 + (n & 127); return ((n & 128) ? Wu : Wg) + (size_t)k * FF + ff; }, [=](int k) { return n2[k]; }, 1024, 5632, (bf16r*)(ws + W_GU2), scr, gw, NGW, lane); }
            { const float* Wd = TAB[30] + (size_t)l * FF * 1024;
              conv_all([=](int k, int n) { return Wd + (size_t)k * 1024 + n; }, [](int) { return 1.0f; }, FF, 1024, (bf16r*)(ws + W_D2), scr, gw, NGW, lane); }
            { const float* Wi = TAB[6] + (size_t)l * 1024 * 3360;
              conv_all([=](int k, int n) { const int sc = n < 2560 ? n : (n < 3328 ? n + 32 : (n < 3360 ? n - 3328 + 2560 : -1)); return sc >= 0 ? Wi + (size_t)k * 3360 + sc : (const float*)nullptr; }, [=](int k) { return nm[k]; }, 1024, NWIN, (bf16r*)(ws + W_IN), scr, gw, NGW, lane); }
            { const float* Wm = TAB[24] + (size_t)l * 1024 * 3072;
              conv_all([=](int k, int n) { return Wm + (size_t)k * 3072 + n; }, [=](int k) { return nm[k]; }, 1024, 3072, (bf16r*)(ws + W_MG), scr, gw, NGW, lane); }
            { const float* Wx = TAB[15] + (size_t)l * 512 * 512;
              conv_all([=](int k, int n) { return Wx + (size_t)k * 512 + n; }, [](int) { return 1.0f; }, 512, 512, (bf16r*)(ws + W_GLU), scr, gw, NGW, lane); }
#pragma unroll
            for (int b = 0; b < 3; ++b) { const float* Wx = TAB[21 + b] + (size_t)l * 512 * 1024;
              conv_all([=](int k, int n) { return Wx + (size_t)k * 1024 + n; }, [](int) { return 1.0f; }, 512, 1024, (bf16r*)(ws + W_BR) + (size_t)b * 1024 * 512, scr, gw, NGW, lane); }
            { const float* Wx = TAB[26] + (size_t)l * 1024 * 1024;
              conv_all([=](int k, int n) { return Wx + (size_t)k * 1024 + n; }, [](int) { return 1.0f; }, 1024, 1024, (bf16r*)(ws + W_OUT), scr, gw, NGW, lane); }
            { bf16r* W1T = (bf16r*)(ws + WS_W1T); bf16r* BTY = (bf16r*)(ws + WS_BTY); float* KT = (float*)(ws + WS_KT);
              __syncthreads();
              { LAS float* LP = (LAS float*)ldsl; LAS float* FB = LP + 1024; LAS float* CC = FB + 2048;
                for (int unit = bx; unit < 256; unit += G) { const int dq = unit & 3, dir = (unit >> 2) & 1, g = unit >> 3;
                  const size_t o1 = ((size_t)(l * 2 + dir) * 32 + g); const float dt = expf(TAB[9][o1]);
                  { const int p = tid & 63, d8 = tid >> 6; const float lre = TAB[7][o1 * 64 + p], lim = TAB[8][o1 * 64 + p];
                    const float ed = (float)(dq * 8 + d8); const float mg = expf(ed * lre * dt), an = ed * lim * dt;
                    LP[(d8 * 64 + p) * 2] = mg * cosf(an); LP[(d8 * 64 + p) * 2 + 1] = mg * sinf(an);
                    const float mag1 = expf(lre * dt), ang1 = lim * dt, lbr = mag1 * cosf(ang1), lbi = mag1 * sinf(ang1);
                    const float den = lre * lre + lim * lim, nr = lbr - 1.0f, ni = lbi, fr = (nr * lre + ni * lim) / den, fi = (ni * lre - nr * lim) / den;
#pragma unroll
                    for (int k = 0; k < 2; ++k) { const int hp = d8 * 2 + k; const float br = TAB[10][(o1 * 64 + p) * 16 + hp], bi = TAB[11][(o1 * 64 + p) * 16 + hp];
                        FB[(p * 16 + hp) * 2] = fr * br - fi * bi; FB[(p * 16 + hp) * 2 + 1] = fr * bi + fi * br;
                        CC[(hp * 64 + p) * 2] = TAB[12][(o1 * 16 + hp) * 64 + p]; CC[(hp * 64 + p) * 2 + 1] = TAB[13][(o1 * 16 + hp) * 64 + p]; } }
                  __syncthreads();
#pragma unroll
                  for (int k = 0; k < 4; ++k) { const int o = tid + 512 * k, hp = o & 15, h = (o >> 4) & 15, d8 = o >> 8; float acc = 0.f;
                      for (int p = 0; p < 64; ++p) { const float cr = CC[(h * 64 + p) * 2], ci = CC[(h * 64 + p) * 2 + 1], pr = LP[(d8 * 64 + p) * 2], pi = LP[(d8 * 64 + p) * 2 + 1];
                          const float wr = cr * pr - ci * pi, wi = cr * pi + ci * pr; acc += wr * FB[(p * 16 + hp) * 2] - wi * FB[(p * 16 + hp) * 2 + 1]; }
                      KT[((((size_t)(g * 2 + dir) * 32 + dq * 8 + d8) * 16 + h) * 16) + hp] = acc; }
                  __syncthreads(); } } }
        }
        GSYNC();
        { PH pg8::Gemm g{XB, (const bf16r*)(ws + W_GU1), M, 5632, 1024, 1024, 1024}; pg8::StaticOrder S; S.init(M, 5632, G, bx);
          pg8::EpiSwiGLU E{HB, SS + (size_t)((3 * l + 0) % 3) * M * 16, FF};
          pg8::gemm_phase<pg8::EpiSwiGLU, pg8::StaticOrder, true, true>(ldsl, g, S, E); }
        { PH
          if (bx >= 128) { const long gt2 = (long)(bx - 128) * 512 + tid, NGT2 = (long)(G - 128) * 512;
            { bf16r* W1T = (bf16r*)(ws + WS_W1T); bf16r* BTY = (bf16r*)(ws + WS_BTY);
              for (long i = gt2; i < 131072; i += NGT2) { const int jq = (int)i & 31, p = (int)(i >> 5) & 63, dir = (int)(i >> 11) & 1, g = (int)(i >> 12);
                const size_t o1 = ((size_t)(l * 2 + dir) * 32 + g);
                const float lre = TAB[7][o1 * 64 + p], lim = TAB[8][o1 * 64 + p], dt = expf(TAB[9][o1]);
                const float mag1 = expf(lre * dt), ang1 = lim * dt, lbr = mag1 * cosf(ang1), lbi = mag1 * sinf(ang1);
                const float den = lre * lre + lim * lim, nr = lbr - 1.0f, ni = lbi, fr = (nr * lre + ni * lim) / den, fi = (ni * lre - nr * lim) / den;
                { const float e1 = (float)(dir ? jq : 31 - jq); const float mg = expf(e1 * lre * dt), an = e1 * lim * dt, pr = mg * cosf(an), pi = mg * sinf(an);
                  const float wr = pr * fr - pi * fi, wi = pr * fi + pi * fr;
                  float re[16], im[16];
#pragma unroll
                  for (int h = 0; h < 16; ++h) { const float br = TAB[10][(o1 * 64 + p) * 16 + h], bi = TAB[11][(o1 * 64 + p) * 16 + h]; re[h] = wr * br - wi * bi; im[h] = wr * bi + wi * br; }
                  v4u* d0 = (v4u*)(W1T + ((size_t)(g * 256 + dir * 128 + 2 * p) * 512 + jq * 16)); v4u* d1 = (v4u*)(W1T + ((size_t)(g * 256 + dir * 128 + 2 * p + 1) * 512 + jq * 16));
                  d0[0] = (v4u){pk2(re[0], re[1]), pk2(re[2], re[3]), pk2(re[4], re[5]), pk2(re[6], re[7])}; d0[1] = (v4u){pk2(re[8], re[9]), pk2(re[10], re[11]), pk2(re[12], re[13]), pk2(re[14], re[15])};
                  d1[0] = (v4u){pk2(im[0], im[1]), pk2(im[2], im[3]), pk2(im[4], im[5]), pk2(im[6], im[7])}; d1[1] = (v4u){pk2(im[8], im[9]), pk2(im[10], im[11]), pk2(im[12], im[13]), pk2(im[14], im[15])}; }
                { const float e2 = (float)(dir ? 32 - jq : jq + 1); const float mg = expf(e2 * lre * dt), an = e2 * lim * dt, pr = mg * cosf(an), pi = mg * sinf(an);
#pragma unroll
                  for (int h = 0; h < 16; ++h) { const float cr = TAB[12][(o1 * 16 + h) * 64 + p], ci = TAB[13][(o1 * 16 + h) * 64 + p]; const float wre = cr * pr - ci * pi, wim = cr * pi + ci * pr;
                      *(unsigned*)(BTY + ((size_t)(g * 512 + jq * 16 + h) * 768 + dir * 128 + 2 * p)) = pk2(wre, -wim); } } }
            }
            {
            const float* KT = (const float*)(ws + WS_KT); bf16r* BTY = (bf16r*)(ws + WS_BTY); const float* dsk = TAB[14] + l * 512;
            for (long it = gt2; it < 524288; it += NGT2) { const int j = (int)it & 31, n = (int)(it >> 5) & 511, g = (int)(it >> 14); const int i = n >> 4, h = n & 15;
                const float* kf = KT + (size_t)((g * 2 + 0) * 32) * 256 + h * 16; const float* kb = KT + (size_t)((g * 2 + 1) * 32) * 256 + h * 16;
                float v[16];
                if (i > j) {
#pragma unroll
                    for (int q = 0; q < 4; ++q) { const f32x4 x = *(const f32x4*)(kf + (i - j) * 256 + 4 * q); v[4 * q] = x[0]; v[4 * q + 1] = x[1]; v[4 * q + 2] = x[2]; v[4 * q + 3] = x[3]; }
                } else if (j > i) {
#pragma unroll
                    for (int q = 0; q < 4; ++q) { const f32x4 x = *(const f32x4*)(kb + (j - i) * 256 + 4 * q); v[4 * q] = x[0]; v[4 * q + 1] = x[1]; v[4 * q + 2] = x[2]; v[4 * q + 3] = x[3]; }
                } else { const float dd = dsk[16 * g + h];
#pragma unroll
                    for (int q = 0; q < 4; ++q) { const f32x4 x = *(const f32x4*)(kf + 4 * q) + *(const f32x4*)(kb + 4 * q); v[4 * q] = x[0]; v[4 * q + 1] = x[1]; v[4 * q + 2] = x[2]; v[4 * q + 3] = x[3]; }
#pragma unroll
                    for (int hp = 0; hp < 16; ++hp) v[hp] += (hp == h) ? dd : 0.f; }
                v4u* dst = (v4u*)(BTY + ((size_t)(g * 512 + n) * 768 + 256 + j * 16));
                dst[0] = (v4u){pk2(v[0], v[1]), pk2(v[2], v[3]), pk2(v[4], v[5]), pk2(v[6], v[7])}; dst[1] = (v4u){pk2(v[8], v[9]), pk2(v[10], v[11]), pk2(v[12], v[13]), pk2(v[14], v[15])}; }
            }
          }
        }
        GSYNC();
        { PH pg8::Gemm g{HB, (const bf16r*)(ws + W_D1), M, 1024, FF, FF, FF}; pg8::StaticOrder S; S.init(M, 1024, G, bx);
          pg8::EpiResid E{(l == 0 ? TAB[0] : (const float*)X), X, XB, SS + (size_t)((3 * l + 1) % 3) * M * 16, 0.5f};
          pg8::gemm_phase<pg8::EpiResid, pg8::StaticOrder, true, true>(ldsl, g, S, E); }
        GSYNC();
        if (l == STOP_L && STOP_P == 2) { fin_buf = 1; goto final_norm; }
        { PH pg8::Gemm g{XB, (const bf16r*)(ws + W_IN), M, 2048, 1024, 1024, 1024}; pg8::StaticOrder S; S.init(M, 2048, G, bx);
          pg8::EpiInSplit E{PROJ, NPROJ, (bf16r*)(ws + WS_UG), SS + (size_t)((3 * l + 1) % 3) * M * 16};
          pg8::gemm_phase<pg8::EpiInSplit, pg8::StaticOrder, true, true>(ldsl, g, S, E); }
        GSYNC();
        { PH pg8::Gemm g{(const bf16r*)(ws + WS_UG) + 256, (const bf16r*)(ws + WS_W1T), 512, 256, 512, 768, 512, (size_t)512 * 768 * 2, (size_t)256 * 512 * 2}; pg8::BatchOrder S; S.init(2, 1, 32, G, bx);
          pg8::EpiF32B E{(float*)(ws + WS_E), 256, (size_t)512 * 256};
          pg8::gemm_phase<pg8::EpiF32B, pg8::BatchOrder, true, true>(ldsl, g, S, E); }
        { PH pg8::Gemm g{XB, (const bf16r*)(ws + W_IN) + (size_t)3072 * 1024, M, 512, 1024, 1024, 1024}; pg8::StaticOrder S; S.init(M, 512, G, (bx + G - 64) % G);
          pg8::EpiScaleBf16 E{PROJ + 2560, NPROJ, SS + (size_t)((3 * l + 1) % 3) * M * 16};
          pg8::gemm_phase<pg8::EpiScaleBf16, pg8::StaticOrder, true, true>(ldsl, g, S, E); }
        GSYNC();
        { PH
            const float* E = (const float*)(ws + WS_E); bf16r* UG = (bf16r*)(ws + WS_UG);
            for (long i = gt; i < 16384; i += NGT) { const int p = (int)i & 63, bb = (int)(i >> 6) & 3, dir = (int)(i >> 8) & 1, g = (int)(i >> 9);
                const size_t o1 = ((size_t)(l * 2 + dir) * 32 + g);
                const float lre = TAB[7][o1 * 64 + p], lim = TAB[8][o1 * 64 + p], dt = expf(TAB[9][o1]);
                const float mg = expf(32.0f * lre * dt), an = 32.0f * lim * dt, ar = mg * cosf(an), ai = mg * sinf(an);
                float xr = 0.f, xi = 0.f;
                for (int c0 = 0; c0 < 128; c0 += 8) { float er[8], ei[8];
#pragma unroll
                    for (int k = 0; k < 8; ++k) { const int c = dir ? 127 - (c0 + k) : c0 + k; const float* pe = E + ((size_t)(g * 512 + bb * 128 + c) * 256 + dir * 128 + 2 * p); er[k] = pe[0]; ei[k] = pe[1]; }
#pragma unroll
                    for (int k = 0; k < 8; ++k) { const int c = dir ? 127 - (c0 + k) : c0 + k;
                        *(unsigned*)(UG + ((size_t)(g * 512 + bb * 128 + c) * 768 + dir * 128 + 2 * p)) = pk2(xr, xi);
                        const float nr = ar * xr - ai * xi + er[k], ni = ar * xi + ai * xr + ei[k]; xr = nr; xi = ni; } } }
        }
        GSYNC();
        { PH pg8::Gemm g{(const bf16r*)(ws + WS_UG), (const bf16r*)(ws + WS_BTY), 512, 512, 768, 768, 768, (size_t)512 * 768 * 2, (size_t)512 * 768 * 2}; pg8::BatchOrder S; S.init(2, 2, 32, G, bx);
          pg8::EpiS5Y E{(bf16r*)(ws + WS_E)};
          pg8::gemm_phase<pg8::EpiS5Y, pg8::BatchOrder, true, true>(ldsl, g, S, E); }
        { PH pg8::Gemm g{XB, (const bf16r*)(ws + W_IN) + (size_t)2048 * 1024, M, 512, 1024, 1024, 1024}; pg8::StaticOrder S; S.init(M, 512, G, (bx + G - 128) % G);
          pg8::EpiScaleBf16 E{PROJ + 1536, NPROJ, SS + (size_t)((3 * l + 1) % 3) * M * 16};
          pg8::gemm_phase<pg8::EpiScaleBf16, pg8::StaticOrder, true, true>(ldsl, g, S, E); }
        GSYNC();
        { PH pg8::Gemm g{(const bf16r*)(ws + WS_E), (const bf16r*)(ws + W_GLU), M, 512, 512, 512, 512}; pg8::StaticOrder S; S.init(M, 512, G, bx);
          pg8::EpiGlu E{(const bf16r*)(ws + WS_E), 512, YS5, 512};
          pg8::gemm_phase<pg8::EpiGlu, pg8::StaticOrder, true, true>(ldsl, g, S, E); }
        { PH pg8::Gemm g{XB, (const bf16r*)(ws + W_IN) + (size_t)2560 * 1024, M, 512, 1024, 1024, 1024}; pg8::StaticOrder S; S.init(M, 512, G, (bx + G - 128) % G);
          pg8::EpiScaleBf16 E{PROJ + 2048, NPROJ, SS + (size_t)((3 * l + 1) % 3) * M * 16};
          pg8::gemm_phase<pg8::EpiScaleBf16, pg8::StaticOrder, true, true>(ldsl, g, S, E); }
        GSYNC();
        { PH
          for (int unit = bx; unit < 256; unit += G) gla_passA_mfma(TAB, l, unit, tid, PROJ, (float*)(ws + WS_GE), (float*)(ws + WS_GDT), ldsl);
          __syncthreads();
          {
            const float* qg = TAB[19] + l * 64; const float* kg = TAB[20] + l * 64;
            const int d = lane, e = d & 31, fi_ = e & 15; const bool second = e >= 16;
            const float* ROPE = (const float*)(ws + WS_ROPE);
            for (long it = gw; it < (long)M * 10; it += NGW) {
                const int row = (int)(it / 10), j = (int)(it % 10); const int tt = row & (SEQ - 1);
                bf16r* px = PROJ + (size_t)row * NPROJ + (j < 8 ? PC_AQ + 64 * j : PC_AK + 64 * (j - 8)) + d;
                const float x = bf2f(*px); const float ssq = wave_sum(x * x);
                const float gain = j < 8 ? qg[d] : kg[d];
                const float y = x * rsqrtf(ssq * (1.0f / 64.0f) + 1e-6f) * gain;
                const int posi = (d < 32) ? (tt >> 6) : (tt & 63);
                const float cs = ROPE[(posi * 16 + fi_) * 2], sn = ROPE[(posi * 16 + fi_) * 2 + 1];
                const float partner = __shfl_xor(y, 16);
                float o = second ? (y * cs + partner * sn) : (y * cs - partner * sn);
                if (j < 8) o *= 0.125f * 1.4426950408889634f;
                *px = (bf16r)f2bf(o);
            }
          }
        }
        GSYNC();
        { PH
          for (int unit = bx; unit < 256; unit += G) gla_passB_mfma(TAB, l, unit, tid, PROJ, ACC, YGLA, (const float*)(ws + WS_GE), (const float*)(ws + WS_GDT), ldsl); }
        GSYNC();
        { PH
            const float* gn = TAB[18] + l * 128;
            for (long it = gw; it < (long)M * 4; it += NGW) { const int row = (int)(it >> 2), h = (int)(it & 3);
                const unsigned oa = *(const unsigned*)((const bf16r*)ACC + (size_t)row * 512 + h * 128 + 2 * lane); const unsigned ob = *(const unsigned*)(YGLA + (size_t)row * 512 + h * 128 + 2 * lane); const float o0 = pg8::bflo(oa) + pg8::bflo(ob), o1 = pg8::bfhi(oa) + pg8::bfhi(ob);
                const float ssq = wave_sum(o0 * o0 + o1 * o1); const float r = rsqrtf(ssq * (1.0f / 128.0f) + 1e-6f);
                const unsigned gg = *(const unsigned*)(PROJ + (size_t)row * NPROJ + PC_GG + h * 128 + 2 * lane);
                const float y0 = o0 * r * gn[2 * lane] * silu_(pg8::bflo(gg)), y1 = o1 * r * gn[2 * lane + 1] * silu_(pg8::bfhi(gg));
                *(unsigned*)(YGLA + (size_t)row * 512 + h * 128 + 2 * lane) = pk2(y0, y1); }
        }
        GSYNC();
#ifndef NO_ATT
        { PH
            const attn_body::AttnTensors AT{(const attn_body::bf16*)(PROJ + PC_AQ), (const attn_body::bf16*)(PROJ + PC_AK), (const attn_body::bf16*)(PROJ + PC_AV), (attn_body::bf16*)YATT};
            const attn_body::StaticOrder S(G, bx);
            attn_body::attn_phase<attn_body::StaticOrder>((char*)lds, AT, S);
        }
#endif
        GSYNC();
#ifndef NO_MERGE
        { PH
            { pg8::Gemm g{XB, (const bf16r*)(ws + W_MG), M, 1024, 1024, 1024, 1024, 0, (size_t)1024 * 1024 * 2}; pg8::TileBatchOrder S; S.init(M, 1024, 3, G, bx);
              pg8::EpiGate3 E{GSCR, TAB[25] + l * 3072, SS + (size_t)((3 * l + 1) % 3) * M * 16};
              pg8::gemm_phase<pg8::EpiGate3, pg8::TileBatchOrder, true, true>(ldsl, g, S, E); }
            { pg8::Gemm g{YS5, (const bf16r*)(ws + W_BR), M, 1024, 512, 512, 512, 0, (size_t)1024 * 512 * 2, {0, (size_t)(WS_YGLA - WS_YS5), (size_t)(WS_ACC - WS_YS5)}, 1}; pg8::TileBatchOrder S; S.init(M, 1024, 3, G, bx);
              pg8::EpiMerge3 E{GSCR, (bf16r*)(ws + WS_MG16)};
              pg8::gemm_phase<pg8::EpiMerge3, pg8::TileBatchOrder, true, true>(ldsl, g, S, E); }
        }
#endif
        GSYNC();
        { PH pg8::Gemm g{GSCR, (const bf16r*)(ws + W_OUT), M, 1024, 1024, 1024, 1024}; pg8::StaticOrder S; S.init(M, 1024, G, bx);
          pg8::EpiResid E{X, X, XB, SS + (size_t)((3 * l + 2) % 3) * M * 16, 1.0f};
          pg8::gemm_phase<pg8::EpiResid, pg8::StaticOrder, true, true>(ldsl, g, S, E); }
        GSYNC();
        if (l == STOP_L && STOP_P == 10) { fin_buf = 2; goto final_norm; }
        { PH pg8::Gemm g{XB, (const bf16r*)(ws + W_GU2), M, 5632, 1024, 1024, 1024}; pg8::StaticOrder S; S.init(M, 5632, G, bx);
          pg8::EpiSwiGLU E{HB, SS + (size_t)((3 * l + 2) % 3) * M * 16, FF};
          pg8::gemm_phase<pg8::EpiSwiGLU, pg8::StaticOrder, true, true>(ldsl, g, S, E); }
        GSYNC();
        { PH pg8::Gemm g{HB, (const bf16r*)(ws + W_D2), M, 1024, FF, FF, FF}; pg8::StaticOrder S; S.init(M, 1024, G, bx);
          pg8::EpiResid E{X, X, (l == 1 ? (bf16r*)nullptr : XB), SS + (size_t)((3 * l + 3) % 3) * M * 16, 0.5f};
          pg8::gemm_phase<pg8::EpiResid, pg8::StaticOrder, true, true>(ldsl, g, S, E); }
        GSYNC();
        if (l == STOP_L && STOP_P == 12) { fin_buf = 0; goto final_norm; }

    }
    { constexpr int l = 1;

        { PH
            const float* n1 = TAB[1] + l * 1024; const float* n2 = TAB[27] + l * 1024; const float* nm = TAB[5] + l * 1024;
            { const float* Wg = TAB[2] + (size_t)l * 1024 * FF; const float* Wu = TAB[3] + (size_t)l * 1024 * FF;
              conv_all([=](int k, int n) { const int ff = (n >> 8) * 128 + (n & 127); return ((n & 128) ? Wu : Wg) + (size_t)k * FF + ff; }, [=](int k) { return n1[k]; }, 1024, 5632, (bf16r*)(ws + W_GU1), scr, gw, NGW, lane); }
            { const float* Wd = TAB[4] + (size_t)l * FF * 1024;
              conv_all([=](int k, int n) { return Wd + (size_t)k * 1024 + n; }, [](int) { return 1.0f; }, FF, 1024, (bf16r*)(ws + W_D1), scr, gw, NGW, lane); }
            { const float* Wg = TAB[28] + (size_t)l * 1024 * FF; const float* Wu = TAB[29] + (size_t)l * 1024 * FF;
              conv_all([=](int k, int n) { const int ff = (n >> 8) * 128 + (n & 127); return ((n & 128) ? Wu : Wg) + (size_t)k * FF + ff; }, [=](int k) { return n2[k]; }, 1024, 5632, (bf16r*)(ws + W_GU2), scr, gw, NGW, lane); }
            { const float* Wd = TAB[30] + (size_t)l * FF * 1024;
              conv_all([=](int k, int n) { return Wd + (size_t)k * 1024 + n; }, [](int) { return 1.0f; }, FF, 1024, (bf16r*)(ws + W_D2), scr, gw, NGW, lane); }
            { const float* Wi = TAB[6] + (size_t)l * 1024 * 3360;
              conv_all([=](int k, int n) { const int sc = n < 2560 ? n : (n < 3328 ? n + 32 : (n < 3360 ? n - 3328 + 2560 : -1)); return sc >= 0 ? Wi + (size_t)k * 3360 + sc : (const float*)nullptr; }, [=](int k) { return nm[k]; }, 1024, NWIN, (bf16r*)(ws + W_IN), scr, gw, NGW, lane); }
            { const float* Wm = TAB[24] + (size_t)l * 1024 * 3072;
              conv_all([=](int k, int n) { return Wm + (size_t)k * 3072 + n; }, [=](int k) { return nm[k]; }, 1024, 3072, (bf16r*)(ws + W_MG), scr, gw, NGW, lane); }
            { const float* Wx = TAB[15] + (size_t)l * 512 * 512;
              conv_all([=](int k, int n) { return Wx + (size_t)k * 512 + n; }, [](int) { return 1.0f; }, 512, 512, (bf16r*)(ws + W_GLU), scr, gw, NGW, lane); }
#pragma unroll
            for (int b = 0; b < 3; ++b) { const float* Wx = TAB[21 + b] + (size_t)l * 512 * 1024;
              conv_all([=](int k, int n) { return Wx + (size_t)k * 1024 + n; }, [](int) { return 1.0f; }, 512, 1024, (bf16r*)(ws + W_BR) + (size_t)b * 1024 * 512, scr, gw, NGW, lane); }
            { const float* Wx = TAB[26] + (size_t)l * 1024 * 1024;
              conv_all([=](int k, int n) { return Wx + (size_t)k * 1024 + n; }, [](int) { return 1.0f; }, 1024, 1024, (bf16r*)(ws + W_OUT), scr, gw, NGW, lane); }
            { bf16r* W1T = (bf16r*)(ws + WS_W1T); bf16r* BTY = (bf16r*)(ws + WS_BTY); float* KT = (float*)(ws + WS_KT);
              __syncthreads();
              { LAS float* LP = (LAS float*)ldsl; LAS float* FB = LP + 1024; LAS float* CC = FB + 2048;
                for (int unit = bx; unit < 256; unit += G) { const int dq = unit & 3, dir = (unit >> 2) & 1, g = unit >> 3;
                  const size_t o1 = ((size_t)(l * 2 + dir) * 32 + g); const float dt = expf(TAB[9][o1]);
                  { const int p = tid & 63, d8 = tid >> 6; const float lre = TAB[7][o1 * 64 + p], lim = TAB[8][o1 * 64 + p];
                    const float ed = (float)(dq * 8 + d8); const float mg = expf(ed * lre * dt), an = ed * lim * dt;
                    LP[(d8 * 64 + p) * 2] = mg * cosf(an); LP[(d8 * 64 + p) * 2 + 1] = mg * sinf(an);
                    const float mag1 = expf(lre * dt), ang1 = lim * dt, lbr = mag1 * cosf(ang1), lbi = mag1 * sinf(ang1);
                    const float den = lre * lre + lim * lim, nr = lbr - 1.0f, ni = lbi, fr = (nr * lre + ni * lim) / den, fi = (ni * lre - nr * lim) / den;
#pragma unroll
                    for (int k = 0; k < 2; ++k) { const int hp = d8 * 2 + k; const float br = TAB[10][(o1 * 64 + p) * 16 + hp], bi = TAB[11][(o1 * 64 + p) * 16 + hp];
                        FB[(p * 16 + hp) * 2] = fr * br - fi * bi; FB[(p * 16 + hp) * 2 + 1] = fr * bi + fi * br;
                        CC[(hp * 64 + p) * 2] = TAB[12][(o1 * 16 + hp) * 64 + p]; CC[(hp * 64 + p) * 2 + 1] = TAB[13][(o1 * 16 + hp) * 64 + p]; } }
                  __syncthreads();
#pragma unroll
                  for (int k = 0; k < 4; ++k) { const int o = tid + 512 * k, hp = o & 15, h = (o >> 4) & 15, d8 = o >> 8; float acc = 0.f;
                      for (int p = 0; p < 64; ++p) { const float cr = CC[(h * 64 + p) * 2], ci = CC[(h * 64 + p) * 2 + 1], pr = LP[(d8 * 64 + p) * 2], pi = LP[(d8 * 64 + p) * 2 + 1];
                          const float wr = cr * pr - ci * pi, wi = cr * pi + ci * pr; acc += wr * FB[(p * 16 + hp) * 2] - wi * FB[(p * 16 + hp) * 2 + 1]; }
                      KT[((((size_t)(g * 2 + dir) * 32 + dq * 8 + d8) * 16 + h) * 16) + hp] = acc; }
                  __syncthreads(); } } }
        }
        GSYNC();
        { PH pg8::Gemm g{XB, (const bf16r*)(ws + W_GU1), M, 5632, 1024, 1024, 1024}; pg8::StaticOrder S; S.init(M, 5632, G, bx);
          pg8::EpiSwiGLU E{HB, SS + (size_t)((3 * l + 0) % 3) * M * 16, FF};
          pg8::gemm_phase<pg8::EpiSwiGLU, pg8::StaticOrder, true, true>(ldsl, g, S, E); }
        { PH
          if (bx >= 128) { const long gt2 = (long)(bx - 128) * 512 + tid, NGT2 = (long)(G - 128) * 512;
            { bf16r* W1T = (bf16r*)(ws + WS_W1T); bf16r* BTY = (bf16r*)(ws + WS_BTY);
              for (long i = gt2; i < 131072; i += NGT2) { const int jq = (int)i & 31, p = (int)(i >> 5) & 63, dir = (int)(i >> 11) & 1, g = (int)(i >> 12);
                const size_t o1 = ((size_t)(l * 2 + dir) * 32 + g);
                const float lre = TAB[7][o1 * 64 + p], lim = TAB[8][o1 * 64 + p], dt = expf(TAB[9][o1]);
                const float mag1 = expf(lre * dt), ang1 = lim * dt, lbr = mag1 * cosf(ang1), lbi = mag1 * sinf(ang1);
                const float den = lre * lre + lim * lim, nr = lbr - 1.0f, ni = lbi, fr = (nr * lre + ni * lim) / den, fi = (ni * lre - nr * lim) / den;
                { const float e1 = (float)(dir ? jq : 31 - jq); const float mg = expf(e1 * lre * dt), an = e1 * lim * dt, pr = mg * cosf(an), pi = mg * sinf(an);
                  const float wr = pr * fr - pi * fi, wi = pr * fi + pi * fr;
                  float re[16], im[16];
#pragma unroll
                  for (int h = 0; h < 16; ++h) { const float br = TAB[10][(o1 * 64 + p) * 16 + h], bi = TAB[11][(o1 * 64 + p) * 16 + h]; re[h] = wr * br - wi * bi; im[h] = wr * bi + wi * br; }
                  v4u* d0 = (v4u*)(W1T + ((size_t)(g * 256 + dir * 128 + 2 * p) * 512 + jq * 16)); v4u* d1 = (v4u*)(W1T + ((size_t)(g * 256 + dir * 128 + 2 * p + 1) * 512 + jq * 16));
                  d0[0] = (v4u){pk2(re[0], re[1]), pk2(re[2], re[3]), pk2(re[4], re[5]), pk2(re[6], re[7])}; d0[1] = (v4u){pk2(re[8], re[9]), pk2(re[10], re[11]), pk2(re[12], re[13]), pk2(re[14], re[15])};
                  d1[0] = (v4u){pk2(im[0], im[1]), pk2(im[2], im[3]), pk2(im[4], im[5]), pk2(im[6], im[7])}; d1[1] = (v4u){pk2(im[8], im[9]), pk2(im[10], im[11]), pk2(im[12], im[13]), pk2(im[14], im[15])}; }
                { const float e2 = (float)(dir ? 32 - jq : jq + 1); const float mg = expf(e2 * lre * dt), an = e2 * lim * dt, pr = mg * cosf(an), pi = mg * sinf(an);
#pragma unroll
                  for (int h = 0; h < 16; ++h) { const float cr = TAB[12][(o1 * 16 + h) * 64 + p], ci = TAB[13][(o1 * 16 + h) * 64 + p]; const float wre = cr * pr - ci * pi, wim = cr * pi + ci * pr;
                      *(unsigned*)(BTY + ((size_t)(g * 512 + jq * 16 + h) * 768 + dir * 128 + 2 * p)) = pk2(wre, -wim); } } }
            }
            {
            const float* KT = (const float*)(ws + WS_KT); bf16r* BTY = (bf16r*)(ws + WS_BTY); const float* dsk = TAB[14] + l * 512;
            for (long it = gt2; it < 524288; it += NGT2) { const int j = (int)it & 31, n = (int)(it >> 5) & 511, g = (int)(it >> 14); const int i = n >> 4, h = n & 15;
                const float* kf = KT + (size_t)((g * 2 + 0) * 32) * 256 + h * 16; const float* kb = KT + (size_t)((g * 2 + 1) * 32) * 256 + h * 16;
                float v[16];
                if (i > j) {
#pragma unroll
                    for (int q = 0; q < 4; ++q) { const f32x4 x = *(const f32x4*)(kf + (i - j) * 256 + 4 * q); v[4 * q] = x[0]; v[4 * q + 1] = x[1]; v[4 * q + 2] = x[2]; v[4 * q + 3] = x[3]; }
                } else if (j > i) {
#pragma unroll
                    for (int q = 0; q < 4; ++q) { const f32x4 x = *(const f32x4*)(kb + (j - i) * 256 + 4 * q); v[4 * q] = x[0]; v[4 * q + 1] = x[1]; v[4 * q + 2] = x[2]; v[4 * q + 3] = x[3]; }
                } else { const float dd = dsk[16 * g + h];
#pragma unroll
                    for (int q = 0; q < 4; ++q) { const f32x4 x = *(const f32x4*)(kf + 4 * q) + *(const f32x4*)(kb + 4 * q); v[4 * q] = x[0]; v[4 * q + 1] = x[1]; v[4 * q + 2] = x[2]; v[4 * q + 3] = x[3]; }
#pragma unroll
                    for (int hp = 0; hp < 16; ++hp) v[hp] += (hp == h) ? dd : 0.f; }
                v4u* dst = (v4u*)(BTY + ((size_t)(g * 512 + n) * 768 + 256 + j * 16));
                dst[0] = (v4u){pk2(v[0], v[1]), pk2(v[2], v[3]), pk2(v[4], v[5]), pk2(v[6], v[7])}; dst[1] = (v4u){pk2(v[8], v[9]), pk2(v[10], v[11]), pk2(v[12], v[13]), pk2(v[14], v[15])}; }
            }
          }
        }
        GSYNC();
        { PH pg8::Gemm g{HB, (const bf16r*)(ws + W_D1), M, 1024, FF, FF, FF}; pg8::StaticOrder S; S.init(M, 1024, G, bx);
          pg8::EpiResid E{(l == 0 ? TAB[0] : (const float*)X), X, XB, SS + (size_t)((3 * l + 1) % 3) * M * 16, 0.5f};
          pg8::gemm_phase<pg8::EpiResid, pg8::StaticOrder, true, true>(ldsl, g, S, E); }
        GSYNC();
        if (l == STOP_L && STOP_P == 2) { fin_buf = 1; goto final_norm; }
        { PH pg8::Gemm g{XB, (const bf16r*)(ws + W_IN), M, 2048, 1024, 1024, 1024}; pg8::StaticOrder S; S.init(M, 2048, G, bx);
          pg8::EpiInSplit E{PROJ, NPROJ, (bf16r*)(ws + WS_UG), SS + (size_t)((3 * l + 1) % 3) * M * 16};
          pg8::gemm_phase<pg8::EpiInSplit, pg8::StaticOrder, true, true>(ldsl, g, S, E); }
        GSYNC();
        { PH pg8::Gemm g{(const bf16r*)(ws + WS_UG) + 256, (const bf16r*)(ws + WS_W1T), 512, 256, 512, 768, 512, (size_t)512 * 768 * 2, (size_t)256 * 512 * 2}; pg8::BatchOrder S; S.init(2, 1, 32, G, bx);
          pg8::EpiF32B E{(float*)(ws + WS_E), 256, (size_t)512 * 256};
          pg8::gemm_phase<pg8::EpiF32B, pg8::BatchOrder, true, true>(ldsl, g, S, E); }
        { PH pg8::Gemm g{XB, (const bf16r*)(ws + W_IN) + (size_t)3072 * 1024, M, 512, 1024, 1024, 1024}; pg8::StaticOrder S; S.init(M, 512, G, (bx + G - 64) % G);
          pg8::EpiScaleBf16 E{PROJ + 2560, NPROJ, SS + (size_t)((3 * l + 1) % 3) * M * 16};
          pg8::gemm_phase<pg8::EpiScaleBf16, pg8::StaticOrder, true, true>(ldsl, g, S, E); }
        GSYNC();
        { PH
            const float* E = (const float*)(ws + WS_E); bf16r* UG = (bf16r*)(ws + WS_UG);
            for (long i = gt; i < 16384; i += NGT) { const int p = (int)i & 63, bb = (int)(i >> 6) & 3, dir = (int)(i >> 8) & 1, g = (int)(i >> 9);
                const size_t o1 = ((size_t)(l * 2 + dir) * 32 + g);
                const float lre = TAB[7][o1 * 64 + p], lim = TAB[8][o1 * 64 + p], dt = expf(TAB[9][o1]);
                const float mg = expf(32.0f * lre * dt), an = 32.0f * lim * dt, ar = mg * cosf(an), ai = mg * sinf(an);
                float xr = 0.f, xi = 0.f;
                for (int c0 = 0; c0 < 128; c0 += 8) { float er[8], ei[8];
#pragma unroll
                    for (int k = 0; k < 8; ++k) { const int c = dir ? 127 - (c0 + k) : c0 + k; const float* pe = E + ((size_t)(g * 512 + bb * 128 + c) * 256 + dir * 128 + 2 * p); er[k] = pe[0]; ei[k] = pe[1]; }
#pragma unroll
                    for (int k = 0; k < 8; ++k) { const int c = dir ? 127 - (c0 + k) : c0 + k;
                        *(unsigned*)(UG + ((size_t)(g * 512 + bb * 128 + c) * 768 + dir * 128 + 2 * p)) = pk2(xr, xi);
                        const float nr = ar * xr - ai * xi + er[k], ni = ar * xi + ai * xr + ei[k]; xr = nr; xi = ni; } } }
        }
        GSYNC();
        { PH pg8::Gemm g{(const bf16r*)(ws + WS_UG), (const bf16r*)(ws + WS_BTY), 512, 512, 768, 768, 768, (size_t)512 * 768 * 2, (size_t)512 * 768 * 2}; pg8::BatchOrder S; S.init(2, 2, 32, G, bx);
          pg8::EpiS5Y E{(bf16r*)(ws + WS_E)};
          pg8::gemm_phase<pg8::EpiS5Y, pg8::BatchOrder, true, true>(ldsl, g, S, E); }
        { PH pg8::Gemm g{XB, (const bf16r*)(ws + W_IN) + (size_t)2048 * 1024, M, 512, 1024, 1024, 1024}; pg8::StaticOrder S; S.init(M, 512, G, (bx + G - 128) % G);
          pg8::EpiScaleBf16 E{PROJ + 1536, NPROJ, SS + (size_t)((3 * l + 1) % 3) * M * 16};
          pg8::gemm_phase<pg8::EpiScaleBf16, pg8::StaticOrder, true, true>(ldsl, g, S, E); }
        GSYNC();
        { PH pg8::Gemm g{(const bf16r*)(ws + WS_E), (const bf16r*)(ws + W_GLU), M, 512, 512, 512, 512}; pg8::StaticOrder S; S.init(M, 512, G, bx);
          pg8::EpiGlu E{(const bf16r*)(ws + WS_E), 512, YS5, 512};
          pg8::gemm_phase<pg8::EpiGlu, pg8::StaticOrder, true, true>(ldsl, g, S, E); }
        { PH pg8::Gemm g{XB, (const bf16r*)(ws + W_IN) + (size_t)2560 * 1024, M, 512, 1024, 1024, 1024}; pg8::StaticOrder S; S.init(M, 512, G, (bx + G - 128) % G);
          pg8::EpiScaleBf16 E{PROJ + 2048, NPROJ, SS + (size_t)((3 * l + 1) % 3) * M * 16};
          pg8::gemm_phase<pg8::EpiScaleBf16, pg8::StaticOrder, true, true>(ldsl, g, S, E); }
        GSYNC();
        { PH
          for (int unit = bx; unit < 256; unit += G) gla_passA_mfma(TAB, l, unit, tid, PROJ, (float*)(ws + WS_GE), (float*)(ws + WS_GDT), ldsl);
          __syncthreads();
          {
            const float* qg = TAB[19] + l * 64; const float* kg = TAB[20] + l * 64;
            const int d = lane, e = d & 31, fi_ = e & 15; const bool second = e >= 16;
            const float* ROPE = (const float*)(ws + WS_ROPE);
            for (long it = gw; it < (long)M * 10; it += NGW) {
                const int row = (int)(it / 10), j = (int)(it % 10); const int tt = row & (SEQ - 1);
                bf16r* px = PROJ + (size_t)row * NPROJ + (j < 8 ? PC_AQ + 64 * j : PC_AK + 64 * (j - 8)) + d;
                const float x = bf2f(*px); const float ssq = wave_sum(x * x);
                const float gain = j < 8 ? qg[d] : kg[d];
                const float y = x * rsqrtf(ssq * (1.0f / 64.0f) + 1e-6f) * gain;
                const int posi = (d < 32) ? (tt >> 6) : (tt & 63);
                const float cs = ROPE[(posi * 16 + fi_) * 2], sn = ROPE[(posi * 16 + fi_) * 2 + 1];
                const float partner = __shfl_xor(y, 16);
                float o = second ? (y * cs + partner * sn) : (y * cs - partner * sn);
                if (j < 8) o *= 0.125f * 1.4426950408889634f;
                *px = (bf16r)f2bf(o);
            }
          }
        }
        GSYNC();
        { PH
          for (int unit = bx; unit < 256; unit += G) gla_passB_mfma(TAB, l, unit, tid, PROJ, ACC, YGLA, (const float*)(ws + WS_GE), (const float*)(ws + WS_GDT), ldsl); }
        GSYNC();
        { PH
            const float* gn = TAB[18] + l * 128;
            for (long it = gw; it < (long)M * 4; it += NGW) { const int row = (int)(it >> 2), h = (int)(it & 3);
                const unsigned oa = *(const unsigned*)((const bf16r*)ACC + (size_t)row * 512 + h * 128 + 2 * lane); const unsigned ob = *(const unsigned*)(YGLA + (size_t)row * 512 + h * 128 + 2 * lane); const float o0 = pg8::bflo(oa) + pg8::bflo(ob), o1 = pg8::bfhi(oa) + pg8::bfhi(ob);
                const float ssq = wave_sum(o0 * o0 + o1 * o1); const float r = rsqrtf(ssq * (1.0f / 128.0f) + 1e-6f);
                const unsigned gg = *(const unsigned*)(PROJ + (size_t)row * NPROJ + PC_GG + h * 128 + 2 * lane);
                const float y0 = o0 * r * gn[2 * lane] * silu_(pg8::bflo(gg)), y1 = o1 * r * gn[2 * lane + 1] * silu_(pg8::bfhi(gg));
                *(unsigned*)(YGLA + (size_t)row * 512 + h * 128 + 2 * lane) = pk2(y0, y1); }
        }
        GSYNC();
#ifndef NO_ATT
        { PH
            const attn_body::AttnTensors AT{(const attn_body::bf16*)(PROJ + PC_AQ), (const attn_body::bf16*)(PROJ + PC_AK), (const attn_body::bf16*)(PROJ + PC_AV), (attn_body::bf16*)YATT};
            const attn_body::StaticOrder S(G, bx);
            attn_body::attn_phase<attn_body::StaticOrder>((char*)lds, AT, S);
        }
#endif
        GSYNC();
#ifndef NO_MERGE
        { PH
            { pg8::Gemm g{XB, (const bf16r*)(ws + W_MG), M, 1024, 1024, 1024, 1024, 0, (size_t)1024 * 1024 * 2}; pg8::TileBatchOrder S; S.init(M, 1024, 3, G, bx);
              pg8::EpiGate3 E{GSCR, TAB[25] + l * 3072, SS + (size_t)((3 * l + 1) % 3) * M * 16};
              pg8::gemm_phase<pg8::EpiGate3, pg8::TileBatchOrder, true, true>(ldsl, g, S, E); }
            { pg8::Gemm g{YS5, (const bf16r*)(ws + W_BR), M, 1024, 512, 512, 512, 0, (size_t)1024 * 512 * 2, {0, (size_t)(WS_YGLA - WS_YS5), (size_t)(WS_ACC - WS_YS5)}, 1}; pg8::TileBatchOrder S; S.init(M, 1024, 3, G, bx);
              pg8::EpiMerge3 E{GSCR, (bf16r*)(ws + WS_MG16)};
              pg8::gemm_phase<pg8::EpiMerge3, pg8::TileBatchOrder, true, true>(ldsl, g, S, E); }
        }
#endif
        GSYNC();
        { PH pg8::Gemm g{GSCR, (const bf16r*)(ws + W_OUT), M, 1024, 1024, 1024, 1024}; pg8::StaticOrder S; S.init(M, 1024, G, bx);
          pg8::EpiResid E{X, X, XB, SS + (size_t)((3 * l + 2) % 3) * M * 16, 1.0f};
          pg8::gemm_phase<pg8::EpiResid, pg8::StaticOrder, true, true>(ldsl, g, S, E); }
        GSYNC();
        if (l == STOP_L && STOP_P == 10) { fin_buf = 2; goto final_norm; }
        { PH pg8::Gemm g{XB, (const bf16r*)(ws + W_GU2), M, 5632, 1024, 1024, 1024}; pg8::StaticOrder S; S.init(M, 5632, G, bx);
          pg8::EpiSwiGLU E{HB, SS + (size_t)((3 * l + 2) % 3) * M * 16, FF};
          pg8::gemm_phase<pg8::EpiSwiGLU, pg8::StaticOrder, true, true>(ldsl, g, S, E); }
        GSYNC();
        { PH pg8::Gemm g{HB, (const bf16r*)(ws + W_D2), M, 1024, FF, FF, FF}; pg8::StaticOrder S; S.init(M, 1024, G, bx);
          pg8::EpiResid E{X, X, (l == 1 ? (bf16r*)nullptr : XB), SS + (size_t)((3 * l + 3) % 3) * M * 16, 0.5f};
          pg8::gemm_phase<pg8::EpiResid, pg8::StaticOrder, true, true>(ldsl, g, S, E); }
        GSYNC();
        if (l == STOP_L && STOP_P == 12) { fin_buf = 0; goto final_norm; }

    }
    final_norm:
    { PH
        const float* fg = TAB[31];
        for (int m = gw; m < M; m += NGW) { f32x4* xo = (f32x4*)(X + (size_t)m * 1024) + lane; const float r = pg8::rstd1024(SS + (size_t)fin_buf * M * 16, m);
#pragma unroll
            for (int j = 0; j < 4; ++j) { f32x4 v = xo[64 * j]; const f32x4 gq = ((const f32x4*)fg)[lane + 64 * j]; v = v * r * gq; xo[64 * j] = v; } }
    }
}

extern "C" void kernel_launch(void* const* d_in, const int* in_sizes, int n_in, void* d_out, int out_size, void* d_ws, size_t ws_size, hipStream_t stream) {
    static int grid = 0;
    if (grid == 0) {
        if (n_in != 32 || out_size != M * 1024 || ws_size < WS_NEED) { fprintf(stderr, "kernel_launch: unexpected sizes (n_in %d out %d ws %zu)\n", n_in, out_size, ws_size); grid = -1; return; }
        int dev = 0, cus = 0, per_cu = 0;
        hipGetDevice(&dev); hipDeviceGetAttribute(&cus, hipDeviceAttributeMultiprocessorCount, dev);
        hipFuncSetAttribute((const void*)fwd_kernel, hipFuncAttributeMaxDynamicSharedMemorySize, LDS_BYTES);
        hipOccupancyMaxActiveBlocksPerMultiprocessor(&per_cu, (const void*)fwd_kernel, NWAVES * 64, LDS_BYTES);
        if (per_cu < 1) per_cu = 1;
        grid = cus * per_cu; if (grid > 256) grid = 256;
        (void)hipGetLastError();
    }
    if (grid < 0) return;
    if (hipMemsetAsync((char*)d_ws + WS_BAR, 0, 16384, stream) != hipSuccess) { fprintf(stderr, "memset failed\n"); return; }
    Args a{};
    for (int i = 0; i < 32; ++i) a.in[i] = (const float*)d_in[i];
    a.out = (float*)d_out; a.ws = (unsigned char*)d_ws;
    void* kargs[] = {&a};
    hipError_t e = hipLaunchCooperativeKernel((const void*)fwd_kernel, dim3(grid), dim3(NWAVES * 64), kargs, LDS_BYTES, stream);
    if (e != hipSuccess) fprintf(stderr, "cooperative launch failed: %s (grid %d)\n", hipGetErrorString(e), grid);
}
```

```cpp
#include <hip/hip_runtime.h>
#include <hip/hip_cooperative_groups.h>
#include <hip/hip_bf16.h>
#include <cstdio>
#include <cstdint>
#include <cmath>
namespace cg = cooperative_groups;

namespace pg8 {
#define PG8_LAS __attribute__((address_space(3)))
typedef unsigned short bf16_t;
typedef short bf16x8 __attribute__((ext_vector_type(8)));
typedef float f32x4 __attribute__((ext_vector_type(4)));
typedef unsigned u32x4 __attribute__((ext_vector_type(4)));
constexpr int BM = 256, BK = 64, HALF = 128, HTB = HALF * BK * 2  , STAGE_BYTES = 8 * HTB, NXCD = 8, WGM = 8;

__host__ __device__ __forceinline__ int lds_byte(int r, int c) { const int st = (r >> 4) * 2 + (c >> 5), rr = r & 15, cc = c & 31, ob = rr * 64 + cc * 2; return st * 1024 + (ob ^ (((ob >> 9) & 1) << 5)); }
__host__ __device__ __forceinline__ void stage_rc(int b, int& R, int& C) { const int st = b / 1024, sb = b % 1024, swz = sb ^ (((sb >> 9) & 1) << 5); R = (st >> 1) * 16 + swz / 64; C = (st & 1) * 32 + (swz % 64) / 2; }
__host__ __device__ __forceinline__ int perm32(int rho) { const int n = rho >> 4, i = rho & 15; return 8 * (i >> 2) + 4 * n + (i & 3); }

struct Unit { int pm, pn, g; };

struct StaticOrder {
    int nM, nN, nwg, G, c;
    __host__ __device__ void init(int M, int N, int G_, int c_) { nM = M / BM; nN = N / BM; nwg = nM * nN; G = G_; c = c_; }
    __host__ __device__ bool next(int i, Unit& u) const {
        const long L = (long)i * G + c; if (L >= nwg) return false;
        int wgid = (int)L; { const int q = nwg / NXCD, r = nwg % NXCD, xcd = wgid % NXCD, off = wgid / NXCD; wgid = (xcd < r ? xcd * (q + 1) : r * (q + 1) + (xcd - r) * q) + off; }
        const int nig = WGM * nN, gid = wgid / nig, fm = gid * WGM, gsz = (nM - fm) < WGM ? (nM - fm) : WGM;
        u.pm = fm + ((wgid % nig) % gsz); u.pn = (wgid % nig) / gsz; u.g = 0; return true;
    }
    __device__ __forceinline__ void a_ready(const Unit&) const {}
    __device__ __forceinline__ void done(const Unit&) const {}
};

struct Gemm { const bf16_t* A; const bf16_t* Bt; int M, N, K, lda, ldb; size_t sA, sB; size_t aoff[3]; int useoff; };
#define PG8_ABASE(G_, U_) ((const char*)(G_).A + ((G_).useoff ? ((U_).g == 0 ? (G_).aoff[0] : ((U_).g == 1 ? (G_).aoff[1] : (G_).aoff[2])) : (size_t)(U_).g * (G_).sA))
__device__ __forceinline__ unsigned cvt_pk_bf16(float lo, float hi) { unsigned r; asm volatile("v_cvt_pk_bf16_f32 %0, %1, %2" : "=v"(r) : "v"(lo), "v"(hi)); return r; }
__device__ __forceinline__ float bflo(unsigned w) { return __builtin_bit_cast(float, w << 16); }
__device__ __forceinline__ float bfhi(unsigned w) { return __builtin_bit_cast(float, w & 0xffff0000u); }
__device__ __forceinline__ float rstd1024(const float* ss, int row) { const f32x4* p = (const f32x4*)(ss + (size_t)row * 16); const f32x4 a = p[0], b = p[1], c = p[2], d = p[3];
    const float t = ((a[0] + a[1]) + (a[2] + a[3])) + ((b[0] + b[1]) + (b[2] + b[3])) + ((c[0] + c[1]) + (c[2] + c[3])) + ((d[0] + d[1]) + (d[2] + d[3])); return rsqrtf(t * (1.0f / 1024.0f) + 1e-6f); }
__device__ __forceinline__ float sigmoidf_(float x) { return __builtin_amdgcn_rcpf(1.0f + __expf(-x)); }
__device__ __forceinline__ u32x4 pack8(f32x4 a, f32x4 b) { u32x4 w; w.x = cvt_pk_bf16(a[0], a[1]); w.y = cvt_pk_bf16(a[2], a[3]); w.z = cvt_pk_bf16(b[0], b[1]); w.w = cvt_pk_bf16(b[2], b[3]); return w; }
__device__ __forceinline__ void unpack8(u32x4 w, f32x4& a, f32x4& b) { a = (f32x4){bflo(w.x), bfhi(w.x), bflo(w.y), bfhi(w.y)}; b = (f32x4){bflo(w.z), bfhi(w.z), bflo(w.w), bfhi(w.w)}; }

struct EpiSwiGLU {
    static constexpr bool PERM = true, AFTER_DRAIN = false;
    bf16_t* H; const float* ss; int ldh;
    __device__ __forceinline__ void operator()(const f32x4 (&acc)[2][2][4][2], const Unit& u, int wr, int wc, int fr, int fq) const {
        const int row0 = u.pm * BM + wr * 64 + fr, col0 = u.pn * 128 + wc * 32 + 8 * fq;
#pragma unroll
        for (int ai = 0; ai < 2; ++ai)
#pragma unroll
            for (int m = 0; m < 4; ++m) { const int row = row0 + ai * HALF + m * 16; const float r = rstd1024(ss, row);
                f32x4 o[2];
#pragma unroll
                for (int n = 0; n < 2; ++n)
#pragma unroll
                    for (int j = 0; j < 4; ++j) { const float g = acc[ai][0][m][n][j] * r, up = acc[ai][1][m][n][j] * r; o[n][j] = g * sigmoidf_(g) * up; }
                *(u32x4*)(H + (size_t)row * ldh + col0) = pack8(o[0], o[1]); }
    }
};
struct EpiResid {
    static constexpr bool PERM = true, AFTER_DRAIN = false;
    const float* Xin; float* X; bf16_t* XB; float* ssn; float scale;
    __device__ __forceinline__ void operator()(const f32x4 (&acc)[2][2][4][2], const Unit& u, int wr, int wc, int fr, int fq) const {
        const int row0 = u.pm * BM + wr * 64 + fr, col0 = u.pn * BM + wc * 32 + 8 * fq;
#pragma unroll
        for (int ai = 0; ai < 2; ++ai)
#pragma unroll
            for (int m = 0; m < 4; ++m) { const int row = row0 + ai * HALF + m * 16; float part = 0.f;
#pragma unroll
                for (int bj = 0; bj < 2; ++bj) { float* xp = X + (size_t)row * 1024 + col0 + bj * HALF; const float* xi = Xin + (size_t)row * 1024 + col0 + bj * HALF;
                    f32x4 x0 = *(const f32x4*)xi, x1 = *(const f32x4*)(xi + 4);
                    x0 = x0 + acc[ai][bj][m][0] * scale; x1 = x1 + acc[ai][bj][m][1] * scale;
                    *(f32x4*)xp = x0; *(f32x4*)(xp + 4) = x1;
                    if (XB) *(u32x4*)(XB + (size_t)row * 1024 + col0 + bj * HALF) = pack8(x0, x1);
                    part += (x0[0] * x0[0] + x0[1] * x0[1]) + (x0[2] * x0[2] + x0[3] * x0[3]) + (x1[0] * x1[0] + x1[1] * x1[1]) + (x1[2] * x1[2] + x1[3] * x1[3]); }
                part += __shfl_xor(part, 16); part += __shfl_xor(part, 32);
                if (fq == 0) ssn[(size_t)row * 16 + u.pn * 4 + wc] = part; }
    }
};
struct EpiScaleBf16 {
    static constexpr bool PERM = true, AFTER_DRAIN = false;
    bf16_t* O; int ldo; const float* ss;
    __device__ __forceinline__ void operator()(const f32x4 (&acc)[2][2][4][2], const Unit& u, int wr, int wc, int fr, int fq) const {
        const int row0 = u.pm * BM + wr * 64 + fr, col0 = u.pn * BM + wc * 32 + 8 * fq;
#pragma unroll
        for (int ai = 0; ai < 2; ++ai)
#pragma unroll
            for (int m = 0; m < 4; ++m) { const int row = row0 + ai * HALF + m * 16; const float r = rstd1024(ss, row);
#pragma unroll
                for (int bj = 0; bj < 2; ++bj) *(u32x4*)(O + (size_t)row * ldo + col0 + bj * HALF) = pack8(acc[ai][bj][m][0] * r, acc[ai][bj][m][1] * r); }
    }
};
struct EpiGlu {
    static constexpr bool PERM = true, AFTER_DRAIN = false;
    const bf16_t* YG; int ldg; bf16_t* Y; int ldy;
    __device__ __forceinline__ void operator()(const f32x4 (&acc)[2][2][4][2], const Unit& u, int wr, int wc, int fr, int fq) const {
        const int row0 = u.pm * BM + wr * 64 + fr, col0 = u.pn * BM + wc * 32 + 8 * fq;
#pragma unroll
        for (int ai = 0; ai < 2; ++ai)
#pragma unroll
            for (int m = 0; m < 4; ++m) { const int row = row0 + ai * HALF + m * 16;
#pragma unroll
                for (int bj = 0; bj < 2; ++bj) { const int col = col0 + bj * HALF; f32x4 y0, y1; unpack8(*(const u32x4*)(YG + (size_t)row * ldg + col), y0, y1);
#pragma unroll
                    for (int j = 0; j < 4; ++j) { y0[j] *= sigmoidf_(acc[ai][bj][m][0][j]); y1[j] *= sigmoidf_(acc[ai][bj][m][1][j]); }
                    *(u32x4*)(Y + (size_t)row * ldy + col) = pack8(y0, y1); } }
    }
};
struct EpiGate {
    static constexpr bool PERM = true, AFTER_DRAIN = false;
    bf16_t* G; const float* bias; const float* ss;
    __device__ __forceinline__ void operator()(const f32x4 (&acc)[2][2][4][2], const Unit& u, int wr, int wc, int fr, int fq) const {
        const int row0 = u.pm * BM + wr * 64 + fr, col0 = u.pn * BM + wc * 32 + 8 * fq;
#pragma unroll
        for (int ai = 0; ai < 2; ++ai)
#pragma unroll
            for (int m = 0; m < 4; ++m) { const int row = row0 + ai * HALF + m * 16; const float r = rstd1024(ss, row);
#pragma unroll
                for (int bj = 0; bj < 2; ++bj) { const int col = col0 + bj * HALF; const f32x4 b0 = *(const f32x4*)(bias + col), b1 = *(const f32x4*)(bias + col + 4); f32x4 g0, g1;
#pragma unroll
                    for (int j = 0; j < 4; ++j) { g0[j] = sigmoidf_(acc[ai][bj][m][0][j] * r + b0[j]); g1[j] = sigmoidf_(acc[ai][bj][m][1][j] * r + b1[j]); }
                    *(u32x4*)(G + (size_t)row * 1024 + col) = pack8(g0, g1); } }
    }
};
template <int MODE> struct EpiMerge {
    static constexpr bool PERM = true, AFTER_DRAIN = false;
    bf16_t* G; float* MG;
    __device__ __forceinline__ void operator()(const f32x4 (&acc)[2][2][4][2], const Unit& u, int wr, int wc, int fr, int fq) const {
        const int row0 = u.pm * BM + wr * 64 + fr, col0 = u.pn * BM + wc * 32 + 8 * fq;
#pragma unroll
        for (int ai = 0; ai < 2; ++ai)
#pragma unroll
            for (int m = 0; m < 4; ++m) { const int row = row0 + ai * HALF + m * 16;
#pragma unroll
                for (int bj = 0; bj < 2; ++bj) { const size_t off = (size_t)row * 1024 + col0 + bj * HALF; f32x4 g0, g1; unpack8(*(const u32x4*)(G + off), g0, g1);
                    f32x4 v0 = g0 * acc[ai][bj][m][0], v1 = g1 * acc[ai][bj][m][1];
                    if (MODE != 0) { v0 = v0 + *(const f32x4*)(MG + off); v1 = v1 + *(const f32x4*)(MG + off + 4); }
                    if (MODE != 2) { *(f32x4*)(MG + off) = v0; *(f32x4*)(MG + off + 4) = v1; }
                    else *(u32x4*)(G + off) = pack8(v0, v1); } }
    }
};

struct BatchOrder {
    int nM, nN, per, total, G, c;
    __device__ void init(int nM_, int nN_, int nb, int G_, int c_) { nM = nM_; nN = nN_; per = nM_ * nN_; total = per * nb; G = G_; c = c_; }
    __device__ bool next(int i, Unit& u) const { const int L = i * G + c; if (L >= total) return false; u.g = L / per; const int r = L % per; u.pm = r / nN; u.pn = r % nN; return true; }
    __device__ __forceinline__ void a_ready(const Unit&) const {}
    __device__ __forceinline__ void done(const Unit&) const {}
};
struct TileBatchOrder {
    StaticOrder so; int nb;
    __device__ void init(int M, int N, int nb_, int G_, int c_) { so.init(M, N, G_, c_); nb = nb_; }
    __device__ bool next(int i, Unit& u) const { if (!so.next(i / nb, u)) return false; u.g = i % nb; return true; }
    __device__ __forceinline__ void a_ready(const Unit&) const {}
    __device__ __forceinline__ void done(const Unit&) const {}
};
struct EpiGate3 {
    static constexpr bool PERM = true, AFTER_DRAIN = false;
    bf16_t* G3; const float* bias; const float* ss;
    __device__ __forceinline__ void operator()(const f32x4 (&acc)[2][2][4][2], const Unit& u, int wr, int wc, int fr, int fq) const {
        const int row0 = u.pm * BM + wr * 64 + fr, col0 = u.pn * BM + wc * 32 + 8 * fq;
        bf16_t* Gb = G3 + (size_t)u.g * 16384 * 1024; const float* bb = bias + u.g * 1024;
#pragma unroll
        for (int ai = 0; ai < 2; ++ai)
#pragma unroll
            for (int m = 0; m < 4; ++m) { const int row = row0 + ai * HALF + m * 16; const float r = rstd1024(ss, row);
#pragma unroll
                for (int bj = 0; bj < 2; ++bj) { const int col = col0 + bj * HALF; const f32x4 b0 = *(const f32x4*)(bb + col), b1 = *(const f32x4*)(bb + col + 4); f32x4 g0, g1;
#pragma unroll
                    for (int j = 0; j < 4; ++j) { g0[j] = sigmoidf_(acc[ai][bj][m][0][j] * r + b0[j]); g1[j] = sigmoidf_(acc[ai][bj][m][1][j] * r + b1[j]); }
                    *(u32x4*)(Gb + (size_t)row * 1024 + col) = pack8(g0, g1); } }
    }
};
struct EpiMerge3 {
    static constexpr bool PERM = true, AFTER_DRAIN = false;
    bf16_t* G3; bf16_t* MG;
    __device__ __forceinline__ void operator()(const f32x4 (&acc)[2][2][4][2], const Unit& u, int wr, int wc, int fr, int fq) const {
        const int row0 = u.pm * BM + wr * 64 + fr, col0 = u.pn * BM + wc * 32 + 8 * fq;
        const bf16_t* Gb = G3 + (size_t)u.g * 16384 * 1024;
#pragma unroll
        for (int ai = 0; ai < 2; ++ai)
#pragma unroll
            for (int m = 0; m < 4; ++m) { const int row = row0 + ai * HALF + m * 16;
#pragma unroll
                for (int bj = 0; bj < 2; ++bj) { const size_t off = (size_t)row * 1024 + col0 + bj * HALF; f32x4 g0, g1; unpack8(*(const u32x4*)(Gb + off), g0, g1);
                    f32x4 v0 = g0 * acc[ai][bj][m][0], v1 = g1 * acc[ai][bj][m][1];
                    if (u.g != 0) { f32x4 m0, m1; unpack8(*(const u32x4*)(MG + off), m0, m1); v0 = v0 + m0; v1 = v1 + m1; }
                    if (u.g != 2) *(u32x4*)(MG + off) = pack8(v0, v1); else *(u32x4*)(G3 + off) = pack8(v0, v1); } }
    }
};
struct EpiInSplit {
    static constexpr bool PERM = true, AFTER_DRAIN = false;
    bf16_t* O; int ldo; bf16_t* UG; const float* ss;
    __device__ __forceinline__ void operator()(const f32x4 (&acc)[2][2][4][2], const Unit& u, int wr, int wc, int fr, int fq) const {
        const int row0 = u.pm * BM + wr * 64 + fr;
#pragma unroll
        for (int ai = 0; ai < 2; ++ai)
#pragma unroll
            for (int m = 0; m < 4; ++m) { const int row = row0 + ai * HALF + m * 16; const float r = rstd1024(ss, row);
#pragma unroll
                for (int bj = 0; bj < 2; ++bj) { const u32x4 w = pack8(acc[ai][bj][m][0] * r, acc[ai][bj][m][1] * r);
                    if (u.pn < 2) { const int cidx = u.pn * BM + bj * HALF + wc * 32 + 8 * fq, gg = cidx >> 4, h0 = cidx & 15, b = row >> 12, tt = row & 4095;
                        *(u32x4*)(UG + ((size_t)(gg * 512 + b * 128 + (tt >> 5)) * 768 + 256 + (tt & 31) * 16 + h0)) = w; }
                    else *(u32x4*)(O + (size_t)row * ldo + (u.pn - 2) * BM + bj * HALF + wc * 32 + 8 * fq) = w; } }
    }
};
struct EpiF32B {
    static constexpr bool PERM = true, AFTER_DRAIN = false;
    float* C; int ldc; size_t sC;
    __device__ __forceinline__ void operator()(const f32x4 (&acc)[2][2][4][2], const Unit& u, int wr, int wc, int fr, int fq) const {
        const int row0 = u.pm * BM + wr * 64 + fr, col0 = u.pn * BM + wc * 32 + 8 * fq;
#pragma unroll
        for (int ai = 0; ai < 2; ++ai)
#pragma unroll
            for (int m = 0; m < 4; ++m) { const int row = row0 + ai * HALF + m * 16;
#pragma unroll
                for (int bj = 0; bj < 2; ++bj) { float* p = C + (size_t)u.g * sC + (size_t)row * ldc + col0 + bj * HALF; *(f32x4*)p = acc[ai][bj][m][0]; *(f32x4*)(p + 4) = acc[ai][bj][m][1]; } }
    }
};
__device__ __forceinline__ float gelu_tanh_(float x) { const float z = 0.7978845608028654f * (x + 0.044715f * x * x * x); const float tt = 1.0f - 2.0f * __builtin_amdgcn_rcpf(__expf(2.0f * z) + 1.0f); return 0.5f * x * (1.0f + tt); }
struct EpiS5Y {
    static constexpr bool PERM = true, AFTER_DRAIN = false;
    bf16_t* YG;
    __device__ __forceinline__ void operator()(const f32x4 (&acc)[2][2][4][2], const Unit& u, int wr, int wc, int fr, int fq) const {
        const int row0 = u.pm * BM + wr * 64 + fr, col0 = u.pn * BM + wc * 32 + 8 * fq;
#pragma unroll
        for (int ai = 0; ai < 2; ++ai)
#pragma unroll
            for (int m = 0; m < 4; ++m) { const int r = row0 + ai * HALF + m * 16, b = r >> 7, c = r & 127;
#pragma unroll
                for (int bj = 0; bj < 2; ++bj) { const int n = col0 + bj * HALF, i = n >> 4, h0 = n & 15; f32x4 y0, y1;
#pragma unroll
                    for (int j = 0; j < 4; ++j) { y0[j] = gelu_tanh_(acc[ai][bj][m][0][j]); y1[j] = gelu_tanh_(acc[ai][bj][m][1][j]); }
                    *(u32x4*)(YG + (size_t)(b * 4096 + 32 * c + i) * 512 + 16 * u.g + h0) = pack8(y0, y1); } }
    }
};
template <class Epi, class Sched, bool ALIGN_EPI = false, bool SP2 = false>
__device__ __forceinline__ void gemm_phase(PG8_LAS unsigned char* lds, const Gemm g, const Sched& S, const Epi& E) {
    int tid_o = threadIdx.x; asm volatile("" : "+v"(tid_o));
    const int tid = tid_o, wid = __builtin_amdgcn_readfirstlane(tid >> 6), lane = tid & 63, wr = wid >> 2, wc = wid & 3, fr = lane & 15, fq = lane >> 4;
    const int K = g.K, nt = K / BK;
    unsigned voffA[2], voffB[2];
#pragma unroll
    for (int i = 0; i < 2; ++i) { int R, C; stage_rc(tid * 16 + i * 8192, R, C); const int Rb = Epi::PERM ? ((R & ~31) + perm32(R & 31)) : R;
        voffA[i] = (unsigned)(R * g.lda + C) * 2u; voffB[i] = (unsigned)(Rb * g.ldb + C) * 2u; }
    const size_t kstep = (size_t)(BK * 2);
    const size_t hstepA = (size_t)HALF * g.lda * 2, hstepB = (size_t)HALF * g.ldb * 2;
    const size_t tstepA = 2 * hstepA, tstepB = 2 * hstepB;
    const unsigned ldsw = (unsigned)wid * 1024u;
    const int aoff = lds_byte(wr * 64 + fr, fq * 8), boff = lds_byte(wc * 32 + fr, fq * 8);
#define PG8_SA(b, h) (((b) * 2 + (h)) * HTB)
#define PG8_SB(b, h) ((4 + (b) * 2 + (h)) * HTB)
#define PG8_STAGE(bufoff, gbase, voff) do { _Pragma("unroll") for (int _i = 0; _i < 2; ++_i) \
        __builtin_amdgcn_global_load_lds((const unsigned*)((const char*)(gbase) + (voff)[_i]), (PG8_LAS unsigned*)(lds + (bufoff) + ldsw + _i * 8192), 16, 0, 0); } while (0)
#define PG8_LDA(dst, b, h) do { _Pragma("unroll") for (int m = 0; m < 4; ++m) _Pragma("unroll") for (int k = 0; k < 2; ++k) dst[m][k] = *(const PG8_LAS bf16x8*)(lds + PG8_SA(b, h) + aoff + m * 2048 + k * 1024); } while (0)
#define PG8_LDB(dst, b, h) do { _Pragma("unroll") for (int n = 0; n < 2; ++n) _Pragma("unroll") for (int k = 0; k < 2; ++k) dst[n][k] = *(const PG8_LAS bf16x8*)(lds + PG8_SB(b, h) + boff + n * 2048 + k * 1024); } while (0)
#define PG8_MMA(ai, bj, At, Bt) do { __builtin_amdgcn_s_setprio(1); _Pragma("unroll") for (int m = 0; m < 4; ++m) _Pragma("unroll") for (int n = 0; n < 2; ++n) _Pragma("unroll") for (int k = 0; k < 2; ++k) \
        acc[ai][bj][m][n] = __builtin_amdgcn_mfma_f32_16x16x32_bf16(Bt[n][k], At[m][k], acc[ai][bj][m][n], 0, 0, 0); __builtin_amdgcn_s_setprio(0); } while (0)
#define PG8_WAIT_V(n) asm volatile("s_waitcnt vmcnt(" #n ")" ::: "memory")
#define PG8_WAIT_L(n) asm volatile("s_waitcnt lgkmcnt(" #n ")" ::: "memory")
#define PG8_BAR __builtin_amdgcn_s_barrier()
#define PG8_SCHED __builtin_amdgcn_sched_barrier(0)
    Unit cur, nxt; int ui = 0;
    if (!S.next(0, cur)) return;
    f32x4 acc[2][2][4][2];
#pragma unroll
    for (int a = 0; a < 2; ++a)
#pragma unroll
        for (int b = 0; b < 2; ++b)
#pragma unroll
            for (int m = 0; m < 4; ++m)
#pragma unroll
                for (int n = 0; n < 2; ++n) acc[a][b][m][n] = (f32x4){0.f, 0.f, 0.f, 0.f};
    bf16x8 At[4][2], B0[2][2], B1[2][2];
    const char* cA = PG8_ABASE(g, cur) + (size_t)cur.pm * tstepA; const char* cB = (const char*)g.Bt + (size_t)cur.g * g.sB + (size_t)cur.pn * tstepB;
    S.a_ready(cur);
    if constexpr (SP2) {
        PG8_STAGE(PG8_SB(0, 0), cB, voffB); PG8_STAGE(PG8_SB(0, 1), cB + hstepB, voffB); PG8_STAGE(PG8_SA(0, 0), cA, voffA); PG8_STAGE(PG8_SA(0, 1), cA + hstepA, voffA);
        if (wr == 1) PG8_BAR;
        PG8_WAIT_V(2); PG8_BAR;
        PG8_STAGE(PG8_SB(1, 0), cB + kstep, voffB); PG8_STAGE(PG8_SA(1, 0), cA + kstep, voffA); PG8_STAGE(PG8_SB(1, 1), cB + hstepB + kstep, voffB);
        PG8_WAIT_V(6); PG8_BAR;
    } else {
        PG8_STAGE(PG8_SB(0, 0), cB, voffB); PG8_STAGE(PG8_SA(0, 0), cA, voffA); PG8_STAGE(PG8_SB(0, 1), cB + hstepB, voffB); PG8_STAGE(PG8_SA(0, 1), cA + hstepA, voffA);
        if (wr == 1) PG8_BAR;
        PG8_WAIT_V(4); PG8_BAR;
        PG8_STAGE(PG8_SB(1, 0), cB + kstep, voffB); PG8_STAGE(PG8_SA(1, 0), cA + kstep, voffA); PG8_STAGE(PG8_SB(1, 1), cB + hstepB + kstep, voffB);
        PG8_WAIT_V(6); PG8_BAR;
    }
    for (;;) {
        const bool has_next = S.next(ui + 1, nxt);
        const char* nA = has_next ? PG8_ABASE(g, nxt) + (size_t)nxt.pm * tstepA : cA; const char* nB = has_next ? (const char*)g.Bt + (size_t)nxt.g * g.sB + (size_t)nxt.pn * tstepB : cB;
        for (int t = 0; t < nt; t += 2) {
            const bool last = (t == nt - 2);
            const char* a1 = cA + (size_t)(t + 1) * kstep;
            const char* a2 = last ? nA : cA + (size_t)(t + 2) * kstep; const char* b2 = last ? nB : cB + (size_t)(t + 2) * kstep;
            const char* a3 = a2 + kstep; const char* b3 = b2 + kstep;
            if (last && has_next) S.a_ready(nxt);
            if constexpr (SP2) {
            PG8_LDB(B0, 0, 0); PG8_LDB(B1, 0, 1); PG8_SCHED; PG8_LDA(At, 0, 0); PG8_STAGE(PG8_SA(1, 1), a1 + hstepA, voffA);
            PG8_WAIT_V(8); PG8_WAIT_L(0); PG8_BAR; PG8_MMA(0, 0, At, B0); PG8_MMA(0, 1, At, B1); PG8_BAR; PG8_SCHED;
            PG8_LDA(At, 0, 1); PG8_STAGE(PG8_SB(0, 0), b2, voffB); PG8_STAGE(PG8_SB(0, 1), b2 + hstepB, voffB); PG8_STAGE(PG8_SA(0, 0), a2, voffA);
            PG8_WAIT_V(8); PG8_WAIT_L(0); PG8_BAR; PG8_MMA(1, 0, At, B0); PG8_MMA(1, 1, At, B1); PG8_BAR; PG8_SCHED;
            PG8_LDB(B0, 1, 0); PG8_LDB(B1, 1, 1); PG8_SCHED; PG8_LDA(At, 1, 0); PG8_STAGE(PG8_SA(0, 1), a2 + hstepA, voffA);
            PG8_WAIT_V(8); PG8_WAIT_L(0); PG8_BAR; PG8_MMA(0, 0, At, B0); PG8_MMA(0, 1, At, B1); PG8_BAR; PG8_SCHED;
            PG8_LDA(At, 1, 1); PG8_STAGE(PG8_SB(1, 0), b3, voffB); PG8_STAGE(PG8_SB(1, 1), b3 + hstepB, voffB); PG8_STAGE(PG8_SA(1, 0), a3, voffA);
            PG8_WAIT_V(8); PG8_WAIT_L(0); PG8_BAR; PG8_MMA(1, 0, At, B0); PG8_MMA(1, 1, At, B1); PG8_BAR; PG8_SCHED;
            } else {
            PG8_LDB(B0, 0, 0); PG8_SCHED; PG8_LDA(At, 0, 0); PG8_STAGE(PG8_SA(1, 1), a1 + hstepA, voffA);
            PG8_WAIT_L(8); PG8_BAR; PG8_WAIT_L(0); PG8_MMA(0, 0, At, B0); PG8_BAR; PG8_SCHED;
            PG8_LDB(B1, 0, 1); PG8_STAGE(PG8_SB(0, 0), b2, voffB);
            PG8_BAR; PG8_WAIT_L(0); PG8_MMA(0, 1, At, B1); PG8_BAR;
            PG8_LDA(At, 0, 1); PG8_STAGE(PG8_SA(0, 0), a2, voffA);
            PG8_BAR; PG8_WAIT_L(0); PG8_MMA(1, 0, At, B0); PG8_BAR; PG8_SCHED;
            PG8_STAGE(PG8_SB(0, 1), b2 + hstepB, voffB);
            PG8_WAIT_V(6); PG8_BAR; PG8_MMA(1, 1, At, B1); PG8_BAR;
            PG8_LDB(B0, 1, 0); PG8_SCHED; PG8_LDA(At, 1, 0); PG8_STAGE(PG8_SA(0, 1), a2 + hstepA, voffA);
            PG8_WAIT_L(8); PG8_BAR; PG8_WAIT_L(0); PG8_MMA(0, 0, At, B0); PG8_BAR; PG8_SCHED;
            PG8_LDB(B1, 1, 1); PG8_STAGE(PG8_SB(1, 0), b3, voffB);
            PG8_BAR; PG8_WAIT_L(0); PG8_MMA(0, 1, At, B1); PG8_BAR;
            PG8_LDA(At, 1, 1); PG8_STAGE(PG8_SA(1, 0), a3, voffA);
            PG8_BAR; PG8_WAIT_L(0); PG8_MMA(1, 0, At, B0); PG8_BAR; PG8_SCHED;
            PG8_STAGE(PG8_SB(1, 1), b3 + hstepB, voffB);
            PG8_WAIT_V(6); PG8_BAR; PG8_MMA(1, 1, At, B1); PG8_BAR;
            }
        }
        if constexpr (ALIGN_EPI) { if (wr == 0) PG8_BAR; }
        if constexpr (!Epi::AFTER_DRAIN) { E(acc, cur, wr, wc, fr, fq); S.done(cur); }
        if (!has_next) break;
#pragma unroll
        for (int a = 0; a < 2; ++a)
#pragma unroll
            for (int b = 0; b < 2; ++b)
#pragma unroll
                for (int m = 0; m < 4; ++m)
#pragma unroll
                    for (int n = 0; n < 2; ++n) acc[a][b][m][n] = (f32x4){0.f, 0.f, 0.f, 0.f};
        cur = nxt; cA = nA; cB = nB; ++ui;
        if constexpr (ALIGN_EPI) { if (wr == 1) PG8_BAR; }
    }
    PG8_WAIT_V(0);
    if constexpr (!ALIGN_EPI) { if (wr == 0) PG8_BAR; }
    PG8_BAR;
    if constexpr (Epi::AFTER_DRAIN) { E.fused(acc, cur, wr, wc, fr, fq, lds, wid, lane); S.done(cur); }
#undef PG8_SA
#undef PG8_SB
#undef PG8_STAGE
#undef PG8_LDA
#undef PG8_LDB
#undef PG8_MMA
#undef PG8_WAIT_V
#undef PG8_WAIT_L
#undef PG8_BAR
#undef PG8_SCHED
}
}
#include <hip/hip_bf16.h>
namespace attn_body {
using bf16=__hip_bfloat16;
using bf16x8=__attribute__((ext_vector_type(8)))short;
using s16x4=__attribute__((ext_vector_type(4)))short;
using f32x16=__attribute__((ext_vector_type(16)))float;
using u32x4=__attribute__((ext_vector_type(4)))unsigned;
constexpr int BATCH=4,NHEAD=8,NKV=2,SEQ=4096,D=64,DM=3072,DMO=512;
constexpr int NW=8,QBLK=32,QB=QBLK*NW,KVBLK=64,NQB=SEQ/QB;
constexpr int ATTN_PITCH=DM, ATTN_UNIT_ROWS=QB;
__device__ __forceinline__ int crow(int r,int hi){return (r&3)+8*(r>>2)+4*hi;}
#define SBAR() __builtin_amdgcn_sched_barrier(0)
__device__ __forceinline__ void cmask(f32x16&p0,f32x16&p1,int jb,int qrel,int hi){
  const float NEG=-INFINITY; int kb=64*jb+4*hi;
  #pragma unroll
  for(int r=0;r<16;++r){int kv=kb+(r&3)+8*(r>>2); if(kv>qrel)p0[r]=NEG; if(kv+32>qrel)p1[r]=NEG;}
}

constexpr int NSLOT=3, SLOTB=8192;
constexpr int LDS_K=0, LDS_V=NSLOT*SLOTB, LDS_WS=2*NSLOT*SLOTB, LDS_OST=LDS_WS+NW*64*4, LDS_BYTES=LDS_OST+NW*4096;
constexpr float C2=0.125f*1.4426950408889634f;
__device__ __forceinline__ void glds16(const void*gsrc,unsigned lds_dst){unsigned keep;
  asm volatile("s_mov_b32 %0, m0\n\ts_mov_b32 m0, %2\n\ts_nop 0\n\tglobal_load_lds_dwordx4 %1, off\n\ts_mov_b32 m0, %0":"=&s"(keep):"v"(gsrc),"s"(lds_dst):"memory");}
__device__ __forceinline__ float max3f(float a,float b,float c){float r;asm("v_max3_f32 %0, %1, %2, %3":"=v"(r):"v"(a),"v"(b),"v"(c));return r;}
__device__ __forceinline__ float max2f(float a,float b){float r;asm("v_max_f32_e32 %0, %1, %2":"=v"(r):"v"(a),"v"(b));return r;}
__device__ __forceinline__ float fadd_s(float a,float b){float r;asm("v_add_f32_e32 %0, %1, %2":"=v"(r):"v"(a),"v"(b));return r;}
__device__ __forceinline__ float fsub_s(float a,float b){float r;asm("v_sub_f32_e32 %0, %1, %2":"=v"(r):"v"(a),"v"(b));return r;}
typedef float f32x2_t __attribute__((ext_vector_type(2))); typedef __bf16 bf16x2_t __attribute__((ext_vector_type(2)));
__device__ __forceinline__ unsigned cvtpk_s(float lo,float hi){f32x2_t v={lo,hi};bf16x2_t b=__builtin_convertvector(v,bf16x2_t);return __builtin_bit_cast(unsigned,b);}
#define WAIT_BAR(N) asm volatile("s_waitcnt vmcnt(" #N ") lgkmcnt(0)\n\ts_barrier":::"memory")

__device__ __forceinline__ void qkt(f32x16&p0,f32x16&p1,const char*Kslot,const bf16x8*qr,const f32x16&negm,int r32,int hi){
  const char*kb=Kslot+hi*1024+r32*16;
  #pragma unroll
  for(int d0=0;d0<4;++d0){
    const bf16x8 b0=*reinterpret_cast<const bf16x8*>(kb+d0*2048);
    const bf16x8 b1=*reinterpret_cast<const bf16x8*>(kb+d0*2048+512);
    if(d0==0){p0=__builtin_amdgcn_mfma_f32_32x32x16_bf16(b0,qr[0],negm,0,0,0);p1=__builtin_amdgcn_mfma_f32_32x32x16_bf16(b1,qr[0],negm,0,0,0);}
    else{p0=__builtin_amdgcn_mfma_f32_32x32x16_bf16(b0,qr[d0],p0,0,0,0);p1=__builtin_amdgcn_mfma_f32_32x32x16_bf16(b1,qr[d0],p1,0,0,0);}}
}
typedef __attribute__((address_space(3))) const char* lds_cptr;
typedef short v4i16_t __attribute__((ext_vector_type(4)));
__device__ __forceinline__ void kload8(bf16x8*kf,lds_cptr kp){
  kf[0]=*(const __attribute__((address_space(3))) bf16x8*)(kp);      kf[1]=*(const __attribute__((address_space(3))) bf16x8*)(kp+512);
  kf[2]=*(const __attribute__((address_space(3))) bf16x8*)(kp+2048); kf[3]=*(const __attribute__((address_space(3))) bf16x8*)(kp+2560);
  kf[4]=*(const __attribute__((address_space(3))) bf16x8*)(kp+4096); kf[5]=*(const __attribute__((address_space(3))) bf16x8*)(kp+4608);
  kf[6]=*(const __attribute__((address_space(3))) bf16x8*)(kp+6144); kf[7]=*(const __attribute__((address_space(3))) bf16x8*)(kp+6656);
}
__device__ __forceinline__ void kload2(bf16x8*kf,lds_cptr kp,int j){ kf[2*j]=*(const __attribute__((address_space(3))) bf16x8*)(kp+j*2048); kf[2*j+1]=*(const __attribute__((address_space(3))) bf16x8*)(kp+j*2048+512); }
__device__ __forceinline__ s16x4 vtr(lds_cptr p){ return __builtin_bit_cast(s16x4,__builtin_amdgcn_ds_read_tr16_b64_v4i16((__attribute__((address_space(3))) v4i16_t*)p)); }
__device__ __forceinline__ float rowmax(const f32x16&p0,const f32x16&p1){
  float a=max3f(p0[0],p0[1],p1[0]),b=max3f(p0[2],p0[3],p1[1]);a=max3f(a,p1[2],p1[3]);
  #pragma unroll
  for(int r=4;r<16;r+=4){a=max3f(a,p0[r],p0[r+1]);b=max3f(b,p0[r+2],p0[r+3]);a=max3f(a,p1[r],p1[r+1]);b=max3f(b,p1[r+2],p1[r+3]);}
  const float m=max2f(a,b);
  auto rr=__builtin_amdgcn_permlane32_swap(__float_as_uint(m),__float_as_uint(m),false,false);
  return max2f(__uint_as_float(rr[0]),__uint_as_float(rr[1]));
}
__device__ __forceinline__ void pv(f32x16*o,int vb,bf16x8 pa0,bf16x8 pa1,bf16x8 pa2,bf16x8 pa3){
  #pragma unroll
  for(int d0=0;d0<2;++d0){s16x4 lo[4],hi[4];
    #pragma unroll
    for(int ks=0;ks<4;++ks){
      asm volatile("ds_read_b64_tr_b16 %0,%1 offset:%c2":"=&v"(lo[ks]):"v"(vb),"i"(d0*4096+ks*1024):"memory");
      asm volatile("ds_read_b64_tr_b16 %0,%1 offset:%c2":"=&v"(hi[ks]):"v"(vb),"i"(d0*4096+ks*1024+512):"memory");}
    asm volatile("s_waitcnt lgkmcnt(0)":::"memory");SBAR();
    #define PK(k) (bf16x8){lo[k][0],lo[k][1],lo[k][2],lo[k][3],hi[k][0],hi[k][1],hi[k][2],hi[k][3]}
    o[d0]=__builtin_amdgcn_mfma_f32_32x32x16_bf16(pa0,PK(0),o[d0],0,0,0);
    o[d0]=__builtin_amdgcn_mfma_f32_32x32x16_bf16(pa1,PK(1),o[d0],0,0,0);
    o[d0]=__builtin_amdgcn_mfma_f32_32x32x16_bf16(pa2,PK(2),o[d0],0,0,0);
    o[d0]=__builtin_amdgcn_mfma_f32_32x32x16_bf16(pa3,PK(3),o[d0],0,0,0);
    #undef PK
  }
}

#ifndef ATTN_STORE16
#define ATTN_STORE16(p,v) (*(u32x4*)(p)=(v))
#endif
template<int THRL> __device__ __forceinline__ void attn_unit(int b,int h,int qb,const bf16*Q,const bf16*__restrict__ K,const bf16*__restrict__ V,bf16*O,char*shm){
  int tid_o=threadIdx.x; asm volatile("":"+v"(tid_o)); const int tid=tid_o,lane=tid&63,r32=lane&31,hi=lane>>5; const int wid=__builtin_amdgcn_readfirstlane(tid>>6);
  const long rowbase=(long)b*SEQ; const int q0=qb*QB;
  const bf16*Qw=Q+(rowbase+q0+wid*QBLK)*DM+h*D;
  const bf16*Kh=K+rowbase*DM+(h>>2)*D,*Vh=V+rowbase*DM+(h>>2)*D;
  const unsigned lds0=(unsigned)(uintptr_t)shm;
  float*wsf=(float*)(shm+LDS_WS)+wid*64;
  const bf16*ksrc=Kh+(long)lane*DM+wid*8;
  const bf16*vsrc=Vh+(long)(16*(wid&3)+(lane>>2))*DM+(wid>>2)*32+(lane&3)*8;
  const unsigned kdst=lds0+LDS_K+wid*1024, vdst=lds0+LDS_V+wid*1024;
  #define DMA_K(t,slot) glds16(ksrc+(long)(t)*KVBLK*DM,(unsigned)__builtin_amdgcn_readfirstlane(kdst+(slot)))
  #define DMA_V(t,slot) glds16(vsrc+(long)(t)*KVBLK*DM,(unsigned)__builtin_amdgcn_readfirstlane(vdst+(slot)))
  const int vb0=(int)(lds0+LDS_V)+((lane>>4)&1)*32+(lane&3)*8+(4*hi+((lane&15)>>2))*64;
  const char*Kbase=shm+LDS_K; bf16x8 kf[8];
  const lds_cptr shm3=(lds_cptr)shm; const lds_cptr kp0=shm3+LDS_K+hi*1024+r32*16; const lds_cptr vp0=shm3+LDS_V+((lane>>4)&1)*32+(lane&3)*8+(4*hi+((lane&15)>>2))*64;
  const int NT=SEQ/KVBLK;
  DMA_K(0,0);DMA_V(0,0);DMA_K(1,SLOTB);
  bf16x8 qr[4];
  #pragma unroll
  for(int d0=0;d0<4;++d0)qr[d0]=*reinterpret_cast<const bf16x8*>(&Qw[(long)r32*DM+d0*16+hi*8]);
  float mhat=0.f,l_reg=0.f;f32x16 o[2];o[0]=f32x16{};o[1]=f32x16{};f32x16 negm=f32x16{};asm volatile("":"+v"(negm));

  #define CMASK(P0,P1,t) do{}while(0)
  bool resc=false;
  #define START(P0,P1) do{ const float rm=rowmax(P0,P1); resc=false; \
    { const float dl=rm; mhat=fadd_s(mhat,dl); \
      _Pragma("unroll") for(int r=0;r<16;++r){P0[r]=fsub_s(P0[r],dl);P1[r]=fsub_s(P1[r],dl);} \
      _Pragma("unroll") for(int r=0;r<16;++r)negm[r]=-mhat; asm volatile("":"+v"(negm)); } \
    _Pragma("unroll") for(int r=0;r<16;++r)P0[r]=__builtin_amdgcn_exp2f(P0[r]); }while(0)
  #define RESC() do{ if(resc){ asm volatile("s_waitcnt lgkmcnt(0)":::"memory"); \
      _Pragma("unroll") for(int d_=0;d_<2;++d_) _Pragma("unroll") for(int r=0;r<16;++r)o[d_][r]*=wsf[crow(r,hi)]; } }while(0)
  f32x16 pA0,pA1,pB0,pB1;
  int sl_prev=0,sl_cur=0,sl_next=SLOTB;
  #define ROT() do{sl_prev=sl_cur;sl_cur=sl_next;sl_next=(sl_next==(NSLOT-1)*SLOTB)?0:sl_next+SLOTB;}while(0)
  DMA_K(2,2*SLOTB);
  WAIT_BAR(3);
  qkt(pA0,pA1,Kbase,qr,negm,r32,hi);asm volatile("s_nop 15\n\ts_nop 7":"+v"(pA0),"+v"(pA1));CMASK(pA0,pA1,0);
  START(pA0,pA1);
  _Pragma("unroll") for(int r=0;r<16;++r)pA1[r]=__builtin_amdgcn_exp2f(pA1[r]);
  WAIT_BAR(0);
  DMA_K(3,0);DMA_V(1,SLOTB);
  ROT();
  kload8(kf,kp0+sl_cur);
  WAIT_BAR(2);
  s16x4 vlo[8],vhi[8]; u32x4 pw0,pw1,pw2,pw3;
  #define PKW(P,B) cvtpk_s(P[B],P[B+1])
  #define PAF(k) __builtin_bit_cast(bf16x8,pw##k)
  #define VFR(i) (bf16x8){vlo[i][0],vlo[i][1],vlo[i][2],vlo[i][3],vhi[i][0],vhi[i][1],vhi[i][2],vhi[i][3]}
  #define PIN(x) asm volatile("":"+v"(x))
  #define MX3(a,b,c) __builtin_fmaxf(__builtin_fmaxf((a),(b)),(c))
  #define GAPA(MF,A0,A1,A2,A3,W0,W1,PW) do{ MF; sacc+=A0; sacc+=A1; sacc+=A2; sacc+=A3; PIN(sacc); W0; W1; PIN(PW); SBAR(); }while(0)
  #define EX(v) __builtin_amdgcn_exp2f(v)
  #define GAPB(MF,X,B) do{ MF; X[B]=EX(X[B]); X[B+1]=EX(X[B+1]); X[B+2]=EX(X[B+2]); X[B+3]=EX(X[B+3]); PIN(X); SBAR(); }while(0)
  #define VRD(i) do{ vlo[i]=vtr(vp_+(((i)>>2)*4096+((i)&3)*1024)); vhi[i]=vtr(vp_+(((i)>>2)*4096+((i)&3)*1024+512)); }while(0)
  #define KRD(G,j) do{ if(G){ kload2(kf,kp0+sl_next,j); SBAR(); } }while(0)
  #define STEP(C0,C1,P0,P1,t,GK,GV,GL) do{ SBAR(); \
    const lds_cptr vp_=vp0+sl_prev; \
    VRD(0); SBAR(); float sacc=(P0[0]+P0[1]); \
    GAPA(C0=__builtin_amdgcn_mfma_f32_32x32x16_bf16(kf[0],qr[0],negm,0,0,0), P0[2],P0[3],P0[4],P0[5],     pw0[0]=PKW(P0,0), pw0[1]=PKW(P0,2), pw0); \
    VRD(4); SBAR(); GAPA(C1=__builtin_amdgcn_mfma_f32_32x32x16_bf16(kf[1],qr[0],negm,0,0,0), P0[6],P0[7],P0[8],P0[9],     pw0[2]=PKW(P0,4), pw0[3]=PKW(P0,6), pw0); \
    VRD(1); SBAR(); GAPA(C0=__builtin_amdgcn_mfma_f32_32x32x16_bf16(kf[2],qr[1],C0,0,0,0),   P0[10],P0[11],P0[12],P0[13], pw1[0]=PKW(P0,8), pw1[1]=PKW(P0,10), pw1); \
    VRD(5); SBAR(); GAPA(C1=__builtin_amdgcn_mfma_f32_32x32x16_bf16(kf[3],qr[1],C1,0,0,0),   P0[14],P0[15],P1[0],P1[1],   pw1[2]=PKW(P0,12),pw1[3]=PKW(P0,14), pw1); \
    VRD(2); SBAR(); GAPA(C0=__builtin_amdgcn_mfma_f32_32x32x16_bf16(kf[4],qr[2],C0,0,0,0),   P1[2],P1[3],P1[4],P1[5],     pw2[0]=PKW(P1,0), pw2[1]=PKW(P1,2), pw2); \
    VRD(6); SBAR(); GAPA(C1=__builtin_amdgcn_mfma_f32_32x32x16_bf16(kf[5],qr[2],C1,0,0,0),   P1[6],P1[7],P1[8],P1[9],     pw2[2]=PKW(P1,4), pw2[3]=PKW(P1,6), pw2); \
    VRD(3); SBAR(); GAPA(C0=__builtin_amdgcn_mfma_f32_32x32x16_bf16(kf[6],qr[3],C0,0,0,0),   P1[10],P1[11],P1[12],P1[13], pw3[0]=PKW(P1,8), pw3[1]=PKW(P1,10), pw3); \
    VRD(7); SBAR(); GAPA(C1=__builtin_amdgcn_mfma_f32_32x32x16_bf16(kf[7],qr[3],C1,0,0,0),   P1[14],P1[15],0.f,0.f,       pw3[2]=PKW(P1,12),pw3[3]=PKW(P1,14), pw3); \
    l_reg+=sacc; \
    if(GK){DMA_K((t)+3,sl_cur);} if(GV){DMA_V((t)+1,sl_next);} \
    CMASK(C0,C1,t); \
    { float a=MX3(C0[0],C0[1],C1[0]),b=MX3(C0[2],C0[3],C1[1]); a=MX3(a,C1[2],C1[3]); \
      _Pragma("unroll") for(int r=4;r<16;r+=4){a=MX3(a,C0[r],C0[r+1]);b=MX3(b,C0[r+2],C0[r+3]);a=MX3(a,C1[r],C1[r+1]);b=MX3(b,C1[r+2],C1[r+3]);} \
      float rm=__builtin_fmaxf(a,b); { auto rr=__builtin_amdgcn_permlane32_swap(__float_as_uint(rm),__float_as_uint(rm),false,false); rm=__builtin_fmaxf(__uint_as_float(rr[0]),__uint_as_float(rr[1])); } \
      resc=false; \
      if(__builtin_expect(__any(rm>(float)THRL),0)){ const float dl=__builtin_fmaxf(rm,0.f); mhat+=dl; \
        _Pragma("unroll") for(int r=0;r<16;++r){C0[r]-=dl;C1[r]-=dl;} \
        _Pragma("unroll") for(int r=0;r<16;++r)negm[r]=-mhat; asm volatile("":"+v"(negm)); \
        const float f=__builtin_amdgcn_exp2f(-dl); l_reg*=f; if(hi==0)wsf[r32]=f; resc=true; } } \
    SBAR(); \
    GAPB(o[0]=__builtin_amdgcn_mfma_f32_32x32x16_bf16(PAF(0),VFR(0),o[0],0,0,0), C0,0); \
    GAPB(o[1]=__builtin_amdgcn_mfma_f32_32x32x16_bf16(PAF(0),VFR(4),o[1],0,0,0), C0,4); \
    KRD(GL,0); GAPB(o[0]=__builtin_amdgcn_mfma_f32_32x32x16_bf16(PAF(1),VFR(1),o[0],0,0,0), C0,8); \
    KRD(GL,1); GAPB(o[1]=__builtin_amdgcn_mfma_f32_32x32x16_bf16(PAF(1),VFR(5),o[1],0,0,0), C0,12); \
    KRD(GL,2); GAPB(o[0]=__builtin_amdgcn_mfma_f32_32x32x16_bf16(PAF(2),VFR(2),o[0],0,0,0), C1,0); \
    KRD(GL,3); GAPB(o[1]=__builtin_amdgcn_mfma_f32_32x32x16_bf16(PAF(2),VFR(6),o[1],0,0,0), C1,4); \
    GAPB(o[0]=__builtin_amdgcn_mfma_f32_32x32x16_bf16(PAF(3),VFR(3),o[0],0,0,0), C1,8); \
    GAPB(o[1]=__builtin_amdgcn_mfma_f32_32x32x16_bf16(PAF(3),VFR(7),o[1],0,0,0), C1,12); \
    }while(0)
  int t=1;
  #undef CMASK
  #define CMASK(P0,P1,t) do{}while(0)
  for(;t+5<NT;t+=2){
    STEP(pB0,pB1,pA0,pA1,t,true,true,true);     WAIT_BAR(2); RESC(); ROT();
    STEP(pA0,pA1,pB0,pB1,t+1,true,true,true);   WAIT_BAR(2); RESC(); ROT();
  }
  #undef CMASK
  #define CMASK(P0,P1,t) do{}while(0)
  #define ENDW(tt) do{ if((tt)+3<NT){WAIT_BAR(2);} else if((tt)+2<NT){WAIT_BAR(1);} else {WAIT_BAR(0);} }while(0)
  for(;t+1<NT;t+=2){
    STEP(pB0,pB1,pA0,pA1,t,(t+3<NT),(t+1<NT),(t+1<NT));       ENDW(t);   RESC(); ROT();
    STEP(pA0,pA1,pB0,pB1,t+1,(t+4<NT),(t+2<NT),(t+2<NT));     ENDW(t+1); RESC(); ROT();
  }
  STEP(pB0,pB1,pA0,pA1,NT-1,false,false,false); RESC();
  { float sacc=pB0[0]+pB0[1]; _Pragma("unroll") for(int r=2;r<16;++r)sacc+=pB0[r]; _Pragma("unroll") for(int r=0;r<16;++r)sacc+=pB1[r]; l_reg+=sacc;
    pw0=(u32x4){PKW(pB0,0),PKW(pB0,2),PKW(pB0,4),PKW(pB0,6)};pw1=(u32x4){PKW(pB0,8),PKW(pB0,10),PKW(pB0,12),PKW(pB0,14)};pw2=(u32x4){PKW(pB1,0),PKW(pB1,2),PKW(pB1,4),PKW(pB1,6)};pw3=(u32x4){PKW(pB1,8),PKW(pB1,10),PKW(pB1,12),PKW(pB1,14)};
    SBAR(); pv(o,vb0+sl_cur,PAF(0),PAF(1),PAF(2),PAF(3)); }
  #undef PKW
  #undef PAF
  #undef VFR
  #undef PIN
  #undef MX3
  #undef GAPA
  #undef GAPB
  #undef EX
  #undef VRD
  #undef KRD
  #undef STEP
  #undef ENDW
  {auto rr=__builtin_amdgcn_permlane32_swap(__float_as_uint(l_reg),__float_as_uint(l_reg),false,false);l_reg=__uint_as_float(rr[0])+__uint_as_float(rr[1]);}
  if(hi==0)wsf[32+r32]=l_reg;asm volatile("s_waitcnt lgkmcnt(0)":::"memory");
  float rli[16];
  #pragma unroll
  for(int r=0;r<16;++r)rli[r]=__builtin_amdgcn_rcpf(wsf[32+crow(r,hi)]);
  bf16*Ow=O+(rowbase+q0+wid*QBLK)*DMO+h*D;
  { bf16*stg=(bf16*)(shm+LDS_OST)+wid*2048;
    #pragma unroll
    for(int r=0;r<16;++r){const int orow=crow(r,hi);
      #pragma unroll
      for(int d0=0;d0<2;++d0)stg[orow*64+d0*32+r32]=__float2bfloat16(o[d0][r]*rli[r]);}
    asm volatile("s_waitcnt lgkmcnt(0)":::"memory");
    #pragma unroll
    for(int i=0;i<4;++i){const int row=i*8+(lane>>3),ch=lane&7; const u32x4 v=*(const u32x4*)(stg+row*64+ch*8); ATTN_STORE16(Ow+(long)row*DMO+ch*8,v);} }
  asm volatile("s_waitcnt lgkmcnt(0)\n\ts_barrier":::"memory");
  #undef DMA_K
  #undef DMA_V
  #undef CMASK
  #undef START
  #undef RESC
  #undef ROT
}
constexpr int ATTN_LDS_BYTES=LDS_BYTES;
struct AttnTensors { const bf16* Q; const bf16* K; const bf16* V; bf16* O; };
struct AttnUnit { int bh; int qb; };
struct StaticOrder {
  int vcu, G;
  __device__ __forceinline__ explicit StaticOrder(int grid,int block):vcu((grid%8==0)?(block%8)*(grid/8)+block/8:block),G(grid){}
  __device__ __forceinline__ bool next(int i,AttnUnit&u)const{ const int L=i*G+vcu; if(L>=BATCH*NHEAD*NQB)return false; u.bh=L/NQB; u.qb=L%NQB; return true; }
  __device__ __forceinline__ void a_ready(const AttnUnit&)const{}
  __device__ __forceinline__ void done(const AttnUnit&)const{}
};
template<class Sched,int THRL=8> __device__ __forceinline__ void attn_phase(char*lds,const AttnTensors&T,const Sched&S){
  AttnUnit u;
  for(int i=0;S.next(i,u);++i){ S.a_ready(u); attn_unit<THRL>(u.bh/NHEAD,u.bh%NHEAD,u.qb,T.Q,T.K,T.V,T.O,lds); S.done(u); }
}
#undef SBAR
#undef WAIT_BAR
}
#define LAS __attribute__((address_space(3)))
typedef unsigned short bf16r;
typedef unsigned v4u __attribute__((ext_vector_type(4)));
typedef float f32x4 __attribute__((ext_vector_type(4)));
constexpr int M = 16384, DMODEL = 1024, FF = 2816, NPROJ = 3072, NWIN = 3584, SEQ = 4096, NWAVES = 8;
constexpr int LDS_BYTES = 147456;
constexpr int STOP_L = 99, STOP_P = 99;
constexpr size_t MiB = 1u << 20;
constexpr size_t WS_TAB = 0;
constexpr size_t WS_SS = 53 * MiB;
constexpr size_t WS_W = 1 * MiB;
constexpr size_t W_GU1 = WS_W, W_D1 = W_GU1 + (size_t)5632 * 1024 * 2, W_GU2 = W_D1 + (size_t)1024 * 2816 * 2, W_D2 = W_GU2 + (size_t)5632 * 1024 * 2,
                 W_IN = W_D2 + (size_t)1024 * 2816 * 2, W_MG = W_IN + (size_t)NWIN * 1024 * 2, W_GLU = W_MG + (size_t)3072 * 1024 * 2, W_BR = W_GLU + (size_t)512 * 512 * 2,
                 W_OUT = W_BR + (size_t)3 * 1024 * 512 * 2, W_END = W_OUT + (size_t)1024 * 1024 * 2;
constexpr size_t WS_XB = 56 * MiB, WS_BIG = 88 * MiB  , WS_UG = 184 * MiB  , WS_W1T = 208 * MiB  ,
                 WS_BTY = 216 * MiB  , WS_E = 240 * MiB  , WS_KT = 256 * MiB  ,
                 WS_ACC = 200 * MiB, WS_MG16 = 216 * MiB  , WS_YS5 = WS_UG, WS_GEB = 232 * MiB, WS_YGLA = 248 * MiB, WS_END = 264 * MiB;
static_assert(W_END <= WS_SS && WS_SS + 3 * (size_t)M * 64 <= WS_XB, "weights fit");
constexpr int PC_GQ = 0, PC_GK = 512, PC_GV = 1024, PC_GG = 1536, PC_AQ = 2048, PC_AK = 2560, PC_AV = 2688, PC_Z = 2816;

struct Args { const float* in[32]; float* out; unsigned char* ws; };

__device__ __forceinline__ unsigned f2bf(float f) { unsigned u = __builtin_bit_cast(unsigned, f); return (u + 0x7fffu + ((u >> 16) & 1u)) >> 16; }
__device__ __forceinline__ unsigned pk2(float lo, float hi) { return f2bf(lo) | (f2bf(hi) << 16); }
__device__ __forceinline__ float bf2f(bf16r v) { return __builtin_bit_cast(float, (unsigned)v << 16); }
__device__ __forceinline__ float wave_sum(float v) {
#pragma unroll
    for (int o = 1; o < 64; o <<= 1) v += __shfl_xor(v, o);
    return v;
}
#define LDS_WAIT() asm volatile("s_waitcnt lgkmcnt(0)" ::: "memory")

template <class P, class Gn> __device__ __forceinline__ void conv_item(P src, Gn gain, int K, int Nd, bf16r* WT, LAS float* scr, int item, int lane) {
    const int nblk = Nd / 32, kb = item / nblk, nb = item % nblk, k0 = 64 * kb, n0 = 32 * nb;
    const int nq = lane & 7, kr = lane >> 3;
    f32x4 v[8];
#pragma unroll
    for (int i = 0; i < 8; ++i) { const float* s = src(k0 + 8 * i + kr, n0 + 4 * nq); v[i] = s ? *(const f32x4*)s : (f32x4){0.f, 0.f, 0.f, 0.f}; }
#pragma unroll
    for (int i = 0; i < 8; ++i) { const int kk = 8 * i + kr; const float gk = gain(k0 + kk); LAS float* d = scr + kk * 33 + 4 * nq; d[0] = v[i][0] * gk; d[1] = v[i][1] * gk; d[2] = v[i][2] * gk; d[3] = v[i][3] * gk; }
    LDS_WAIT(); asm volatile("" ::: "memory");
    const int c = lane & 7;
#pragma unroll
    for (int j = 0; j < 4; ++j) { const int n = (lane >> 3) + 8 * j; const LAS float* s = scr + (8 * c) * 33 + n;
        v4u o; o.x = pk2(s[0 * 33], s[1 * 33]); o.y = pk2(s[2 * 33], s[3 * 33]); o.z = pk2(s[4 * 33], s[5 * 33]); o.w = pk2(s[6 * 33], s[7 * 33]);
        *(v4u*)(WT + (size_t)(n0 + n) * K + k0 + 8 * c) = o; }
    LDS_WAIT(); asm volatile("" ::: "memory");
}
template <class P, class Gn> __device__ __forceinline__ void conv_all(P src, Gn gain, int K, int Nd, bf16r* WT, LAS float* scr, int gw, int NGW, int lane) {
    const int items = (K / 64) * (Nd / 32);
    for (int it = gw; it < items; it += NGW) conv_item(src, gain, K, Nd, WT, scr, it, lane);
}

__device__ __forceinline__ float gelu_tanh(float x) { const float z = 0.7978845608028654f * (x + 0.044715f * x * x * x); const float t = 1.0f - 2.0f * __builtin_amdgcn_rcpf(__expf(2.0f * z) + 1.0f); return 0.5f * x * (1.0f + t); }
__device__ __forceinline__ float silu_(float x) { return x * __builtin_amdgcn_rcpf(1.0f + __expf(-x)); }


constexpr size_t WS_S5X = 264 * MiB;
constexpr size_t WS_GDT = 266 * MiB;
constexpr size_t WS_GE = WS_GEB;
constexpr size_t WS_NEED = 267 * MiB;
typedef float f32x2v __attribute__((ext_vector_type(2)));
template <bool OUT> __device__ __forceinline__ void gla_unit(const float* const* TAB, int l, int unit, int tid, const bf16r* PROJ, float* ACC, bf16r* OB, float* GE, float* GDT, LAS unsigned char* ldsl) {
    const int c = unit & 7, h = (unit >> 3) & 3, b = (unit >> 5) & 3, dir = unit >> 7;
    LAS float* sa = (LAS float*)ldsl; LAS float* sq = sa + 1024; LAS float* sk = sq + 1024; LAS float* sv = sk + 1024; LAS float* sop = sv + 1024;
    const int dks = tid & 127;
    const int dvg = tid & 31, dkg = tid >> 5;
    f32x2v S2[8][2];
#pragma unroll
    for (int j = 0; j < 8; ++j) { S2[j][0] = (f32x2v){0.f, 0.f}; S2[j][1] = (f32x2v){0.f, 0.f}; }
    if (OUT) {
        for (int cc = 0; cc < 8; ++cc) { const int c2 = dir ? 7 - cc : cc; if (c2 == c) break; const size_t u2 = (size_t)(unit - c + c2);
            const f32x4 d0 = *(const f32x4*)(GDT + u2 * 128 + dkg * 8), d1 = *(const f32x4*)(GDT + u2 * 128 + dkg * 8 + 4);
#pragma unroll
            for (int j = 0; j < 8; ++j) { const f32x4 g4 = *(const f32x4*)(GE + (u2 * 128 + dkg * 8 + j) * 128 + 4 * dvg); const float dd = j < 4 ? d0[j & 3] : d1[j & 3];
                S2[j][0] = dd * S2[j][0] + (f32x2v){g4[0], g4[1]}; S2[j][1] = dd * S2[j][1] + (f32x2v){g4[2], g4[3]}; } }
    }
    const float* wal = TAB[16] + ((size_t)(l * 2 + dir) * 16) * 512 + h * 128 + dks; const float bal = TAB[17][(l * 2 + dir) * 512 + h * 128 + dks];
    float wr_[16];
#pragma unroll
    for (int r = 0; r < 16; ++r) wr_[r] = wal[r * 512];
    const int zcol = PC_Z + dir * 16;
    float lsum = 0.f;
    v4u rz0[2], rz1[2]; bf16r rq[2], rk[2], rvv[2];
#define GLA_LOAD(BLK) do { _Pragma("unroll") for (int i = 0; i < 2; ++i) { const int idx = tid + 512 * i, s = idx >> 7, dk = idx & 127; const int step = (BLK) * 8 + s, t = dir ? (c * 512 + 511 - step) : (c * 512 + step); \
        const bf16r* pr = PROJ + ((size_t)b * SEQ + t) * NPROJ; rz0[i] = *(const v4u*)(pr + zcol); rz1[i] = *(const v4u*)(pr + zcol + 8); \
        rq[i] = OUT ? pr[PC_GQ + h * 128 + dk] : (bf16r)0; rk[i] = pr[PC_GK + h * 128 + dk]; rvv[i] = pr[PC_GV + h * 128 + dk]; } } while (0)
    GLA_LOAD(0);
    for (int blk = 0; blk <= 64; ++blk) {
        if (blk < 64) {
#pragma unroll
            for (int i = 0; i < 2; ++i) { const int idx = tid + 512 * i;
                const v4u z0 = rz0[i], z1 = rz1[i];
                float lg = bal;
                lg += pg8::bflo(z0.x) * wr_[0] + pg8::bfhi(z0.x) * wr_[1] + pg8::bflo(z0.y) * wr_[2] + pg8::bfhi(z0.y) * wr_[3] + pg8::bflo(z0.z) * wr_[4] + pg8::bfhi(z0.z) * wr_[5] + pg8::bflo(z0.w) * wr_[6] + pg8::bfhi(z0.w) * wr_[7];
                lg += pg8::bflo(z1.x) * wr_[8] + pg8::bfhi(z1.x) * wr_[9] + pg8::bflo(z1.y) * wr_[10] + pg8::bfhi(z1.y) * wr_[11] + pg8::bflo(z1.z) * wr_[12] + pg8::bfhi(z1.z) * wr_[13] + pg8::bflo(z1.w) * wr_[14] + pg8::bfhi(z1.w) * wr_[15];
                const float ls = (fminf(lg, 0.f) - log1pf(expf(-fabsf(lg)))) * (1.0f / 16.0f);
                lsum += ls;
                sa[idx] = expf(ls); if (OUT) sq[idx] = bf2f(rq[i]) * 0.08838834764831845f; sk[idx] = bf2f(rk[i]); sv[idx] = bf2f(rvv[i]); }
            if (blk + 1 < 64) GLA_LOAD(blk + 1);
        }
        if (OUT && blk > 0) {
#pragma unroll
            for (int i = 0; i < 2; ++i) { const int idx = tid + 512 * i, s = idx >> 7, dvv = idx & 127; const int step = (blk - 1) * 8 + s, t = dir ? (c * 512 + 511 - step) : (c * 512 + step);
                float val = 0.f;
#pragma unroll
                for (int gq = 0; gq < 16; ++gq) val += sop[gq * 1024 + idx];
                const size_t oi = ((size_t)b * SEQ + t) * 512 + h * 128 + dvv; if (dir) OB[oi] = (bf16r)f2bf(val); else ACC[oi] = val; }
        }
        __syncthreads();
        if (blk < 64) {
            for (int s = 0; s < 8; ++s) {
                const f32x4 v4 = *(const LAS f32x4*)(sv + s * 128 + 4 * dvg); const f32x2v v01 = (f32x2v){v4[0], v4[1]}, v23 = (f32x2v){v4[2], v4[3]};
                const LAS f32x4* pa = (const LAS f32x4*)(sa + s * 128 + dkg * 8); const LAS f32x4* pq = (const LAS f32x4*)(sq + s * 128 + dkg * 8); const LAS f32x4* pk = (const LAS f32x4*)(sk + s * 128 + dkg * 8);
                f32x2v o01 = (f32x2v){0.f, 0.f}, o23 = (f32x2v){0.f, 0.f};
#pragma unroll
                for (int jj = 0; jj < 2; ++jj) { const f32x4 a4 = pa[jj], k4 = pk[jj]; f32x4 q4 = (f32x4){0.f, 0.f, 0.f, 0.f}; if (OUT) q4 = pq[jj];
#pragma unroll
                    for (int e = 0; e < 4; ++e) { const int j = jj * 4 + e;
                        S2[j][0] = a4[e] * S2[j][0] + k4[e] * v01; S2[j][1] = a4[e] * S2[j][1] + k4[e] * v23;
                        if (OUT) { o01 = o01 + q4[e] * S2[j][0]; o23 = o23 + q4[e] * S2[j][1]; } } }
                if (OUT) *(LAS f32x4*)(sop + (dkg * 8 + s) * 128 + 4 * dvg) = (f32x4){o01.x, o01.y, o23.x, o23.y}; }
        }
        __syncthreads();
    }
    if (!OUT) {
#pragma unroll
        for (int j = 0; j < 8; ++j) *(f32x4*)(GE + ((size_t)unit * 128 + dkg * 8 + j) * 128 + 4 * dvg) = (f32x4){S2[j][0].x, S2[j][0].y, S2[j][1].x, S2[j][1].y};
        sop[tid] = lsum; __syncthreads();
#undef GLA_LOAD
        if (tid < 128) GDT[(size_t)unit * 128 + tid] = expf((sop[tid] + sop[128 + tid]) + (sop[256 + tid] + sop[384 + tid]));
        __syncthreads();
    }
}

typedef short gbf16x8 __attribute__((ext_vector_type(8)));
__device__ __forceinline__ void gla_passA_mfma(const float* const* TAB, int l, int unit, int tid, const bf16r* PROJ, bf16r* GE, float* GDT, LAS unsigned char* ldsl) {
    const int c = unit & 7, h = (unit >> 3) & 3, b = (unit >> 5) & 3, dir = unit >> 7;
    LAS float* LB = (LAS float*)ldsl;
    LAS bf16r* KET = (LAS bf16r*)(ldsl + 32768);
    LAS bf16r* VT = (LAS bf16r*)(ldsl + 32768 + 18432);
    LAS float* DD = (LAS float*)(ldsl + 32768 + 2 * 18432);
    LAS float* TT = (LAS float*)(ldsl + 126976);
    const int lane = tid & 63, w = tid >> 6, fr = lane & 15, fq = lane >> 4;
    const int col = tid & 127, rq = tid >> 7;
    const float* wal = TAB[16] + ((size_t)(l * 2 + dir) * 16) * 512 + h * 128 + col; const float bal = TAB[17][(l * 2 + dir) * 512 + h * 128 + col];
    float wr_[16];
#pragma unroll
    for (int r = 0; r < 16; ++r) wr_[r] = wal[r * 512];
    const int zcol = PC_Z + dir * 16;
    f32x4 S[8];
#pragma unroll
    for (int mt = 0; mt < 8; ++mt) S[mt] = (f32x4){0.f, 0.f, 0.f, 0.f};
    float ltot = 0.f;
    for (int sc = 0; sc < 8; ++sc) {
        bf16r rk[16], rv[16];
#pragma unroll
        for (int r = 0; r < 16; ++r) { const int step = sc * 64 + rq * 16 + r, t = dir ? (c * 512 + 511 - step) : (c * 512 + step); const bf16r* pr = PROJ + ((size_t)b * SEQ + t) * NPROJ;
            rk[r] = pr[PC_GK + h * 128 + col]; rv[r] = pr[PC_GV + h * 128 + col]; }
        float lav[16];
#pragma unroll
        for (int half = 0; half < 4; ++half) {
            v4u z0[4], z1[4];
#pragma unroll
            for (int r = 0; r < 4; ++r) { const int step = sc * 64 + rq * 16 + half * 4 + r, t = dir ? (c * 512 + 511 - step) : (c * 512 + step); const bf16r* pr = PROJ + ((size_t)b * SEQ + t) * NPROJ;
                z0[r] = *(const v4u*)(pr + zcol); z1[r] = *(const v4u*)(pr + zcol + 8); }
#pragma unroll
            for (int r = 0; r < 4; ++r) { float lg = bal;
                lg += pg8::bflo(z0[r].x) * wr_[0] + pg8::bfhi(z0[r].x) * wr_[1] + pg8::bflo(z0[r].y) * wr_[2] + pg8::bfhi(z0[r].y) * wr_[3] + pg8::bflo(z0[r].z) * wr_[4] + pg8::bfhi(z0[r].z) * wr_[5] + pg8::bflo(z0[r].w) * wr_[6] + pg8::bfhi(z0[r].w) * wr_[7];
                lg += pg8::bflo(z1[r].x) * wr_[8] + pg8::bfhi(z1[r].x) * wr_[9] + pg8::bflo(z1[r].y) * wr_[10] + pg8::bfhi(z1[r].y) * wr_[11] + pg8::bflo(z1[r].z) * wr_[12] + pg8::bfhi(z1[r].z) * wr_[13] + pg8::bflo(z1[r].w) * wr_[14] + pg8::bfhi(z1[r].w) * wr_[15];
                lav[half * 4 + r] = (fminf(lg, 0.f) - __logf(1.0f + __expf(-fabsf(lg)))) * (1.0f / 16.0f); }
        }
#pragma unroll
        for (int r = 1; r < 16; ++r) lav[r] += lav[r - 1];
        TT[rq * 128 + col] = lav[15];
        __syncthreads();
        float off = 0.f, bl = 0.f;
#pragma unroll
        for (int q = 0; q < 4; ++q) { const float tq = TT[q * 128 + col]; bl += tq; off += (q < rq) ? tq : 0.f; }
        if (rq == 0) { DD[col] = __expf(bl); ltot += bl; }
        { unsigned kw[8], vw[8];
#pragma unroll
          for (int r = 0; r < 8; ++r) { kw[r] = pk2(bf2f(rk[2 * r]) * __expf(bl - (lav[2 * r] + off)), bf2f(rk[2 * r + 1]) * __expf(bl - (lav[2 * r + 1] + off))); vw[r] = (unsigned)rv[2 * r] | ((unsigned)rv[2 * r + 1] << 16); }
          LAS v4u* kd = (LAS v4u*)(KET + col * 72 + rq * 16); kd[0] = (v4u){kw[0], kw[1], kw[2], kw[3]}; kd[1] = (v4u){kw[4], kw[5], kw[6], kw[7]};
          LAS v4u* vd = (LAS v4u*)(VT + col * 72 + rq * 16); vd[0] = (v4u){vw[0], vw[1], vw[2], vw[3]}; vd[1] = (v4u){vw[4], vw[5], vw[6], vw[7]}; }
        __syncthreads();
        { gbf16x8 bfr[2];
#pragma unroll
          for (int ks = 0; ks < 2; ++ks) bfr[ks] = *(const LAS gbf16x8*)(VT + (16 * w + fr) * 72 + 32 * ks + 8 * fq);
#pragma unroll
          for (int mt = 0; mt < 8; ++mt) { const f32x4 d4 = *(const LAS f32x4*)(DD + 16 * mt + 4 * fq); f32x4 acc = S[mt] * d4;
#pragma unroll
              for (int ks = 0; ks < 2; ++ks) { const gbf16x8 afr = *(const LAS gbf16x8*)(KET + (16 * mt + fr) * 72 + 32 * ks + 8 * fq); acc = __builtin_amdgcn_mfma_f32_16x16x32_bf16(afr, bfr[ks], acc, 0, 0, 0); }
              S[mt] = acc; } }
        __syncthreads();
    }
#pragma unroll
    for (int mt = 0; mt < 8; ++mt)
#pragma unroll
        for (int jj = 0; jj < 4; ++jj) GE[((size_t)unit * 128 + 16 * mt + 4 * fq + jj) * 128 + 16 * w + fr] = (bf16r)f2bf(S[mt][jj]);
    if (tid < 128) GDT[(size_t)unit * 128 + tid] = expf(ltot);
}

__device__ __forceinline__ void gla_passB_mfma(const float* const* TAB, int l, int unit, int tid, const bf16r* PROJ, float* ACC, bf16r* OB, const bf16r* GE, const float* GDT, LAS unsigned char* ldsl) {
    const int c = unit & 7, h = (unit >> 3) & 3, b = (unit >> 5) & 3, dir = unit >> 7;
    LAS float* LB = (LAS float*)ldsl;
    LAS bf16r* KET = (LAS bf16r*)(ldsl + 34816);
    LAS bf16r* VT = (LAS bf16r*)(ldsl + 53248);
    LAS float* DD = (LAS float*)(ldsl + 71680);
    LAS bf16r* QD = (LAS bf16r*)(ldsl + 72192);
    LAS bf16r* KD = (LAS bf16r*)(ldsl + 89600);
    LAS bf16r* PP = (LAS bf16r*)(ldsl + 107008);
    LAS float* TT = (LAS float*)(ldsl + 126976);
    const int lane = tid & 63, w = tid >> 6, fr = lane & 15, fq = lane >> 4;
    LAS bf16r* STw = (LAS bf16r*)ldsl + w * (16 * 136);
    const int col = tid & 127, rq = tid >> 7;
    const float* wal = TAB[16] + ((size_t)(l * 2 + dir) * 16) * 512 + h * 128 + col; const float bal = TAB[17][(l * 2 + dir) * 512 + h * 128 + col];
    float wr_[16];
#pragma unroll
    for (int r = 0; r < 16; ++r) wr_[r] = wal[r * 512];
    const int zcol = PC_Z + dir * 16;
    f32x4 S[8];
#pragma unroll
    for (int mt = 0; mt < 8; ++mt) S[mt] = (f32x4){0.f, 0.f, 0.f, 0.f};
    for (int cc = 0; cc < 8; ++cc) { const int c2 = dir ? 7 - cc : cc; if (c2 == c) break; const size_t u2 = (size_t)(unit - c + c2);
#pragma unroll
        for (int mt = 0; mt < 8; ++mt) { const f32x4 d4 = *(const f32x4*)(GDT + u2 * 128 + 16 * mt + 4 * fq);
#pragma unroll
            for (int jj = 0; jj < 4; ++jj) S[mt][jj] = d4[jj] * S[mt][jj] + bf2f(GE[(u2 * 128 + 16 * mt + 4 * fq + jj) * 128 + 16 * w + fr]); } }
    for (int sc = 0; sc < 8; ++sc) {
        bf16r rqv[16], rk[16], rv[16];
#pragma unroll
        for (int r = 0; r < 16; ++r) { const int step = sc * 64 + rq * 16 + r, t = dir ? (c * 512 + 511 - step) : (c * 512 + step); const bf16r* pr = PROJ + ((size_t)b * SEQ + t) * NPROJ;
            rqv[r] = pr[PC_GQ + h * 128 + col]; rk[r] = pr[PC_GK + h * 128 + col]; rv[r] = pr[PC_GV + h * 128 + col]; }
        float lav[16];
#pragma unroll
        for (int half = 0; half < 4; ++half) {
            v4u z0[4], z1[4];
#pragma unroll
            for (int r = 0; r < 4; ++r) { const int step = sc * 64 + rq * 16 + half * 4 + r, t = dir ? (c * 512 + 511 - step) : (c * 512 + step); const bf16r* pr = PROJ + ((size_t)b * SEQ + t) * NPROJ;
                z0[r] = *(const v4u*)(pr + zcol); z1[r] = *(const v4u*)(pr + zcol + 8); }
#pragma unroll
            for (int r = 0; r < 4; ++r) { float lg = bal;
                lg += pg8::bflo(z0[r].x) * wr_[0] + pg8::bfhi(z0[r].x) * wr_[1] + pg8::bflo(z0[r].y) * wr_[2] + pg8::bfhi(z0[r].y) * wr_[3] + pg8::bflo(z0[r].z) * wr_[4] + pg8::bfhi(z0[r].z) * wr_[5] + pg8::bflo(z0[r].w) * wr_[6] + pg8::bfhi(z0[r].w) * wr_[7];
                lg += pg8::bflo(z1[r].x) * wr_[8] + pg8::bfhi(z1[r].x) * wr_[9] + pg8::bflo(z1[r].y) * wr_[10] + pg8::bfhi(z1[r].y) * wr_[11] + pg8::bflo(z1[r].z) * wr_[12] + pg8::bfhi(z1[r].z) * wr_[13] + pg8::bflo(z1[r].w) * wr_[14] + pg8::bfhi(z1[r].w) * wr_[15];
                lav[half * 4 + r] = (fminf(lg, 0.f) - __logf(1.0f + __expf(-fabsf(lg)))) * (1.0f / 16.0f); }
        }
#pragma unroll
        for (int r = 1; r < 16; ++r) lav[r] += lav[r - 1];
        TT[rq * 128 + col] = lav[15];
        __syncthreads();
        { float off = 0.f, bl = 0.f;
#pragma unroll
          for (int q = 0; q < 4; ++q) { const float tq = TT[q * 128 + col]; bl += tq; off += (q < rq) ? tq : 0.f; }
          if (rq == 0) DD[col] = __expf(bl);
          unsigned kw[8], vw[8];
#pragma unroll
          for (int r = 0; r < 16; ++r) { const int j = rq * 16 + r; const float bj = lav[r] + off, kf = bf2f(rk[r]);
              QD[j * 136 + col] = (bf16r)f2bf(bf2f(rqv[r]) * 0.08838834764831845f * __expf(bj)); KD[j * 136 + col] = (bf16r)f2bf(kf * __expf(-bj));
              const unsigned ke = f2bf(kf * __expf(bl - bj));
              if (r & 1) { kw[r >> 1] |= ke << 16; vw[r >> 1] |= (unsigned)rv[r] << 16; } else { kw[r >> 1] = ke; vw[r >> 1] = (unsigned)rv[r]; } }
          LAS v4u* kd = (LAS v4u*)(KET + col * 72 + rq * 16); kd[0] = (v4u){kw[0], kw[1], kw[2], kw[3]}; kd[1] = (v4u){kw[4], kw[5], kw[6], kw[7]};
          LAS v4u* vd = (LAS v4u*)(VT + col * 72 + rq * 16); vd[0] = (v4u){vw[0], vw[1], vw[2], vw[3]}; vd[1] = (v4u){vw[4], vw[5], vw[6], vw[7]}; }
        __syncthreads();
#pragma unroll
        for (int mt = 0; mt < 8; ++mt) { unsigned long long pk = (unsigned long long)pk2(S[mt][0], S[mt][1]) | ((unsigned long long)pk2(S[mt][2], S[mt][3]) << 32);
            *(LAS unsigned long long*)(STw + fr * 136 + 16 * mt + 4 * fq) = pk; }
#pragma unroll
        for (int tt = 0; tt < 2; ++tt) { const int tile = 2 * w + tt, mi = tile >> 2, nj = tile & 3; f32x4 acc = (f32x4){0.f, 0.f, 0.f, 0.f};
            if (nj <= mi) {
#pragma unroll
                for (int ks = 0; ks < 4; ++ks) { const gbf16x8 afr = *(const LAS gbf16x8*)(QD + (16 * mi + fr) * 136 + 32 * ks + 8 * fq); const gbf16x8 bfr = *(const LAS gbf16x8*)(KD + (16 * nj + fr) * 136 + 32 * ks + 8 * fq);
                    acc = __builtin_amdgcn_mfma_f32_16x16x32_bf16(afr, bfr, acc, 0, 0, 0); } }
#pragma unroll
            for (int jj = 0; jj < 4; ++jj) { const int i = 16 * mi + 4 * fq + jj, j = 16 * nj + fr; PP[i * 72 + j] = (bf16r)f2bf(j <= i ? acc[jj] : 0.f); } }
        __syncthreads();
        { gbf16x8 vb[2], sb[4];
#pragma unroll
          for (int ks = 0; ks < 2; ++ks) vb[ks] = *(const LAS gbf16x8*)(VT + (16 * w + fr) * 72 + 32 * ks + 8 * fq);
#pragma unroll
          for (int ks = 0; ks < 4; ++ks) sb[ks] = *(const LAS gbf16x8*)(STw + fr * 136 + 32 * ks + 8 * fq);
#pragma unroll
          for (int mi = 0; mi < 4; ++mi) { f32x4 acc = (f32x4){0.f, 0.f, 0.f, 0.f};
#pragma unroll
              for (int ks = 0; ks < 2; ++ks) { const gbf16x8 afr = *(const LAS gbf16x8*)(PP + (16 * mi + fr) * 72 + 32 * ks + 8 * fq); acc = __builtin_amdgcn_mfma_f32_16x16x32_bf16(afr, vb[ks], acc, 0, 0, 0); }
#pragma unroll
              for (int ks = 0; ks < 4; ++ks) { const gbf16x8 afr = *(const LAS gbf16x8*)(QD + (16 * mi + fr) * 136 + 32 * ks + 8 * fq); acc = __builtin_amdgcn_mfma_f32_16x16x32_bf16(afr, sb[ks], acc, 0, 0, 0); }
#pragma unroll
              for (int jj = 0; jj < 4; ++jj) { const int step = sc * 64 + 16 * mi + 4 * fq + jj, t = dir ? (c * 512 + 511 - step) : (c * 512 + step);
                  const size_t oi = ((size_t)b * SEQ + t) * 512 + h * 128 + 16 * w + fr; if (dir) OB[oi] = (bf16r)f2bf(acc[jj]); else ((bf16r*)ACC)[oi] = (bf16r)f2bf(acc[jj]); } }
#pragma unroll
          for (int mt = 0; mt < 8; ++mt) { const f32x4 d4 = *(const LAS f32x4*)(DD + 16 * mt + 4 * fq); f32x4 acc = S[mt] * d4;
#pragma unroll
              for (int ks = 0; ks < 2; ++ks) { const gbf16x8 afr = *(const LAS gbf16x8*)(KET + (16 * mt + fr) * 72 + 32 * ks + 8 * fq); acc = __builtin_amdgcn_mfma_f32_16x16x32_bf16(afr, vb[ks], acc, 0, 0, 0); }
              S[mt] = acc; } }
        __syncthreads();
    }
}

constexpr size_t WS_BAR = 4096;
constexpr size_t WS_ROPE = 32768;
constexpr int MISC_OFF = 131072 + 320;
typedef __attribute__((address_space(1))) unsigned gu32;
#define RLX_AGENT __ATOMIC_RELAXED, __HIP_MEMORY_SCOPE_AGENT
#define XB_TMO      128
#define XB_XCNT(j)  (256  + 64 * (j))
#define XB_XSUB(j)  (1280 + 64 * (j))
#define XB_XGEN(j)  (2304 + 64 * (j))
#define XB_TOP      3328
#define XB_TOPGEN   3392
#define XCD_BAR_WORDS 3456
#define XB_SPIN_CAP (1u << 18)

__device__ __forceinline__ unsigned xb_ld(unsigned* p)              { return __hip_atomic_load(p, __ATOMIC_RELAXED, __HIP_MEMORY_SCOPE_AGENT); }
__device__ __forceinline__ unsigned xb_add(unsigned* p, unsigned v) { return __hip_atomic_fetch_add(p, v, __ATOMIC_RELAXED, __HIP_MEMORY_SCOPE_AGENT); }
__device__ __forceinline__ unsigned xb_xcc_id() { return (unsigned)__builtin_amdgcn_s_getreg((3 << 11) | 20) & 0xFu; }
#define XB_SPIN(cond, bar) do { unsigned _sp = 0; while (cond) { __builtin_amdgcn_s_sleep(1); \
    if ((++_sp & 255u) == 0u) { if (xb_ld(&(bar)[XB_TMO])) break; if (_sp > XB_SPIN_CAP) { atomicAdd(&(bar)[XB_TMO], 1u); break; } } } } while (0)

struct XcdBarrier {
    unsigned* bar; unsigned x;
    volatile LAS unsigned* st;
};

__device__ __forceinline__ XcdBarrier xcd_barrier_post(unsigned* bar, volatile LAS unsigned* st) {
    XcdBarrier b; b.bar = bar; b.x = xb_xcc_id(); b.st = st;
    if (threadIdx.x == 0) (void)xb_add(&bar[XB_XCNT(b.x)], 1u);
    return b;
}
__device__ __forceinline__ void xcd_barrier_complete(unsigned* bar, unsigned x, unsigned& nloc, unsigned& nx) {
    const unsigned G = gridDim.x * gridDim.y * gridDim.z;
    unsigned sum, cnt, mine, sp = 0u;
    for (;;) {
        sum = 0u; cnt = 0u; mine = 0u;
#pragma unroll
        for (unsigned j = 0; j < 16; ++j) { const unsigned c = xb_ld(&bar[XB_XCNT(j)]); sum += c; cnt += (c > 0u) ? 1u : 0u; mine = (j == x) ? c : mine; }
        if (sum == G) break;
        __builtin_amdgcn_s_sleep(1);
        if ((++sp & 255u) == 0u) { if (xb_ld(&bar[XB_TMO])) break; if (sp > XB_SPIN_CAP) { atomicAdd(&bar[XB_TMO], 1u); break; } }
    }
    nloc = mine > 0u ? mine : 1u; nx = cnt > 0u ? cnt : 1u;
}

__device__ __forceinline__ void xcd_barrier(const XcdBarrier& b) {
    asm volatile("s_waitcnt vmcnt(0)" ::: "memory");
    __syncthreads();
    if (threadIdx.x == 0) {
        unsigned* bar = b.bar;
        __builtin_amdgcn_s_waitcnt(0);
        unsigned nloc = b.st[0], nx = b.st[1];
        if (nloc == 0u) { xcd_barrier_complete(bar, b.x, nloc, nx); b.st[0] = nloc; b.st[1] = nx; }
        const unsigned old = xb_add(&bar[XB_XSUB(b.x)], 1u);
        const unsigned gen = old / nloc;
        if (old + 1u == (gen + 1u) * nloc) {
            __builtin_amdgcn_fence(__ATOMIC_RELEASE, "agent");
            asm volatile("s_waitcnt vmcnt(0)" ::: "memory");
            const unsigned og = xb_add(&bar[XB_TOP], 1u);
            const unsigned tg = og / nx;
            if (og + 1u == (tg + 1u) * nx) xb_add(&bar[XB_TOPGEN], 1u);
            else XB_SPIN(xb_ld(&bar[XB_TOPGEN]) == tg, bar);
            __builtin_amdgcn_fence(__ATOMIC_ACQUIRE, "agent");
            xb_add(&bar[XB_XGEN(b.x)], 1u);
            asm volatile("s_waitcnt vmcnt(0)" ::: "memory");
        } else {
            XB_SPIN(xb_ld(&bar[XB_XGEN(b.x)]) == gen, bar);
            __builtin_amdgcn_fence(__ATOMIC_ACQUIRE, "agent");
            asm volatile("s_waitcnt vmcnt(0)" ::: "memory");
        }
    }
    __syncthreads();
}

__global__ void __launch_bounds__(NWAVES * 64, 2) fwd_kernel(Args args) {
    extern __shared__ __attribute__((aligned(16))) unsigned char lds[];
    cg::grid_group grid = cg::this_grid();
    unsigned seam = 0; int fin_buf = 0;
    grid.sync();
    for (int u = threadIdx.x; u < (LDS_BYTES - 131072) / 4; u += NWAVES * 64) ((LAS unsigned*)((LAS unsigned char*)lds + 131072))[u] = 0u;
    __syncthreads();
    (void)xcd_barrier_post((unsigned*)(args.ws + WS_BAR), (volatile LAS unsigned*)((LAS unsigned char*)lds + MISC_OFF) + 8);
#define GSYNC() do { XcdBarrier xb_; xb_.bar = (unsigned*)(args.ws + WS_BAR); xb_.x = xb_xcc_id(); xb_.st = (volatile LAS unsigned*)((LAS unsigned char*)lds + MISC_OFF) + 8; xcd_barrier(xb_); } while (0)
#define PH \
    __attribute__((address_space(1))) unsigned char* ws_g = (__attribute__((address_space(1))) unsigned char*)args.ws; asm volatile("" : "+s"(ws_g)); unsigned char* ws = (unsigned char*)ws_g; \
    __attribute__((address_space(1))) float* X_g = (__attribute__((address_space(1))) float*)args.out; asm volatile("" : "+s"(X_g)); float* X = (float*)X_g; \
    int tid = threadIdx.x; asm volatile("" : "+v"(tid)); const int lane = tid & 63, wave = __builtin_amdgcn_readfirstlane(tid >> 6); \
    int G = gridDim.x; asm volatile("" : "+s"(G)); const int bx = blockIdx.x; const int gw = bx * NWAVES + wave, NGW = G * NWAVES; const long gt = (long)bx * 512 + tid, NGT = (long)G * 512; \
    const float* const* TAB = (const float* const*)(ws + WS_TAB); float* SS = (float*)(ws + WS_SS); bf16r* XB = (bf16r*)(ws + WS_XB); bf16r* HB = (bf16r*)(ws + WS_BIG); bf16r* PROJ = (bf16r*)(ws + WS_BIG); \
    bf16r* GSCR = (bf16r*)(ws + WS_BIG); float* MERGED = (float*)(ws + WS_BIG + 32 * MiB); float* ACC = (float*)(ws + WS_ACC); bf16r* YATT = (bf16r*)(ws + WS_ACC); bf16r* YS5 = (bf16r*)(ws + WS_YS5); bf16r* YGLA = (bf16r*)(ws + WS_YGLA); \
    LAS unsigned char* ldsl = (LAS unsigned char*)lds; LAS float* scr = (LAS float*)(ldsl + wave * 16384); \
    (void)TAB; (void)SS; (void)XB; (void)HB; (void)PROJ; (void)GSCR; (void)MERGED; (void)ACC; (void)YATT; (void)YS5; (void)YGLA; (void)scr; (void)gw; (void)NGW; (void)gt; (void)NGT; (void)X; (void)lane;
    { PH
      if (bx == 0 && tid == 0) { const float** tw = (const float**)(ws + WS_TAB);
#pragma unroll
        for (int i = 0; i < 32; ++i) tw[i] = args.in[i]; } }
    { PH
        const float* xin = args.in[0];
        for (int m = gw; m < M; m += NGW) {
            const f32x4* xr = (const f32x4*)(xin + (size_t)m * 1024) + lane; f32x4* xo = (f32x4*)(X + (size_t)m * 1024) + lane;
            unsigned long long* o8 = (unsigned long long*)(XB + (size_t)m * 1024) + lane; float s = 0.f;
#pragma unroll
            for (int j = 0; j < 4; ++j) { const f32x4 v = xr[64 * j]; s += (v.x * v.x + v.y * v.y) + (v.z * v.z + v.w * v.w);
                o8[64 * j] = (unsigned long long)pk2(v.x, v.y) | ((unsigned long long)pk2(v.z, v.w) << 32); }
            s = wave_sum(s); if (lane < 16) SS[(size_t)m * 16 + lane] = lane == 0 ? s : 0.f;
        }
        for (long i = gt; i < 1024; i += NGT) { const int pos = (int)(i >> 4), fq_ = (int)(i & 15); float sn, cs; sincosf((float)pos * exp2f(-(float)fq_ * (13.287712379549449f / 16.0f)), &sn, &cs);
            float* rp = (float*)(ws + WS_ROPE); rp[2 * i] = cs; rp[2 * i + 1] = sn; }
    }
    GSYNC();

    { constexpr int l = 0;

        { PH
            const float* n1 = TAB[1] + l * 1024; const float* n2 = TAB[27] + l * 1024; const float* nm = TAB[5] + l * 1024;
            { const float* Wg = TAB[2] + (size_t)l * 1024 * FF; const float* Wu = TAB[3] + (size_t)l * 1024 * FF;
              conv_all([=](int k, int n) { const int ff = (n >> 8) * 128 + (n & 127); return ((n & 128) ? Wu : Wg) + (size_t)k * FF + ff; }, [=](int k) { return n1[k]; }, 1024, 5632, (bf16r*)(ws + W_GU1), scr, gw, NGW, lane); }
            { const float* Wd = TAB[4] + (size_t)l * FF * 1024;
              conv_all([=](int k, int n) { return Wd + (size_t)k * 1024 + n; }, [](int) { return 1.0f; }, FF, 1024, (bf16r*)(ws + W_D1), scr, gw, NGW, lane); }
            { const float* Wg = TAB[28] + (size_t)l * 1024 * FF; const float* Wu = TAB[29] + (size_t)l * 1024 * FF;
              conv_all([=](int k, int n) { const int ff = (n >> 8) * 128 + (n & 127); return ((n & 128) ? Wu : Wg) + (size_t)k * FF + ff; }, [=](int k) { return n2[k]; }, 1024, 5632, (bf16r*)(ws + W_GU2), scr, gw, NGW, lane); }
            { const float* Wd = TAB[30] + (size_t)l * FF * 1024;
              conv_all([=](int k, int n) { return Wd + (size_t)k * 1024 + n; }, [](int) { return 1.0f; }, FF, 1024, (bf16r*)(ws + W_D2), scr, gw, NGW, lane); }
            { const float* Wi = TAB[6] + (size_t)l * 1024 * 3360;
              conv_all([=](int k, int n) { const int sc = n < 2560 ? n : (n < 3328 ? n + 32 : (n < 3360 ? n - 3328 + 2560 : -1)); return sc >= 0 ? Wi + (size_t)k * 3360 + sc : (const float*)nullptr; }, [=](int k) { return nm[k]; }, 1024, NWIN, (bf16r*)(ws + W_IN), scr, gw, NGW, lane); }
            { const float* Wm = TAB[24] + (size_t)l * 1024 * 3072;
              conv_all([=](int k, int n) { return Wm + (size_t)k * 3072 + n; }, [=](int k) { return nm[k]; }, 1024, 3072, (bf16r*)(ws + W_MG), scr, gw, NGW, lane); }
            { const float* Wx = TAB[15] + (size_t)l * 512 * 512;
              conv_all([=](int k, int n) { return Wx + (size_t)k * 512 + n; }, [](int) { return 1.0f; }, 512, 512, (bf16r*)(ws + W_GLU), scr, gw, NGW, lane); }
#pragma unroll
            for (int b = 0; b < 3; ++b) { const float* Wx = TAB[21 + b] + (size_t)l * 512 * 1024;
              conv_all([=](int k, int n) { return Wx + (size_t)k * 1024 + n; }, [](int) { return 1.0f; }, 512, 1024, (bf16r*)(ws + W_BR) + (size_t)b * 1024 * 512, scr, gw, NGW, lane); }
            { const float* Wx = TAB[26] + (size_t)l * 1024 * 1024;
              conv_all([=](int k, int n) { return Wx + (size_t)k * 1024 + n; }, [](int) { return 1.0f; }, 1024, 1024, (bf16r*)(ws + W_OUT), scr, gw, NGW, lane); }
            { bf16r* W1T = (bf16r*)(ws + WS_W1T); bf16r* BTY = (bf16r*)(ws + WS_BTY); float* KT = (float*)(ws + WS_KT);
              __syncthreads();
              { LAS float* LP = (LAS float*)ldsl; LAS float* FB = LP + 1024; LAS float* CC = FB + 2048;
                for (int unit = bx; unit < 256; unit += G) { const int dq = unit & 3, dir = (unit >> 2) & 1, g = unit >> 3;
                  const size_t o1 = ((size_t)(l * 2 + dir) * 32 + g); const float dt = expf(TAB[9][o1]);
                  { const int p = tid & 63, d8 = tid >> 6; const float lre = TAB[7][o1 * 64 + p], lim = TAB[8][o1 * 64 + p];
                    const float ed = (float)(dq * 8 + d8); const float mg = expf(ed * lre * dt), an = ed * lim * dt;
                    LP[(d8 * 64 + p) * 2] = mg * cosf(an); LP[(d8 * 64 + p) * 2 + 1] = mg * sinf(an);
                    const float mag1 = expf(lre * dt), ang1 = lim * dt, lbr = mag1 * cosf(ang1), lbi = mag1 * sinf(ang1);
                    const float den = lre * lre + lim * lim, nr = lbr - 1.0f, ni = lbi, fr = (nr * lre + ni * lim) / den, fi = (ni * lre - nr * lim) / den;
#pragma unroll
                    for (int k = 0; k < 2; ++k) { const int hp = d8 * 2 + k; const float br = TAB[10][(o1 * 64 + p) * 16 + hp], bi = TAB[11][(o1 * 64 + p) * 16 + hp];
                        FB[(p * 16 + hp) * 2] = fr * br - fi * bi; FB[(p * 16 + hp) * 2 + 1] = fr * bi + fi * br;
                        CC[(hp * 64 + p) * 2] = TAB[12][(o1 * 16 + hp) * 64 + p]; CC[(hp * 64 + p) * 2 + 1] = TAB[13][(o1 * 16 + hp) * 64 + p]; } }
                  __syncthreads();
#pragma unroll
                  for (int k = 0; k < 4; ++k) { const int o = tid + 512 * k, hp = o & 15, h = (o >> 4) & 15, d8 = o >> 8; float acc = 0.f;
                      for (int p = 0; p < 64; ++p) { const float cr = CC[(h * 64 + p) * 2], ci = CC[(h * 64 + p) * 2 + 1], pr = LP[(d8 * 64 + p) * 2], pi = LP[(d8 * 64 + p) * 2 + 1];
                          const float wr = cr * pr - ci * pi, wi = cr * pi + ci * pr; acc += wr * FB[(p * 16 + hp) * 2] - wi * FB[(p * 16 + hp) * 2 + 1]; }
                      KT[((((size_t)(g * 2 + dir) * 32 + dq * 8 + d8) * 16 + h) * 16) + hp] = acc; }
                  __syncthreads(); } } }
        }
        GSYNC();
        { PH pg8::Gemm g{XB, (const bf16r*)(ws + W_GU1), M, 5632, 1024, 1024, 1024}; pg8::StaticOrder S; S.init(M, 5632, G, bx);
          pg8::EpiSwiGLU E{HB, SS + (size_t)((3 * l + 0) % 3) * M * 16, FF};
          pg8::gemm_phase<pg8::EpiSwiGLU, pg8::StaticOrder, true, true>(ldsl, g, S, E); }
        { PH
          if (bx >= 128) { const long gt2 = (long)(bx - 128) * 512 + tid, NGT2 = (long)(G - 128) * 512;
            { bf16r* W1T = (bf16r*)(ws + WS_W1T); bf16r* BTY = (bf16r*)(ws + WS_BTY);
              for (long i = gt2; i < 131072; i += NGT2) { const int jq = (int)i & 31, p = (int)(i >> 5) & 63, dir = (int)(i >> 11) & 1, g = (int)(i >> 12);
                const size_t o1 = ((size_t)(l * 2 + dir) * 32 + g);
                const float lre = TAB[7][o1 * 64 + p], lim = TAB[8][o1 * 64 + p], dt = expf(TAB[9][o1]);
                const float mag1 = expf(lre * dt), ang1 = lim * dt, lbr = mag1 * cosf(ang1), lbi = mag1 * sinf(ang1);
                const float den = lre * lre + lim * lim, nr = lbr - 1.0f, ni = lbi, fr = (nr * lre + ni * lim) / den, fi = (ni * lre - nr * lim) / den;
                { const float e1 = (float)(dir ? jq : 31 - jq); const float mg = expf(e1 * lre * dt), an = e1 * lim * dt, pr = mg * cosf(an), pi = mg * sinf(an);
                  const float wr = pr * fr - pi * fi, wi = pr * fi + pi * fr;
                  float re[16], im[16];
#pragma unroll
                  for (int h = 0; h < 16; ++h) { const float br = TAB[10][(o1 * 64 + p) * 16 + h], bi = TAB[11][(o1 * 64 + p) * 16 + h]; re[h] = wr * br - wi * bi; im[h] = wr * bi + wi * br; }
                  v4u* d0 = (v4u*)(W1T + ((size_t)(g * 256 + dir * 128 + 2 * p) * 512 + jq * 16)); v4u* d1 = (v4u*)(W1T + ((size_t)(g * 256 + dir * 128 + 2 * p + 1) * 512 + jq * 16));
                  d0[0] = (v4u){pk2(re[0], re[1]), pk2(re[2], re[3]), pk2(re[4], re[5]), pk2(re[6], re[7])}; d0[1] = (v4u){pk2(re[8], re[9]), pk2(re[10], re[11]), pk2(re[12], re[13]), pk2(re[14], re[15])};
                  d1[0] = (v4u){pk2(im[0], im[1]), pk2(im[2], im[3]), pk2(im[4], im[5]), pk2(im[6], im[7])}; d1[1] = (v4u){pk2(im[8], im[9]), pk2(im[10], im[11]), pk2(im[12], im[13]), pk2(im[14], im[15])}; }
                { const float e2 = (float)(dir ? 32 - jq : jq + 1); const float mg = expf(e2 * lre * dt), an = e2 * lim * dt, pr = mg * cosf(an), pi = mg * sinf(an);
#pragma unroll
                  for (int h = 0; h < 16; ++h) { const float cr = TAB[12][(o1 * 16 + h) * 64 + p], ci = TAB[13][(o1 * 16 + h) * 64 + p]; const float wre = cr * pr - ci * pi, wim = cr * pi + ci * pr;
                      *(unsigned*)(BTY + ((size_t)(g * 512 + jq * 16 + h) * 768 + dir * 128 + 2 * p)) = pk2(wre, -wim); } } }
            }
            {
            const float* KT = (const float*)(ws + WS_KT); bf16r* BTY = (bf16r*)(ws + WS_BTY); const float* dsk = TAB[14] + l * 512;
            for (long it = gt2; it < 524288; it += NGT2) { const int j = (int)it & 31, n = (int)(it >> 5) & 511, g = (int)(it >> 14); const int i = n >> 4, h = n & 15;
                const float* kf = KT + (size_t)((g * 2 + 0) * 32) * 256 + h * 16; const float* kb = KT + (size_t)((g * 2 + 1) * 32) * 256 + h * 16;
                float v[16];
                if (i > j) {
#pragma unroll
                    for (int q = 0; q < 4; ++q) { const f32x4 x = *(const f32x4*)(kf + (i - j) * 256 + 4 * q); v[4 * q] = x[0]; v[4 * q + 1] = x[1]; v[4 * q + 2] = x[2]; v[4 * q + 3] = x[3]; }
                } else if (j > i) {
#pragma unroll
                    for (int q = 0; q < 4; ++q) { const f32x4 x = *(const f32x4*)(kb + (j - i) * 256 + 4 * q); v[4 * q] = x[0]; v[4 * q + 1] = x[1]; v[4 * q + 2] = x[2]; v[4 * q + 3] = x[3]; }
                } else { const float dd = dsk[16 * g + h];
#pragma unroll
                    for (int q = 0; q < 4; ++q) { const f32x4 x = *(const f32x4*)(kf + 4 * q) + *(const f32x4*)(kb + 4 * q); v[4 * q] = x[0]; v[4 * q + 1] = x[1]; v[4 * q + 2] = x[2]; v[4 * q + 3] = x[3]; }
#pragma unroll
                    for (int hp = 0; hp < 16; ++hp) v[hp] += (hp == h) ? dd : 0.f; }
                v4u* dst = (v4u*)(BTY + ((size_t)(g * 512 + n) * 768 + 256 + j * 16));
                dst[0] = (v4u){pk2(v[0], v[1]), pk2(v[2], v[3]), pk2(v[4], v[5]), pk2(v[6], v[7])}; dst[1] = (v4u){pk2(v[8], v[9]), pk2(v[10], v[11]), pk2(v[12], v[13]), pk2(v[14], v[15])}; }
            }
          }
        }
        GSYNC();
        { PH pg8::Gemm g{HB, (const bf16r*)(ws + W_D1), M, 1024, FF, FF, FF}; pg8::StaticOrder S; S.init(M, 1024, G, bx);
          pg8::EpiResid E{(l == 0 ? TAB[0] : (const float*)X), X, XB, SS + (size_t)((3 * l + 1) % 3) * M * 16, 0.5f};
          pg8::gemm_phase<pg8::EpiResid, pg8::StaticOrder, true, true>(ldsl, g, S, E); }
        GSYNC();
        if (l == STOP_L && STOP_P == 2) { fin_buf = 1; goto final_norm; }
        { PH pg8::Gemm g{XB, (const bf16r*)(ws + W_IN), M, 2048, 1024, 1024, 1024}; pg8::StaticOrder S; S.init(M, 2048, G, bx);
          pg8::EpiInSplit E{PROJ, NPROJ, (bf16r*)(ws + WS_UG), SS + (size_t)((3 * l + 1) % 3) * M * 16};
          pg8::gemm_phase<pg8::EpiInSplit, pg8::StaticOrder, true, true>(ldsl, g, S, E); }
        GSYNC();
        { PH pg8::Gemm g{(const bf16r*)(ws + WS_UG) + 256, (const bf16r*)(ws + WS_W1T), 512, 256, 512, 768, 512, (size_t)512 * 768 * 2, (size_t)256 * 512 * 2}; pg8::BatchOrder S; S.init(2, 1, 32, G, bx);
          pg8::EpiF32B E{(float*)(ws + WS_E), 256, (size_t)512 * 256};
          pg8::gemm_phase<pg8::EpiF32B, pg8::BatchOrder, true, true>(ldsl, g, S, E); }
        { PH pg8::Gemm g{XB, (const bf16r*)(ws + W_IN) + (size_t)3072 * 1024, M, 512, 1024, 1024, 1024}; pg8::StaticOrder S; S.init(M, 512, G, (bx + G - 64) % G);
          pg8::EpiScaleBf16 E{PROJ + 2560, NPROJ, SS + (size_t)((3 * l + 1) % 3) * M * 16};
          pg8::gemm_phase<pg8::EpiScaleBf16, pg8::StaticOrder, true, true>(ldsl, g, S, E); }
        GSYNC();
        { PH
            const float* E = (const float*)(ws + WS_E); bf16r* UG = (bf16r*)(ws + WS_UG);
            for (long i = gt; i < 16384; i += NGT) { const int p = (int)i & 63, bb = (int)(i >> 6) & 3, dir = (int)(i >> 8) & 1, g = (int)(i >> 9);
                const size_t o1 = ((size_t)(l * 2 + dir) * 32 + g);
                const float lre = TAB[7][o1 * 64 + p], lim = TAB[8][o1 * 64 + p], dt = expf(TAB[9][o1]);
                const float mg = expf(32.0f * lre * dt), an = 32.0f * lim * dt, ar = mg * cosf(an), ai = mg * sinf(an);
                float xr = 0.f, xi = 0.f;
                for (int c0 = 0; c0 < 128; c0 += 8) { float er[8], ei[8];
#pragma unroll
                    for (int k = 0; k < 8; ++k) { const int c = dir ? 127 - (c0 + k) : c0 + k; const float* pe = E + ((size_t)(g * 512 + bb * 128 + c) * 256 + dir * 128 + 2 * p); er[k] = pe[0]; ei[k] = pe[1]; }
#pragma unroll
                    for (int k = 0; k < 8; ++k) { const int c = dir ? 127 - (c0 + k) : c0 + k;
                        *(unsigned*)(UG + ((size_t)(g * 512 + bb * 128 + c) * 768 + dir * 128 + 2 * p)) = pk2(xr, xi);
                        const float nr = ar * xr - ai * xi + er[k], ni = ar * xi + ai * xr + ei[k]; xr = nr; xi = ni; } } }
        }
        GSYNC();
        { PH pg8::Gemm g{(const bf16r*)(ws + WS_UG), (const bf16r*)(ws + WS_BTY), 512, 512, 768, 768, 768, (size_t)512 * 768 * 2, (size_t)512 * 768 * 2}; pg8::BatchOrder S; S.init(2, 2, 32, G, bx);
          pg8::EpiS5Y E{(bf16r*)(ws + WS_E)};
          pg8::gemm_phase<pg8::EpiS5Y, pg8::BatchOrder, true, true>(ldsl, g, S, E); }
        { PH pg8::Gemm g{XB, (const bf16r*)(ws + W_IN) + (size_t)2048 * 1024, M, 512, 1024, 1024, 1024}; pg8::StaticOrder S; S.init(M, 512, G, (bx + G - 128) % G);
          pg8::EpiScaleBf16 E{PROJ + 1536, NPROJ, SS + (size_t)((3 * l + 1) % 3) * M * 16};
          pg8::gemm_phase<pg8::EpiScaleBf16, pg8::StaticOrder, true, true>(ldsl, g, S, E); }
        GSYNC();
        { PH pg8::Gemm g{(const bf16r*)(ws + WS_E), (const bf16r*)(ws + W_GLU), M, 512, 512, 512, 512}; pg8::StaticOrder S; S.init(M, 512, G, bx);
          pg8::EpiGlu E{(const bf16r*)(ws + WS_E), 512, YS5, 512};
          pg8::gemm_phase<pg8::EpiGlu, pg8::StaticOrder, true, true>(ldsl, g, S, E); }
        { PH pg8::Gemm g{XB, (const bf16r*)(ws + W_IN) + (size_t)2560 * 1024, M, 512, 1024, 1024, 1024}; pg8::StaticOrder S; S.init(M, 512, G, (bx + G - 128) % G);
          pg8::EpiScaleBf16 E{PROJ + 2048, NPROJ, SS + (size_t)((3 * l + 1) % 3) * M * 16};
          pg8::gemm_phase<pg8::EpiScaleBf16, pg8::StaticOrder, true, true>(ldsl, g, S, E); }
        GSYNC();
        { PH
          for (int unit = bx; unit < 256; unit += G) gla_passA_mfma(TAB, l, unit, tid, PROJ, (bf16r*)(ws + WS_GE), (float*)(ws + WS_GDT), ldsl);
          __syncthreads();
          {
            const float* qg = TAB[19] + l * 64; const float* kg = TAB[20] + l * 64;
            const int d = lane, e = d & 31, fi_ = e & 15; const bool second = e >= 16;
            const float* ROPE = (const float*)(ws + WS_ROPE);
            for (long it = gw; it < (long)M * 10; it += NGW) {
                const int row = (int)(it / 10), j = (int)(it % 10); const int tt = row & (SEQ - 1);
                bf16r* px = PROJ + (size_t)row * NPROJ + (j < 8 ? PC_AQ + 64 * j : PC_AK + 64 * (j - 8)) + d;
                const float x = bf2f(*px); const float ssq = wave_sum(x * x);
                const float gain = j < 8 ? qg[d] : kg[d];
                const float y = x * rsqrtf(ssq * (1.0f / 64.0f) + 1e-6f) * gain;
                const int posi = (d < 32) ? (tt >> 6) : (tt & 63);
                const float cs = ROPE[(posi * 16 + fi_) * 2], sn = ROPE[(posi * 16 + fi_) * 2 + 1];
                const float partner = __shfl_xor(y, 16);
                float o = second ? (y * cs + partner * sn) : (y * cs - partner * sn);
                if (j < 8) o *= 0.125f * 1.4426950408889634f;
                *px = (bf16r)f2bf(o);
            }
          }
        }
        GSYNC();
        { PH
          for (int unit = bx; unit < 256; unit += G) gla_passB_mfma(TAB, l, unit, tid, PROJ, ACC, YGLA, (const bf16r*)(ws + WS_GE), (const float*)(ws + WS_GDT), ldsl); }
        GSYNC();
        { PH
            const float* gn = TAB[18] + l * 128;
            for (long it = gw; it < (long)M * 4; it += NGW) { const int row = (int)(it >> 2), h = (int)(it & 3);
                const unsigned oa = *(const unsigned*)((const bf16r*)ACC + (size_t)row * 512 + h * 128 + 2 * lane); const unsigned ob = *(const unsigned*)(YGLA + (size_t)row * 512 + h * 128 + 2 * lane); const float o0 = pg8::bflo(oa) + pg8::bflo(ob), o1 = pg8::bfhi(oa) + pg8::bfhi(ob);
                const float ssq = wave_sum(o0 * o0 + o1 * o1); const float r = rsqrtf(ssq * (1.0f / 128.0f) + 1e-6f);
                const unsigned gg = *(const unsigned*)(PROJ + (size_t)row * NPROJ + PC_GG + h * 128 + 2 * lane);
                const float y0 = o0 * r * gn[2 * lane] * silu_(pg8::bflo(gg)), y1 = o1 * r * gn[2 * lane + 1] * silu_(pg8::bfhi(gg));
                *(unsigned*)(YGLA + (size_t)row * 512 + h * 128 + 2 * lane) = pk2(y0, y1); }
        }
        GSYNC();
#ifndef NO_ATT
        { PH
            const attn_body::AttnTensors AT{(const attn_body::bf16*)(PROJ + PC_AQ), (const attn_body::bf16*)(PROJ + PC_AK), (const attn_body::bf16*)(PROJ + PC_AV), (attn_body::bf16*)YATT};
            const attn_body::StaticOrder S(G, bx);
            attn_body::attn_phase<attn_body::StaticOrder>((char*)lds, AT, S);
        }
#endif
        GSYNC();
#ifndef NO_MERGE
        { PH
            { pg8::Gemm g{XB, (const bf16r*)(ws + W_MG), M, 1024, 1024, 1024, 1024, 0, (size_t)1024 * 1024 * 2}; pg8::TileBatchOrder S; S.init(M, 1024, 3, G, bx);
              pg8::EpiGate3 E{GSCR, TAB[25] + l * 3072, SS + (size_t)((3 * l + 1) % 3) * M * 16};
              pg8::gemm_phase<pg8::EpiGate3, pg8::TileBatchOrder, true, true>(ldsl, g, S, E); }
            { pg8::Gemm g{YS5, (const bf16r*)(ws + W_BR), M, 1024, 512, 512, 512, 0, (size_t)1024 * 512 * 2, {0, (size_t)(WS_YGLA - WS_YS5), (size_t)(WS_ACC - WS_YS5)}, 1}; pg8::TileBatchOrder S; S.init(M, 1024, 3, G, bx);
              pg8::EpiMerge3 E{GSCR, (bf16r*)(ws + WS_MG16)};
              pg8::gemm_phase<pg8::EpiMerge3, pg8::TileBatchOrder, true, true>(ldsl, g, S, E); }
        }
#endif
        GSYNC();
        { PH pg8::Gemm g{GSCR, (const bf16r*)(ws + W_OUT), M, 1024, 1024, 1024, 1024}; pg8::StaticOrder S; S.init(M, 1024, G, bx);
          pg8::EpiResid E{X, X, XB, SS + (size_t)((3 * l + 2) % 3) * M * 16, 1.0f};
          pg8::gemm_phase<pg8::EpiResid, pg8::StaticOrder, true, true>(ldsl, g, S, E); }
        GSYNC();
        if (l == STOP_L && STOP_P == 10) { fin_buf = 2; goto final_norm; }
        { PH pg8::Gemm g{XB, (const bf16r*)(ws + W_GU2), M, 5632, 1024, 1024, 1024}; pg8::StaticOrder S; S.init(M, 5632, G, bx);
          pg8::EpiSwiGLU E{HB, SS + (size_t)((3 * l + 2) % 3) * M * 16, FF};
          pg8::gemm_phase<pg8::EpiSwiGLU, pg8::StaticOrder, true, true>(ldsl, g, S, E); }
        GSYNC();
        { PH pg8::Gemm g{HB, (const bf16r*)(ws + W_D2), M, 1024, FF, FF, FF}; pg8::StaticOrder S; S.init(M, 1024, G, bx);
          pg8::EpiResid E{X, X, (l == 1 ? (bf16r*)nullptr : XB), SS + (size_t)((3 * l + 3) % 3) * M * 16, 0.5f};
          pg8::gemm_phase<pg8::EpiResid, pg8::StaticOrder, true, true>(ldsl, g, S, E); }
        GSYNC();
        if (l == STOP_L && STOP_P == 12) { fin_buf = 0; goto final_norm; }

    }
    { constexpr int l = 1;

        { PH
            const float* n1 = TAB[1] + l * 1024; const float* n2 = TAB[27] + l * 1024; const float* nm = TAB[5] + l * 1024;
            { const float* Wg = TAB[2] + (size_t)l * 1024 * FF; const float* Wu = TAB[3] + (size_t)l * 1024 * FF;
              conv_all([=](int k, int n) { const int ff = (n >> 8) * 128 + (n & 127); return ((n & 128) ? Wu : Wg) + (size_t)k * FF + ff; }, [=](int k) { return n1[k]; }, 1024, 5632, (bf16r*)(ws + W_GU1), scr, gw, NGW, lane); }
            { const float* Wd = TAB[4] + (size_t)l * FF * 1024;
              conv_all([=](int k, int n) { return Wd + (size_t)k * 1024 + n; }, [](int) { return 1.0f; }, FF, 1024, (bf16r*)(ws + W_D1), scr, gw, NGW, lane); }
            { const float* Wg = TAB[28] + (size_t)l * 1024 * FF; const float* Wu = TAB[29] + (size_t)l * 1024 * FF;
              conv_all([=](int k, int n) { const int ff = (n >> 8) * 128 + (n & 127); return ((n & 128) ? Wu : Wg) + (size_t)k * FF + ff; }, [=](int k) { return n2[k]; }, 1024, 5632, (bf16r*)(ws + W_GU2), scr, gw, NGW, lane); }
            { const float* Wd = TAB[30] + (size_t)l * FF * 1024;
              conv_all([=](int k, int n) { return Wd + (size_t)k * 1024 + n; }, [](int) { return 1.0f; }, FF, 1024, (bf16r*)(ws + W_D2), scr, gw, NGW, lane); }
            { const float* Wi = TAB[6] + (size_t)l * 1024 * 3360;
              conv_all([=](int k, int n) { const int sc = n < 2560 ? n : (n < 3328 ? n + 32 : (n < 3360 ? n - 3328 + 2560 : -1)); return sc >= 0 ? Wi + (size_t)k * 3360 + sc : (const float*)nullptr; }, [=](int k) { return nm[k]; }, 1024, NWIN, (bf16r*)(ws + W_IN), scr, gw, NGW, lane); }
            { const float* Wm = TAB[24] + (size_t)l * 1024 * 3072;
              conv_all([=](int k, int n) { return Wm + (size_t)k * 3072 + n; }, [=](int k) { return nm[k]; }, 1024, 3072, (bf16r*)(ws + W_MG), scr, gw, NGW, lane); }
            { const float* Wx = TAB[15] + (size_t)l * 512 * 512;
              conv_all([=](int k, int n) { return Wx + (size_t)k * 512 + n; }, [](int) { return 1.0f; }, 512, 512, (bf16r*)(ws + W_GLU), scr, gw, NGW, lane); }
#pragma unroll
            for (int b = 0; b < 3; ++b) { const float* Wx = TAB[21 + b] + (size_t)l * 512 * 1024;
              conv_all([=](int k, int n) { return Wx + (size_t)k * 1024 + n; }, [](int) { return 1.0f; }, 512, 1024, (bf16r*)(ws + W_BR) + (size_t)b * 1024 * 512, scr, gw, NGW, lane); }
            { const float* Wx = TAB[26] + (size_t)l * 1024 * 1024;
              conv_all([=](int k, int n) { return Wx + (size_t)k * 1024 + n; }, [](int) { return 1.0f; }, 1024, 1024, (bf16r*)(ws + W_OUT), scr, gw, NGW, lane); }
            { bf16r* W1T = (bf16r*)(ws + WS_W1T); bf16r* BTY = (bf16r*)(ws + WS_BTY); float* KT = (float*)(ws + WS_KT);
              __syncthreads();
              { LAS float* LP = (LAS float*)ldsl; LAS float* FB = LP + 1024; LAS float* CC = FB + 2048;
                for (int unit = bx; unit < 256; unit += G) { const int dq = unit & 3, dir = (unit >> 2) & 1, g = unit >> 3;
                  const size_t o1 = ((size_t)(l * 2 + dir) * 32 + g); const float dt = expf(TAB[9][o1]);
                  { const int p = tid & 63, d8 = tid >> 6; const float lre = TAB[7][o1 * 64 + p], lim = TAB[8][o1 * 64 + p];
                    const float ed = (float)(dq * 8 + d8); const float mg = expf(ed * lre * dt), an = ed * lim * dt;
                    LP[(d8 * 64 + p) * 2] = mg * cosf(an); LP[(d8 * 64 + p) * 2 + 1] = mg * sinf(an);
                    const float mag1 = expf(lre * dt), ang1 = lim * dt, lbr = mag1 * cosf(ang1), lbi = mag1 * sinf(ang1);
                    const float den = lre * lre + lim * lim, nr = lbr - 1.0f, ni = lbi, fr = (nr * lre + ni * lim) / den, fi = (ni * lre - nr * lim) / den;
#pragma unroll
                    for (int k = 0; k < 2; ++k) { const int hp = d8 * 2 + k; const float br = TAB[10][(o1 * 64 + p) * 16 + hp], bi = TAB[11][(o1 * 64 + p) * 16 + hp];
                        FB[(p * 16 + hp) * 2] = fr * br - fi * bi; FB[(p * 16 + hp) * 2 + 1] = fr * bi + fi * br;
                        CC[(hp * 64 + p) * 2] = TAB[12][(o1 * 16 + hp) * 64 + p]; CC[(hp * 64 + p) * 2 + 1] = TAB[13][(o1 * 16 + hp) * 64 + p]; } }
                  __syncthreads();
#pragma unroll
                  for (int k = 0; k < 4; ++k) { const int o = tid + 512 * k, hp = o & 15, h = (o >> 4) & 15, d8 = o >> 8; float acc = 0.f;
                      for (int p = 0; p < 64; ++p) { const float cr = CC[(h * 64 + p) * 2], ci = CC[(h * 64 + p) * 2 + 1], pr = LP[(d8 * 64 + p) * 2], pi = LP[(d8 * 64 + p) * 2 + 1];
                          const float wr = cr * pr - ci * pi, wi = cr * pi + ci * pr; acc += wr * FB[(p * 16 + hp) * 2] - wi * FB[(p * 16 + hp) * 2 + 1]; }
                      KT[((((size_t)(g * 2 + dir) * 32 + dq * 8 + d8) * 16 + h) * 16) + hp] = acc; }
                  __syncthreads(); } } }
        }
        GSYNC();
        { PH pg8::Gemm g{XB, (const bf16r*)(ws + W_GU1), M, 5632, 1024, 1024, 1024}; pg8::StaticOrder S; S.init(M, 5632, G, bx);
          pg8::EpiSwiGLU E{HB, SS + (size_t)((3 * l + 0) % 3) * M * 16, FF};
          pg8::gemm_phase<pg8::EpiSwiGLU, pg8::StaticOrder, true, true>(ldsl, g, S, E); }
        { PH
          if (bx >= 128) { const long gt2 = (long)(bx - 128) * 512 + tid, NGT2 = (long)(G - 128) * 512;
            { bf16r* W1T = (bf16r*)(ws + WS_W1T); bf16r* BTY = (bf16r*)(ws + WS_BTY);
              for (long i = gt2; i < 131072; i += NGT2) { const int jq = (int)i & 31, p = (int)(i >> 5) & 63, dir = (int)(i >> 11) & 1, g = (int)(i >> 12);
                const size_t o1 = ((size_t)(l * 2 + dir) * 32 + g);
                const float lre = TAB[7][o1 * 64 + p], lim = TAB[8][o1 * 64 + p], dt = expf(TAB[9][o1]);
                const float mag1 = expf(lre * dt), ang1 = lim * dt, lbr = mag1 * cosf(ang1), lbi = mag1 * sinf(ang1);
                const float den = lre * lre + lim * lim, nr = lbr - 1.0f, ni = lbi, fr = (nr * lre + ni * lim) / den, fi = (ni * lre - nr * lim) / den;
                { const float e1 = (float)(dir ? jq : 31 - jq); const float mg = expf(e1 * lre * dt), an = e1 * lim * dt, pr = mg * cosf(an), pi = mg * sinf(an);
                  const float wr = pr * fr - pi * fi, wi = pr * fi + pi * fr;
                  float re[16], im[16];
#pragma unroll
                  for (int h = 0; h < 16; ++h) { const float br = TAB[10][(o1 * 64 + p) * 16 + h], bi = TAB[11][(o1 * 64 + p) * 16 + h]; re[h] = wr * br - wi * bi; im[h] = wr * bi + wi * br; }
                  v4u* d0 = (v4u*)(W1T + ((size_t)(g * 256 + dir * 128 + 2 * p) * 512 + jq * 16)); v4u* d1 = (v4u*)(W1T + ((size_t)(g * 256 + dir * 128 + 2 * p + 1) * 512 + jq * 16));
                  d0[0] = (v4u){pk2(re[0], re[1]), pk2(re[2], re[3]), pk2(re[4], re[5]), pk2(re[6], re[7])}; d0[1] = (v4u){pk2(re[8], re[9]), pk2(re[10], re[11]), pk2(re[12], re[13]), pk2(re[14], re[15])};
                  d1[0] = (v4u){pk2(im[0], im[1]), pk2(im[2], im[3]), pk2(im[4], im[5]), pk2(im[6], im[7])}; d1[1] = (v4u){pk2(im[8], im[9]), pk2(im[10], im[11]), pk2(im[12], im[13]), pk2(im[14], im[15])}; }
                { const float e2 = (float)(dir ? 32 - jq : jq + 1); const float mg = expf(e2 * lre * dt), an = e2 * lim * dt, pr = mg * cosf(an), pi = mg * sinf(an);
#pragma unroll
                  for (int h = 0; h < 16; ++h) { const float cr = TAB[12][(o1 * 16 + h) * 64 + p], ci = TAB[13][(o1 * 16 + h) * 64 + p]; const float wre = cr * pr - ci * pi, wim = cr * pi + ci * pr;
                      *(unsigned*)(BTY + ((size_t)(g * 512 + jq * 16 + h) * 768 + dir * 128 + 2 * p)) = pk2(wre, -wim); } } }
            }
            {
            const float* KT = (const float*)(ws + WS_KT); bf16r* BTY = (bf16r*)(ws + WS_BTY); const float* dsk = TAB[14] + l * 512;
            for (long it = gt2; it < 524288; it += NGT2) { const int j = (int)it & 31, n = (int)(it >> 5) & 511, g = (int)(it >> 14); const int i = n >> 4, h = n & 15;
                const float* kf = KT + (size_t)((g * 2 + 0) * 32) * 256 + h * 16; const float* kb = KT + (size_t)((g * 2 + 1) * 32) * 256 + h * 16;
                float v[16];
                if (i > j) {
#pragma unroll
                    for (int q = 0; q < 4; ++q) { const f32x4 x = *(const f32x4*)(kf + (i - j) * 256 + 4 * q); v[4 * q] = x[0]; v[4 * q + 1] = x[1]; v[4 * q + 2] = x[2]; v[4 * q + 3] = x[3]; }
                } else if (j > i) {
#pragma unroll
                    for (int q = 0; q < 4; ++q) { const f32x4 x = *(const f32x4*)(kb + (j - i) * 256 + 4 * q); v[4 * q] = x[0]; v[4 * q + 1] = x[1]; v[4 * q + 2] = x[2]; v[4 * q + 3] = x[3]; }
                } else { const float dd = dsk[16 * g + h];
#pragma unroll
                    for (int q = 0; q < 4; ++q) { const f32x4 x = *(const f32x4*)(kf + 4 * q) + *(const f32x4*)(kb + 4 * q); v[4 * q] = x[0]; v[4 * q + 1] = x[1]; v[4 * q + 2] = x[2]; v[4 * q + 3] = x[3]; }
#pragma unroll
                    for (int hp = 0; hp < 16; ++hp) v[hp] += (hp == h) ? dd : 0.f; }
                v4u* dst = (v4u*)(BTY + ((size_t)(g * 512 + n) * 768 + 256 + j * 16));
                dst[0] = (v4u){pk2(v[0], v[1]), pk2(v[2], v[3]), pk2(v[4], v[5]), pk2(v[6], v[7])}; dst[1] = (v4u){pk2(v[8], v[9]), pk2(v[10], v[11]), pk2(v[12], v[13]), pk2(v[14], v[15])}; }
            }
          }
        }
        GSYNC();
        { PH pg8::Gemm g{HB, (const bf16r*)(ws + W_D1), M, 1024, FF, FF, FF}; pg8::StaticOrder S; S.init(M, 1024, G, bx);
          pg8::EpiResid E{(l == 0 ? TAB[0] : (const float*)X), X, XB, SS + (size_t)((3 * l + 1) % 3) * M * 16, 0.5f};
          pg8::gemm_phase<pg8::EpiResid, pg8::StaticOrder, true, true>(ldsl, g, S, E); }
        GSYNC();
        if (l == STOP_L && STOP_P == 2) { fin_buf = 1; goto final_norm; }
        { PH pg8::Gemm g{XB, (const bf16r*)(ws + W_IN), M, 2048, 1024, 1024, 1024}; pg8::StaticOrder S; S.init(M, 2048, G, bx);
          pg8::EpiInSplit E{PROJ, NPROJ, (bf16r*)(ws + WS_UG), SS + (size_t)((3 * l + 1) % 3) * M * 16};
          pg8::gemm_phase<pg8::EpiInSplit, pg8::StaticOrder, true, true>(ldsl, g, S, E); }
        GSYNC();
        { PH pg8::Gemm g{(const bf16r*)(ws + WS_UG) + 256, (const bf16r*)(ws + WS_W1T), 512, 256, 512, 768, 512, (size_t)512 * 768 * 2, (size_t)256 * 512 * 2}; pg8::BatchOrder S; S.init(2, 1, 32, G, bx);
          pg8::EpiF32B E{(float*)(ws + WS_E), 256, (size_t)512 * 256};
          pg8::gemm_phase<pg8::EpiF32B, pg8::BatchOrder, true, true>(ldsl, g, S, E); }
        { PH pg8::Gemm g{XB, (const bf16r*)(ws + W_IN) + (size_t)3072 * 1024, M, 512, 1024, 1024, 1024}; pg8::StaticOrder S; S.init(M, 512, G, (bx + G - 64) % G);
          pg8::EpiScaleBf16 E{PROJ + 2560, NPROJ, SS + (size_t)((3 * l + 1) % 3) * M * 16};
          pg8::gemm_phase<pg8::EpiScaleBf16, pg8::StaticOrder, true, true>(ldsl, g, S, E); }
        GSYNC();
        { PH
            const float* E = (const float*)(ws + WS_E); bf16r* UG = (bf16r*)(ws + WS_UG);
            for (long i = gt; i < 16384; i += NGT) { const int p = (int)i & 63, bb = (int)(i >> 6) & 3, dir = (int)(i >> 8) & 1, g = (int)(i >> 9);
                const size_t o1 = ((size_t)(l * 2 + dir) * 32 + g);
                const float lre = TAB[7][o1 * 64 + p], lim = TAB[8][o1 * 64 + p], dt = expf(TAB[9][o1]);
                const float mg = expf(32.0f * lre * dt), an = 32.0f * lim * dt, ar = mg * cosf(an), ai = mg * sinf(an);
                float xr = 0.f, xi = 0.f;
                for (int c0 = 0; c0 < 128; c0 += 8) { float er[8], ei[8];
#pragma unroll
                    for (int k = 0; k < 8; ++k) { const int c = dir ? 127 - (c0 + k) : c0 + k; const float* pe = E + ((size_t)(g * 512 + bb * 128 + c) * 256 + dir * 128 + 2 * p); er[k] = pe[0]; ei[k] = pe[1]; }
#pragma unroll
                    for (int k = 0; k < 8; ++k) { const int c = dir ? 127 - (c0 + k) : c0 + k;
                        *(unsigned*)(UG + ((size_t)(g * 512 + bb * 128 + c) * 768 + dir * 128 + 2 * p)) = pk2(xr, xi);
                        const float nr = ar * xr - ai * xi + er[k], ni = ar * xi + ai * xr + ei[k]; xr = nr; xi = ni; } } }
        }
        GSYNC();
        { PH pg8::Gemm g{(const bf16r*)(ws + WS_UG), (const bf16r*)(ws + WS_BTY), 512, 512, 768, 768, 768, (size_t)512 * 768 * 2, (size_t)512 * 768 * 2}; pg8::BatchOrder S; S.init(2, 2, 32, G, bx);
          pg8::EpiS5Y E{(bf16r*)(ws + WS_E)};
          pg8::gemm_phase<pg8::EpiS5Y, pg8::BatchOrder, true, true>(ldsl, g, S, E); }
        { PH pg8::Gemm g{XB, (const bf16r*)(ws + W_IN) + (size_t)2048 * 1024, M, 512, 1024, 1024, 1024}; pg8::StaticOrder S; S.init(M, 512, G, (bx + G - 128) % G);
          pg8::EpiScaleBf16 E{PROJ + 1536, NPROJ, SS + (size_t)((3 * l + 1) % 3) * M * 16};
          pg8::gemm_phase<pg8::EpiScaleBf16, pg8::StaticOrder, true, true>(ldsl, g, S, E); }
        GSYNC();
        { PH pg8::Gemm g{(const bf16r*)(ws + WS_E), (const bf16r*)(ws + W_GLU), M, 512, 512, 512, 512}; pg8::StaticOrder S; S.init(M, 512, G, bx);
          pg8::EpiGlu E{(const bf16r*)(ws + WS_E), 512, YS5, 512};
          pg8::gemm_phase<pg8::EpiGlu, pg8::StaticOrder, true, true>(ldsl, g, S, E); }
        { PH pg8::Gemm g{XB, (const bf16r*)(ws + W_IN) + (size_t)2560 * 1024, M, 512, 1024, 1024, 1024}; pg8::StaticOrder S; S.init(M, 512, G, (bx + G - 128) % G);
          pg8::EpiScaleBf16 E{PROJ + 2048, NPROJ, SS + (size_t)((3 * l + 1) % 3) * M * 16};
          pg8::gemm_phase<pg8::EpiScaleBf16, pg8::StaticOrder, true, true>(ldsl, g, S, E); }
        GSYNC();
        { PH
          for (int unit = bx; unit < 256; unit += G) gla_passA_mfma(TAB, l, unit, tid, PROJ, (bf16r*)(ws + WS_GE), (float*)(ws + WS_GDT), ldsl);
          __syncthreads();
          {
            const float* qg = TAB[19] + l * 64; const float* kg = TAB[20] + l * 64;
            const int d = lane, e = d & 31, fi_ = e & 15; const bool second = e >= 16;
            const float* ROPE = (const float*)(ws + WS_ROPE);
            for (long it = gw; it < (long)M * 10; it += NGW) {
                const int row = (int)(it / 10), j = (int)(it % 10); const int tt = row & (SEQ - 1);
                bf16r* px = PROJ + (size_t)row * NPROJ + (j < 8 ? PC_AQ + 64 * j : PC_AK + 64 * (j - 8)) + d;
                const float x = bf2f(*px); const float ssq = wave_sum(x * x);
                const float gain = j < 8 ? qg[d] : kg[d];
                const float y = x * rsqrtf(ssq * (1.0f / 64.0f) + 1e-6f) * gain;
                const int posi = (d < 32) ? (tt >> 6) : (tt & 63);
                const float cs = ROPE[(posi * 16 + fi_) * 2], sn = ROPE[(posi * 16 + fi_) * 2 + 1];
                const float partner = __shfl_xor(y, 16);
                float o = second ? (y * cs + partner * sn) : (y * cs - partner * sn);
                if (j < 8) o *= 0.125f * 1.4426950408889634f;
                *px = (bf16r)f2bf(o);
            }
          }
        }
        GSYNC();
        { PH
          for (int unit = bx; unit < 256; unit += G) gla_passB_mfma(TAB, l, unit, tid, PROJ, ACC, YGLA, (const bf16r*)(ws + WS_GE), (const float*)(ws + WS_GDT), ldsl); }
        GSYNC();
        { PH
            const float* gn = TAB[18] + l * 128;
            for (long it = gw; it < (long)M * 4; it += NGW) { const int row = (int)(it >> 2), h = (int)(it & 3);
                const unsigned oa = *(const unsigned*)((const bf16r*)ACC + (size_t)row * 512 + h * 128 + 2 * lane); const unsigned ob = *(const unsigned*)(YGLA + (size_t)row * 512 + h * 128 + 2 * lane); const float o0 = pg8::bflo(oa) + pg8::bflo(ob), o1 = pg8::bfhi(oa) + pg8::bfhi(ob);
                const float ssq = wave_sum(o0 * o0 + o1 * o1); const float r = rsqrtf(ssq * (1.0f / 128.0f) + 1e-6f);
                const unsigned gg = *(const unsigned*)(PROJ + (size_t)row * NPROJ + PC_GG + h * 128 + 2 * lane);
                const float y0 = o0 * r * gn[2 * lane] * silu_(pg8::bflo(gg)), y1 = o1 * r * gn[2 * lane + 1] * silu_(pg8::bfhi(gg));
                *(unsigned*)(YGLA + (size_t)row * 512 + h * 128 + 2 * lane) = pk2(y0, y1); }
        }
        GSYNC();
#ifndef NO_ATT
        { PH
            const attn_body::AttnTensors AT{(const attn_body::bf16*)(PROJ + PC_AQ), (const attn_body::bf16*)(PROJ + PC_AK), (const attn_body::bf16*)(PROJ + PC_AV), (attn_body::bf16*)YATT};
            const attn_body::StaticOrder S(G, bx);
            attn_body::attn_phase<attn_body::StaticOrder>((char*)lds, AT, S);
        }
#endif
        GSYNC();
#ifndef NO_MERGE
        { PH
            { pg8::Gemm g{XB, (const bf16r*)(ws + W_MG), M, 1024, 1024, 1024, 1024, 0, (size_t)1024 * 1024 * 2}; pg8::TileBatchOrder S; S.init(M, 1024, 3, G, bx);
              pg8::EpiGate3 E{GSCR, TAB[25] + l * 3072, SS + (size_t)((3 * l + 1) % 3) * M * 16};
              pg8::gemm_phase<pg8::EpiGate3, pg8::TileBatchOrder, true, true>(ldsl, g, S, E); }
            { pg8::Gemm g{YS5, (const bf16r*)(ws + W_BR), M, 1024, 512, 512, 512, 0, (size_t)1024 * 512 * 2, {0, (size_t)(WS_YGLA - WS_YS5), (size_t)(WS_ACC - WS_YS5)}, 1}; pg8::TileBatchOrder S; S.init(M, 1024, 3, G, bx);
              pg8::EpiMerge3 E{GSCR, (bf16r*)(ws + WS_MG16)};
              pg8::gemm_phase<pg8::EpiMerge3, pg8::TileBatchOrder, true, true>(ldsl, g, S, E); }
        }
#endif
        GSYNC();
        { PH pg8::Gemm g{GSCR, (const bf16r*)(ws + W_OUT), M, 1024, 1024, 1024, 1024}; pg8::StaticOrder S; S.init(M, 1024, G, bx);
          pg8::EpiResid E{X, X, XB, SS + (size_t)((3 * l + 2) % 3) * M * 16, 1.0f};
          pg8::gemm_phase<pg8::EpiResid, pg8::StaticOrder, true, true>(ldsl, g, S, E); }
        GSYNC();
        if (l == STOP_L && STOP_P == 10) { fin_buf = 2; goto final_norm; }
        { PH pg8::Gemm g{XB, (const bf16r*)(ws + W_GU2), M, 5632, 1024, 1024, 1024}; pg8::StaticOrder S; S.init(M, 5632, G, bx);
          pg8::EpiSwiGLU E{HB, SS + (size_t)((3 * l + 2) % 3) * M * 16, FF};
          pg8::gemm_phase<pg8::EpiSwiGLU, pg8::StaticOrder, true, true>(ldsl, g, S, E); }
        GSYNC();
        { PH pg8::Gemm g{HB, (const bf16r*)(ws + W_D2), M, 1024, FF, FF, FF}; pg8::StaticOrder S; S.init(M, 1024, G, bx);
          pg8::EpiResid E{X, X, (l == 1 ? (bf16r*)nullptr : XB), SS + (size_t)((3 * l + 3) % 3) * M * 16, 0.5f};
          pg8::gemm_phase<pg8::EpiResid, pg8::StaticOrder, true, true>(ldsl, g, S, E); }
        GSYNC();
        if (l == STOP_L && STOP_P == 12) { fin_buf = 0; goto final_norm; }

    }
    final_norm:
    { PH
        const float* fg = TAB[31];
        for (int m = gw; m < M; m += NGW) { f32x4* xo = (f32x4*)(X + (size_t)m * 1024) + lane; const float r = pg8::rstd1024(SS + (size_t)fin_buf * M * 16, m);
#pragma unroll
            for (int j = 0; j < 4; ++j) { f32x4 v = xo[64 * j]; const f32x4 gq = ((const f32x4*)fg)[lane + 64 * j]; v = v * r * gq; xo[64 * j] = v; } }
    }
}

extern "C" void kernel_launch(void* const* d_in, const int* in_sizes, int n_in, void* d_out, int out_size, void* d_ws, size_t ws_size, hipStream_t stream) {
    static int grid = 0;
    if (grid == 0) {
        if (n_in != 32 || out_size != M * 1024 || ws_size < WS_NEED) { fprintf(stderr, "kernel_launch: unexpected sizes (n_in %d out %d ws %zu)\n", n_in, out_size, ws_size); grid = -1; return; }
        int dev = 0, cus = 0, per_cu = 0;
        hipGetDevice(&dev); hipDeviceGetAttribute(&cus, hipDeviceAttributeMultiprocessorCount, dev);
        hipFuncSetAttribute((const void*)fwd_kernel, hipFuncAttributeMaxDynamicSharedMemorySize, LDS_BYTES);
        hipOccupancyMaxActiveBlocksPerMultiprocessor(&per_cu, (const void*)fwd_kernel, NWAVES * 64, LDS_BYTES);
        if (per_cu < 1) per_cu = 1;
        grid = cus * per_cu; if (grid > 256) grid = 256;
        (void)hipGetLastError();
    }
    if (grid < 0) return;
    if (hipMemsetAsync((char*)d_ws + WS_BAR, 0, 16384, stream) != hipSuccess) { fprintf(stderr, "memset failed\n"); return; }
    Args a{};
    for (int i = 0; i < 32; ++i) a.in[i] = (const float*)d_in[i];
    a.out = (float*)d_out; a.ws = (unsigned char*)d_ws;
    void* kargs[] = {&a};
    hipError_t e = hipLaunchCooperativeKernel((const void*)fwd_kernel, dim3(grid), dim3(NWAVES * 64), kargs, LDS_BYTES, stream);
    if (e != hipSuccess) fprintf(stderr, "cooperative launch failed: %s (grid %d)\n", hipGetErrorString(e), grid);
}
```
